# Optimizing an MI355X kernel written in HIP

```python
import math
import jax, jax.numpy as jnp
from jax import lax
import numpy as np

D_MODEL = 1024
BATCH = 4
SEQ = 4096
DEPTH = 1
DEC_BATCH = 128
DEC_SEQ = 8
PAST_LEN = 2048
PAGE_SIZE = 128

HEAD_DIM = 64
HEADS_PER_GROUP = 4
ATTN_GROUPS = ((128, 1), (512, 4), (2048, 16))
N_GROUPS = len(ATTN_GROUPS)
GROUP_WIDTH = HEADS_PER_GROUP * HEAD_DIM
WIN_STEPS = 128
BLOCK = WIN_STEPS
D_CONV = D_MODEL // 2
CONV_W = 3
D_FF = 4 * D_MODEL
ROPE_THETA = 10000.0
ALPHA = (2.0 * DEPTH) ** 0.25
BETA = (8.0 * DEPTH) ** -0.25
LN_EPS = 1e-5
ATTN_SCALE = HEAD_DIM ** -0.5
N_IN = 3 * D_CONV + 3 * N_GROUPS * GROUP_WIDTH + 2 * D_MODEL

kernel_name = 'hybrid_shortconv_dilated_swa_decoder_step'


def layer_norm(x, g, b):
    xf = x.astype(jnp.float32)
    mu = jnp.mean(xf, axis=-1, keepdims=True)
    var = jnp.mean(jnp.square(xf - mu), axis=-1, keepdims=True)
    return ((xf - mu) * lax.rsqrt(var + LN_EPS) * g.astype(jnp.float32) + b.astype(jnp.float32)).astype(x.dtype)


def rope(x, pos):
    inv = 1.0 / (ROPE_THETA ** (jnp.arange(0, HEAD_DIM, 2, dtype=jnp.float32) / HEAD_DIM))
    ang = pos.astype(jnp.float32)[:, None] * inv[None, :]
    cos = jnp.cos(ang)[None, :, None, :]
    sin = jnp.sin(ang)[None, :, None, :]
    xf = x.astype(jnp.float32)
    x1, x2 = xf[..., :HEAD_DIM // 2], xf[..., HEAD_DIM // 2:]
    return jnp.concatenate([x1 * cos - x2 * sin, x2 * cos + x1 * sin], axis=-1).astype(x.dtype)


def masked_softmax_lse(s, valid):
    s = jnp.where(valid, s, -jnp.inf)
    m = jnp.max(s, axis=-1, keepdims=True)
    p = jnp.exp(s - m)
    denom = jnp.sum(p, axis=-1, keepdims=True)
    return p / denom, (m + jnp.log(denom))[..., 0]


def dilated_attn_prompt(q, k, v, dil):
    n, s_len, h, e = q.shape
    L = s_len // dil
    nb = -(-L // BLOCK)
    lp = nb * BLOCK

    def to_blocks(t):
        t = t.reshape(n, L, dil, h, e).transpose(0, 2, 1, 3, 4)
        t = jnp.pad(t, ((0, 0), (0, 0), (0, lp - L), (0, 0), (0, 0)))
        return t.reshape(n, dil, nb, BLOCK, h, e)

    def with_prev(t):
        prev = jnp.pad(t[:, :, :-1], ((0, 0), (0, 0), (1, 0), (0, 0), (0, 0), (0, 0)))
        return jnp.concatenate([prev, t], axis=3)

    qb = to_blocks(q)
    kk = with_prev(to_blocks(k))
    vv = with_prev(to_blocks(v))
    s = jnp.einsum('nrbqhe,nrbkhe->nrbhqk', qb, kk, preferred_element_type=jnp.float32) * ATTN_SCALE
    qi = jnp.arange(nb)[:, None] * BLOCK + jnp.arange(BLOCK)[None, :]
    ki = (jnp.arange(nb)[:, None] - 1) * BLOCK + jnp.arange(2 * BLOCK)[None, :]
    dist = qi[:, :, None] - ki[:, None, :]
    valid = (dist >= 0) & (dist <= WIN_STEPS) & (ki[:, None, :] >= 0)
    p, lse = masked_softmax_lse(s, valid[:, None])
    o = jnp.einsum('nrbhqk,nrbkhe->nrbqhe', p.astype(v.dtype), vv)
    o = o.reshape(n, dil, lp, h, e)[:, :, :L].transpose(0, 2, 1, 3, 4).reshape(n, s_len, h, e)
    lse = lse.transpose(0, 1, 2, 4, 3).reshape(n, dil, lp, h)[:, :, :L].transpose(0, 2, 1, 3).reshape(n, s_len, h)
    return o, lse


def dilated_attn_sample(q, k, v, kv_prev, dil, window):
    n, t_len, h, e = q.shape
    w = kv_prev.shape[1]
    kv_all = jnp.concatenate([kv_prev.astype(k.dtype), jnp.stack([k, v], axis=2)], axis=1)
    idx = w + jnp.arange(t_len)[:, None] - jnp.arange(WIN_STEPS + 1)[None, :] * dil
    valid = idx >= 0
    g = kv_all[:, jnp.maximum(idx, 0)]
    s = jnp.einsum('nthe,ntjhe->nthj', q, g[:, :, :, 0], preferred_element_type=jnp.float32) * ATTN_SCALE
    p, lse = masked_softmax_lse(s, valid[None, :, None, :])
    o = jnp.einsum('nthj,ntjhe->nthe', p.astype(v.dtype), g[:, :, :, 1])
    new_kv = kv_all[:, -min(window, w + t_len):]
    return o, lse, new_kv


def short_conv(gb, gc, hc, conv_prev, conv_w):
    u = gc * hc
    u_pad = jnp.concatenate([conv_prev.astype(u.dtype), u], axis=1)
    t_len = u.shape[1]
    y = conv_w[0] * u_pad[:, 0:t_len]
    for j in range(1, CONV_W):
        y = y + conv_w[j] * u_pad[:, j:j + t_len]
    return gb * y, u_pad[:, -(CONV_W - 1):]


def decoder_layer(x, pos, conv_prev, kv_prev, w_in, b_gate, conv_w, w_conv_out, w_attn_out, w_o,
                  ln1_g, ln1_b, w_up, w_down, ln2_g, ln2_b):
    n, t_len, _ = x.shape
    z = jnp.einsum('btd,dn->btn', x, w_in)
    gb = z[..., 0:D_CONV]
    gc = z[..., D_CONV:2 * D_CONV]
    hc = z[..., 2 * D_CONV:3 * D_CONV]
    yc, conv_state = short_conv(gb, gc, hc, conv_prev, conv_w)

    outs, lses, kv_new = [], [], []
    for gi, (window, dil) in enumerate(ATTN_GROUPS):
        off = 3 * D_CONV + gi * 3 * GROUP_WIDTH
        q = rope(z[..., off:off + GROUP_WIDTH].reshape(n, t_len, HEADS_PER_GROUP, HEAD_DIM), pos)
        k = rope(z[..., off + GROUP_WIDTH:off + 2 * GROUP_WIDTH].reshape(n, t_len, HEADS_PER_GROUP, HEAD_DIM), pos)
        v = z[..., off + 2 * GROUP_WIDTH:off + 3 * GROUP_WIDTH].reshape(n, t_len, HEADS_PER_GROUP, HEAD_DIM)
        if kv_prev is None:
            o, lse = dilated_attn_prompt(q, k, v, dil)
            kv = jnp.stack([k, v], axis=2)[:, -min(window, t_len):]
        else:
            o, lse, kv = dilated_attn_sample(q, k, v, kv_prev[gi], dil, window)
        outs.append(o)
        lses.append(lse)
        kv_new.append(kv)

    wts = jax.nn.softmax(jnp.stack(lses, axis=0), axis=0)
    ya = wts[0][..., None] * outs[0]
    for gi in range(1, N_GROUPS):
        ya = ya + wts[gi][..., None] * outs[gi]
    ya = ya.astype(x.dtype).reshape(n, t_len, GROUP_WIDTH)

    gates = jax.nn.sigmoid(z[..., -2 * D_MODEL:] + b_gate)
    mixed = gates[..., :D_MODEL] * (yc @ w_conv_out) + gates[..., D_MODEL:] * (ya @ w_attn_out)
    x1 = layer_norm(ALPHA * x + mixed @ w_o, ln1_g, ln1_b)
    hid = jnp.square(jax.nn.relu(x1 @ w_up))
    x2 = layer_norm(ALPHA * x1 + hid @ w_down, ln2_g, ln2_b)
    return x2, conv_state, kv_new


def setup_inputs(seed: int = 0) -> dict:
    key = jax.random.key(seed)
    ks = jax.random.split(key, 20)
    f32 = jnp.float32

    def nrm(k, shape, scale):
        return jax.random.normal(k, shape, f32) * scale

    def kv_cache(k, window):
        return nrm(k, (DEPTH, DEC_BATCH, min(window, PAST_LEN), 2, HEADS_PER_GROUP, HEAD_DIM), 1.0)

    col_scale = jnp.concatenate(
        [jnp.ones((2 * D_CONV,), f32), jnp.full((D_CONV,), BETA, f32)]
        + [jnp.concatenate([jnp.ones((2 * GROUP_WIDTH,), f32), jnp.full((GROUP_WIDTH,), BETA, f32)]) for _ in range(N_GROUPS)]
        + [jnp.ones((2 * D_MODEL,), f32)])
    return {
        'x_prompt': nrm(ks[0], (BATCH, SEQ, D_MODEL), 1.0),
        'x_sample': nrm(ks[1], (DEC_BATCH, DEC_SEQ, D_MODEL), 1.0),
        'state_conv': nrm(ks[2], (DEPTH, DEC_BATCH, CONV_W - 1, D_CONV), 1.0),
        'cache_kv_w128': kv_cache(ks[3], ATTN_GROUPS[0][0]),
        'cache_kv_w512': kv_cache(ks[4], ATTN_GROUPS[1][0]),
        'cache_kv_w2048': kv_cache(ks[5], ATTN_GROUPS[2][0]),
        'w_in': nrm(ks[6], (DEPTH, D_MODEL, N_IN), D_MODEL ** -0.5) * col_scale,
        'b_gate': nrm(ks[7], (DEPTH, 2 * D_MODEL), 0.02),
        'conv_w': nrm(ks[8], (DEPTH, CONV_W, D_CONV), CONV_W ** -0.5),
        'w_conv_out': nrm(ks[9], (DEPTH, D_CONV, D_MODEL), BETA * D_CONV ** -0.5),
        'w_attn_out': nrm(ks[10], (DEPTH, GROUP_WIDTH, D_MODEL), BETA * GROUP_WIDTH ** -0.5),
        'w_o': nrm(ks[11], (DEPTH, D_MODEL, D_MODEL), BETA * D_MODEL ** -0.5),
        'ln1_g': 1.0 + nrm(ks[12], (DEPTH, D_MODEL), 0.02),
        'ln1_b': nrm(ks[13], (DEPTH, D_MODEL), 0.02),
        'w_up': nrm(ks[14], (DEPTH, D_MODEL, D_FF), BETA * D_MODEL ** -0.5),
        'w_down': nrm(ks[15], (DEPTH, D_FF, D_MODEL), BETA * D_FF ** -0.5),
        'ln2_g': 1.0 + nrm(ks[16], (DEPTH, D_MODEL), 0.02),
        'ln2_b': nrm(ks[17], (DEPTH, D_MODEL), 0.02),
    }


def reference(x_prompt, x_sample, state_conv, cache_kv_w128, cache_kv_w512, cache_kv_w2048,
              w_in, b_gate, conv_w, w_conv_out, w_attn_out, w_o, ln1_g, ln1_b, w_up, w_down, ln2_g, ln2_b):
    n_p, s_p, _ = x_prompt.shape
    t_s = x_sample.shape[1]
    pos_p = jnp.arange(s_p, dtype=jnp.int32)
    pos_s = PAST_LEN + jnp.arange(t_s, dtype=jnp.int32)
    conv_zero = jnp.zeros((n_p, CONV_W - 1, D_CONV), x_prompt.dtype)
    hp, hs = x_prompt, x_sample
    cp_list, cs_list, kvp_list, kvs_list = [], [], [], []
    for l in range(DEPTH):
        weights = (w_in[l], b_gate[l], conv_w[l], w_conv_out[l], w_attn_out[l], w_o[l],
                   ln1_g[l], ln1_b[l], w_up[l], w_down[l], ln2_g[l], ln2_b[l])
        hp, cp, kvp = decoder_layer(hp, pos_p, conv_zero, None, *weights)
        hs, cs, kvs = decoder_layer(hs, pos_s, state_conv[l],
                                    (cache_kv_w128[l], cache_kv_w512[l], cache_kv_w2048[l]), *weights)
        cp_list.append(cp)
        cs_list.append(cs)
        kvp_list.append(kvp)
        kvs_list.append(kvs)
    conv_p = jnp.stack(cp_list, axis=0)
    conv_s = jnp.stack(cs_list, axis=0)
    kvp_g = [jnp.stack([kv[g] for kv in kvp_list], axis=0) for g in range(N_GROUPS)]
    kvs_g = [jnp.stack([kv[g] for kv in kvs_list], axis=0) for g in range(N_GROUPS)]
    return (hp, hs, conv_p, kvp_g[0], kvp_g[1], kvp_g[2], conv_s, kvs_g[0], kvs_g[1], kvs_g[2])
```

```cpp
#include <hip/hip_runtime.h>
#include <hip/hip_cooperative_groups.h>
#include <cstdio>
#include <cstdint>
namespace cg = cooperative_groups;

#ifndef MK_MULTI
#define MK_MULTI 0
#endif

namespace pg8 {
#define PG8_LAS __attribute__((address_space(3)))
typedef unsigned short bf16_t;
typedef short bf16x8 __attribute__((ext_vector_type(8)));
typedef float f32x4 __attribute__((ext_vector_type(4)));
typedef unsigned u32x4 __attribute__((ext_vector_type(4)));
typedef unsigned u32x2 __attribute__((ext_vector_type(2)));
constexpr int BM = 256, BK = 64, HALF = 128, HTB = HALF * BK * 2, STAGE_BYTES = 8 * HTB, NXCD = 8, WGM = 8;

__host__ __device__ __forceinline__ int lds_byte(int r, int c) { const int st = (r >> 4) * 2 + (c >> 5), rr = r & 15, cc = c & 31, ob = rr * 64 + cc * 2; return st * 1024 + (ob ^ (((ob >> 9) & 1) << 5)); }
__host__ __device__ __forceinline__ void stage_rc(int b, int& R, int& C) { const int st = b / 1024, sb = b % 1024, swz = sb ^ (((sb >> 9) & 1) << 5); R = (st >> 1) * 16 + swz / 64; C = (st & 1) * 32 + (swz % 64) / 2; }
__host__ __device__ __forceinline__ int perm32(int rho) { const int n = rho >> 4, i = rho & 15; return 8 * (i >> 2) + 4 * n + (i & 3); }
__host__ __device__ __forceinline__ int swap45(int v) { return (v & 15) | ((v & 16) << 1) | ((v & 32) >> 1); }

struct Unit { int pm, pn; };
struct Gemm { const bf16_t* A; const bf16_t* Bt; int M, N, K; };

struct StaticOrder {
    int nM, nN, nwg, G, c;
    __host__ __device__ void init(int M, int N, int G_, int c_) { nM = M / BM; nN = N / BM; nwg = nM * nN; G = G_; c = c_; }
    __host__ __device__ bool next(int i, Unit& u) const {
        const long L = (long)i * G + c; if (L >= nwg) return false;
        int wgid = (int)L; { const int q = nwg / NXCD, r = nwg % NXCD, xcd = wgid % NXCD, off = wgid / NXCD; wgid = (xcd < r ? xcd * (q + 1) : r * (q + 1) + (xcd - r) * q) + off; }
        const int nig = WGM * nN, gid = wgid / nig, fm = gid * WGM, gsz = (nM - fm) < WGM ? (nM - fm) : WGM;
        u.pm = fm + ((wgid % nig) % gsz); u.pn = (wgid % nig) / gsz; return true;
    }
    __device__ __forceinline__ void a_ready(const Unit&) const {}
    __device__ __forceinline__ void done(const Unit&) const {}
};

typedef float cvt_f32x2 __attribute__((ext_vector_type(2)));
typedef __bf16 cvt_bf16x2 __attribute__((ext_vector_type(2)));
__device__ __forceinline__ unsigned cvt_pk_bf16(float lo, float hi) { const cvt_f32x2 v = {lo, hi}; const cvt_bf16x2 b = __builtin_convertvector(v, cvt_bf16x2); return __builtin_bit_cast(unsigned, b); }

template <class Epi, class Sched, bool ALIGN_EPI = false, bool SP2 = false>
__device__ __forceinline__ void gemm_phase(PG8_LAS unsigned char* lds, const Gemm g, const Sched& S, const Epi& E) {
    const int tid = threadIdx.x, wid = __builtin_amdgcn_readfirstlane(tid >> 6), lane = tid & 63, wr = wid >> 2, wc = wid & 3, fr = lane & 15, fq = lane >> 4;
    const int K = g.K, nt = K / BK;
    unsigned voffA[2], voffB[2];
#pragma unroll
    for (int i = 0; i < 2; ++i) { int R, C; stage_rc(tid * 16 + i * 8192, R, C);
        const int Rb = Epi::PERM == 1 ? ((R & ~31) + perm32(R & 31)) : (Epi::PERM == 2 ? ((R & ~63) + swap45(R & 63)) : R);
        voffA[i] = (unsigned)(R * K + C) * 2u; voffB[i] = (unsigned)(Rb * K + C) * 2u; }
    const size_t kstep = (size_t)(BK * 2);
    const size_t hstep = (size_t)HALF * K * 2;
    const size_t tstep = 2 * hstep;
    const unsigned ldsw = (unsigned)wid * 1024u;
    const int aoff = lds_byte(wr * 64 + fr, fq * 8), boff = lds_byte(wc * 32 + fr, fq * 8);
#define PG8_SA(b, h) (((b) * 2 + (h)) * HTB)
#define PG8_SB(b, h) ((4 + (b) * 2 + (h)) * HTB)
#define PG8_STAGE(bufoff, gbase, voff) do { _Pragma("unroll") for (int _i = 0; _i < 2; ++_i) \
        __builtin_amdgcn_global_load_lds((const unsigned*)((const char*)(gbase) + (voff)[_i]), (PG8_LAS unsigned*)(lds + (bufoff) + ldsw + _i * 8192), 16, 0, 0); } while (0)
#define PG8_LDA(dst, b, h) do { _Pragma("unroll") for (int m = 0; m < 4; ++m) _Pragma("unroll") for (int k = 0; k < 2; ++k) dst[m][k] = *(const PG8_LAS bf16x8*)(lds + PG8_SA(b, h) + aoff + m * 2048 + k * 1024); } while (0)
#define PG8_LDB(dst, b, h) do { _Pragma("unroll") for (int n = 0; n < 2; ++n) _Pragma("unroll") for (int k = 0; k < 2; ++k) dst[n][k] = *(const PG8_LAS bf16x8*)(lds + PG8_SB(b, h) + boff + n * 2048 + k * 1024); } while (0)
#define PG8_MMA(ai, bj, At, Bt) do { __builtin_amdgcn_s_setprio(1); _Pragma("unroll") for (int m = 0; m < 4; ++m) _Pragma("unroll") for (int n = 0; n < 2; ++n) _Pragma("unroll") for (int k = 0; k < 2; ++k) \
        acc[ai][bj][m][n] = __builtin_amdgcn_mfma_f32_16x16x32_bf16(Bt[n][k], At[m][k], acc[ai][bj][m][n], 0, 0, 0); __builtin_amdgcn_s_setprio(0); } while (0)
#define PG8_WAIT_V(n) asm volatile("s_waitcnt vmcnt(" #n ")" ::: "memory")
#define PG8_WAIT_L(n) asm volatile("s_waitcnt lgkmcnt(" #n ")" ::: "memory")
#define PG8_BAR __builtin_amdgcn_s_barrier()
#define PG8_SCHED __builtin_amdgcn_sched_barrier(0)
    Unit cur, nxt; int ui = 0;
    if (!S.next(0, cur)) return;
    f32x4 acc[2][2][4][2];
#pragma unroll
    for (int a = 0; a < 2; ++a)
#pragma unroll
        for (int b = 0; b < 2; ++b)
#pragma unroll
            for (int m = 0; m < 4; ++m)
#pragma unroll
                for (int n = 0; n < 2; ++n) acc[a][b][m][n] = (f32x4){0.f, 0.f, 0.f, 0.f};
    bf16x8 At[4][2], B0[2][2], B1[2][2];
    const char* cA = (const char*)g.A + (size_t)cur.pm * tstep; const char* cB = (const char*)g.Bt + (size_t)cur.pn * tstep;
    S.a_ready(cur);
    if constexpr (SP2) {
        PG8_STAGE(PG8_SB(0, 0), cB, voffB); PG8_STAGE(PG8_SB(0, 1), cB + hstep, voffB); PG8_STAGE(PG8_SA(0, 0), cA, voffA); PG8_STAGE(PG8_SA(0, 1), cA + hstep, voffA);
        if (wr == 1) PG8_BAR;
        PG8_WAIT_V(2); PG8_BAR;
        PG8_STAGE(PG8_SB(1, 0), cB + kstep, voffB); PG8_STAGE(PG8_SA(1, 0), cA + kstep, voffA); PG8_STAGE(PG8_SB(1, 1), cB + hstep + kstep, voffB);
        PG8_WAIT_V(6); PG8_BAR;
    } else {
        PG8_STAGE(PG8_SB(0, 0), cB, voffB); PG8_STAGE(PG8_SA(0, 0), cA, voffA); PG8_STAGE(PG8_SB(0, 1), cB + hstep, voffB); PG8_STAGE(PG8_SA(0, 1), cA + hstep, voffA);
        if (wr == 1) PG8_BAR;
        PG8_WAIT_V(4); PG8_BAR;
        PG8_STAGE(PG8_SB(1, 0), cB + kstep, voffB); PG8_STAGE(PG8_SA(1, 0), cA + kstep, voffA); PG8_STAGE(PG8_SB(1, 1), cB + hstep + kstep, voffB);
        PG8_WAIT_V(6); PG8_BAR;
    }
    for (;;) {
        const bool has_next = S.next(ui + 1, nxt);
        const char* nA = has_next ? (const char*)g.A + (size_t)nxt.pm * tstep : cA; const char* nB = has_next ? (const char*)g.Bt + (size_t)nxt.pn * tstep : cB;
        for (int t = 0; t < nt; t += 2) {
            const bool last = (t == nt - 2);
            const char* a1 = cA + (size_t)(t + 1) * kstep;
            const char* a2 = last ? nA : cA + (size_t)(t + 2) * kstep; const char* b2 = last ? nB : cB + (size_t)(t + 2) * kstep;
            const char* a3 = a2 + kstep; const char* b3 = b2 + kstep;
            if (last && has_next) S.a_ready(nxt);
            if constexpr (SP2) {
            PG8_LDB(B0, 0, 0); PG8_LDB(B1, 0, 1); PG8_SCHED; PG8_LDA(At, 0, 0); PG8_STAGE(PG8_SA(1, 1), a1 + hstep, voffA);
            PG8_WAIT_V(8); PG8_WAIT_L(0); PG8_BAR; PG8_MMA(0, 0, At, B0); PG8_MMA(0, 1, At, B1); PG8_BAR; PG8_SCHED;
            PG8_LDA(At, 0, 1); PG8_STAGE(PG8_SB(0, 0), b2, voffB); PG8_STAGE(PG8_SB(0, 1), b2 + hstep, voffB); PG8_STAGE(PG8_SA(0, 0), a2, voffA);
            PG8_WAIT_V(8); PG8_WAIT_L(0); PG8_BAR; PG8_MMA(1, 0, At, B0); PG8_MMA(1, 1, At, B1); PG8_BAR; PG8_SCHED;
            PG8_LDB(B0, 1, 0); PG8_LDB(B1, 1, 1); PG8_SCHED; PG8_LDA(At, 1, 0); PG8_STAGE(PG8_SA(0, 1), a2 + hstep, voffA);
            PG8_WAIT_V(8); PG8_WAIT_L(0); PG8_BAR; PG8_MMA(0, 0, At, B0); PG8_MMA(0, 1, At, B1); PG8_BAR; PG8_SCHED;
            PG8_LDA(At, 1, 1); PG8_STAGE(PG8_SB(1, 0), b3, voffB); PG8_STAGE(PG8_SB(1, 1), b3 + hstep, voffB); PG8_STAGE(PG8_SA(1, 0), a3, voffA);
            PG8_WAIT_V(8); PG8_WAIT_L(0); PG8_BAR; PG8_MMA(1, 0, At, B0); PG8_MMA(1, 1, At, B1); PG8_BAR; PG8_SCHED;
            } else {
            PG8_LDB(B0, 0, 0); PG8_SCHED; PG8_LDA(At, 0, 0); PG8_STAGE(PG8_SA(1, 1), a1 + hstep, voffA);
            PG8_WAIT_L(8); PG8_BAR; PG8_WAIT_L(0); PG8_MMA(0, 0, At, B0); PG8_BAR; PG8_SCHED;
            PG8_LDB(B1, 0, 1); PG8_STAGE(PG8_SB(0, 0), b2, voffB);
            PG8_BAR; PG8_WAIT_L(0); PG8_MMA(0, 1, At, B1); PG8_BAR;
            PG8_LDA(At, 0, 1); PG8_STAGE(PG8_SA(0, 0), a2, voffA);
            PG8_BAR; PG8_WAIT_L(0); PG8_MMA(1, 0, At, B0); PG8_BAR; PG8_SCHED;
            PG8_STAGE(PG8_SB(0, 1), b2 + hstep, voffB);
            PG8_WAIT_V(6); PG8_BAR; PG8_MMA(1, 1, At, B1); PG8_BAR;
            PG8_LDB(B0, 1, 0); PG8_SCHED; PG8_LDA(At, 1, 0); PG8_STAGE(PG8_SA(0, 1), a2 + hstep, voffA);
            PG8_WAIT_L(8); PG8_BAR; PG8_WAIT_L(0); PG8_MMA(0, 0, At, B0); PG8_BAR; PG8_SCHED;
            PG8_LDB(B1, 1, 1); PG8_STAGE(PG8_SB(1, 0), b3, voffB);
            PG8_BAR; PG8_WAIT_L(0); PG8_MMA(0, 1, At, B1); PG8_BAR;
            PG8_LDA(At, 1, 1); PG8_STAGE(PG8_SA(1, 0), a3, voffA);
            PG8_BAR; PG8_WAIT_L(0); PG8_MMA(1, 0, At, B0); PG8_BAR; PG8_SCHED;
            PG8_STAGE(PG8_SB(1, 1), b3 + hstep, voffB);
            PG8_WAIT_V(6); PG8_BAR; PG8_MMA(1, 1, At, B1); PG8_BAR;
            }
        }
        if constexpr (ALIGN_EPI) { if (wr == 0) PG8_BAR; }
        E(acc, cur, wr, wc, fr, fq);
        if (!has_next) break;
#pragma unroll
        for (int a = 0; a < 2; ++a)
#pragma unroll
            for (int b = 0; b < 2; ++b)
#pragma unroll
                for (int m = 0; m < 4; ++m)
#pragma unroll
                    for (int n = 0; n < 2; ++n) acc[a][b][m][n] = (f32x4){0.f, 0.f, 0.f, 0.f};
        cur = nxt; cA = nA; cB = nB; ++ui;
        if constexpr (ALIGN_EPI) { if (wr == 1) PG8_BAR; }
    }
    PG8_WAIT_V(0);
    if constexpr (!ALIGN_EPI) { if (wr == 0) PG8_BAR; }
    PG8_BAR;
#undef PG8_SA
#undef PG8_SB
#undef PG8_STAGE
#undef PG8_LDA
#undef PG8_LDB
#undef PG8_MMA
#undef PG8_WAIT_V
#undef PG8_WAIT_L
#undef PG8_BAR
#undef PG8_SCHED
}
}

using pg8::bf16_t; using pg8::f32x4; using pg8::u32x4; using pg8::u32x2; using pg8::bf16x8; using pg8::cvt_pk_bf16;
#define LAS __attribute__((address_space(3)))
typedef short bf16x4 __attribute__((ext_vector_type(4)));
typedef float f32x2 __attribute__((ext_vector_type(2)));
constexpr int D = 1024, SEQ = 4096, MP = 16384, MS = 1024, M = MP + MS, NIN = 5888, DC = 512, FF = 4096;
constexpr int NT = 512;
constexpr float ALPHA = 1.189207115002721f;
constexpr float LN_EPS = 1e-5f;
constexpr int LDS_BYTES = pg8::STAGE_BYTES;

constexpr size_t WS_XB = 0;
constexpr size_t WS_WIN = WS_XB + (size_t)M * D * 2;
constexpr size_t WS_WC = WS_WIN + (size_t)NIN * D * 2;
constexpr size_t WS_WA = WS_WC + (size_t)1024 * 512 * 2;
constexpr size_t WS_WO = WS_WA + (size_t)1024 * 256 * 2;
constexpr size_t WS_WUP = WS_WO + (size_t)1024 * 1024 * 2;
constexpr size_t WS_WDN = WS_WUP + (size_t)4096 * 1024 * 2;
constexpr size_t WS_ROPE = WS_WDN + (size_t)4096 * 1024 * 2;
constexpr size_t WS_ZC = WS_ROPE + (size_t)4096 * 32 * 8;
constexpr size_t WS_QKV = WS_ZC + (size_t)M * 1536 * 2;
constexpr size_t WS_GATE = WS_QKV + (size_t)9 * M * 256 * 2;
constexpr size_t WS_OG = WS_GATE + (size_t)M * 2048 * 2;
constexpr size_t WS_LSE = WS_OG + (size_t)3 * M * 256 * 2;
constexpr size_t WS_YC = WS_LSE + (size_t)3 * M * 4 * 4;
constexpr size_t WS_YA = WS_YC + (size_t)M * 512 * 2;
constexpr size_t WS_MIX = WS_YA + (size_t)M * 256 * 2;
constexpr size_t WS_PRE = WS_MIX + (size_t)M * 1024 * 2;
constexpr size_t WS_X1F = WS_PRE + (size_t)M * 1024 * 4;
constexpr size_t WS_X1B = WS_X1F + (size_t)M * 1024 * 4;
constexpr size_t WS_HID = WS_X1B + (size_t)M * 1024 * 2;
constexpr size_t WS_END = WS_HID + (size_t)M * 4096 * 2;

constexpr size_t O_YP = 0;
constexpr size_t O_YS = O_YP + (size_t)MP * D;
constexpr size_t O_CP = O_YS + (size_t)MS * D;
constexpr size_t O_KVP0 = O_CP + 4 * 2 * 512;
constexpr size_t O_KVP1 = O_KVP0 + (size_t)4 * 128 * 512;
constexpr size_t O_KVP2 = O_KVP1 + (size_t)4 * 512 * 512;
constexpr size_t O_CS = O_KVP2 + (size_t)4 * 2048 * 512;
constexpr size_t O_KVS0 = O_CS + (size_t)128 * 2 * 512;
constexpr size_t O_KVS1 = O_KVS0 + (size_t)128 * 128 * 512;
constexpr size_t O_KVS2 = O_KVS1 + (size_t)128 * 512 * 512;
constexpr size_t O_END = O_KVS2 + (size_t)128 * 2048 * 512;

struct Params { const float* in[18]; float* out; unsigned char* ws; int ph_lo, ph_hi; };

__device__ __forceinline__ float bflo(unsigned w) { return __builtin_bit_cast(float, w << 16); }
__device__ __forceinline__ float bfhi(unsigned w) { return __builtin_bit_cast(float, w & 0xffff0000u); }
__device__ __forceinline__ float bf1(bf16_t h) { return __builtin_bit_cast(float, (unsigned)h << 16); }
__device__ __forceinline__ float wave_sum(float v) {
#pragma unroll
    for (int o = 1; o < 64; o <<= 1) v += __shfl_xor(v, o);
    return v;
}
__device__ __forceinline__ float wave_max(float v) {
#pragma unroll
    for (int o = 1; o < 64; o <<= 1) v = fmaxf(v, __shfl_xor(v, o));
    return v;
}

using pg8::Unit;
struct Epi1 {
    static constexpr int PERM = 2;
    bf16_t* zc; bf16_t* qkv; bf16_t* gates; const float* bgate; const float* rope; float* out;
    __device__ __forceinline__ void operator()(const f32x4 (&acc)[2][2][4][2], const Unit& u, int wr, int wc, int fr, int fq) const {
        const int row0 = u.pm * 256 + wr * 64 + fr;
        const int cw0 = 64 * (wc >> 1) + 16 * (wc & 1) + 4 * fq;
        if (u.pn < 6) {
#pragma unroll
            for (int ai = 0; ai < 2; ++ai)
#pragma unroll
                for (int m = 0; m < 4; ++m) { bf16_t* rp = zc + (size_t)(row0 + ai * 128 + m * 16) * 1536 + u.pn * 256 + cw0;
#pragma unroll
                    for (int bj = 0; bj < 2; ++bj)
#pragma unroll
                        for (int n = 0; n < 2; ++n) { const f32x4 v = acc[ai][bj][m][n]; u32x2 w; w.x = cvt_pk_bf16(v[0], v[1]); w.y = cvt_pk_bf16(v[2], v[3]); *(u32x2*)(rp + bj * 128 + n * 32) = w; } }
        } else if (u.pn < 15) {
            const int t = u.pn - 6, gi = t / 3, kind = t - 3 * gi;
            bf16_t* dst = qkv + (size_t)(gi * 3 + kind) * M * 256;
            const int Wk = 128 << (2 * gi);
            float* okp = out + (gi == 0 ? O_KVP0 : (gi == 1 ? O_KVP1 : O_KVP2));
            float* oks = out + (gi == 0 ? O_KVS0 : (gi == 1 ? O_KVS1 : O_KVS2));
            const int e0 = 16 * (wc & 1) + 4 * fq;
#pragma unroll
            for (int ai = 0; ai < 2; ++ai)
#pragma unroll
                for (int m = 0; m < 4; ++m) {
                    const int row = row0 + ai * 128 + m * 16;
                    int pos; float* kvb = nullptr;
                    if (row < MP) { const int nb = row >> 12, p = row & 4095; pos = p; const int pk = p - (SEQ - Wk); if (pk >= 0) kvb = okp + ((size_t)(nb * Wk + pk) * 2) * 256; }
                    else { const int rs = row - MP, nb = rs >> 3, tt = rs & 7; pos = 2048 + tt; kvb = oks + ((size_t)(nb * Wk + Wk - 8 + tt) * 2) * 256; }
                    f32x4 cs0 = {1.f, 0.f, 1.f, 0.f}, cs1 = {1.f, 0.f, 1.f, 0.f};
                    if (kind < 2) { const f32x4* rp = (const f32x4*)(rope + ((size_t)pos * 32 + e0) * 2); cs0 = rp[0]; cs1 = rp[1]; }
#pragma unroll
                    for (int bj = 0; bj < 2; ++bj) {
                        f32x4 x1 = acc[ai][bj][m][0], x2 = acc[ai][bj][m][1];
                        if (kind < 2) {
                            const f32x4 c = {cs0[0], cs0[2], cs1[0], cs1[2]}, s = {cs0[1], cs0[3], cs1[1], cs1[3]};
                            const f32x4 o1 = x1 * c - x2 * s, o2 = x2 * c + x1 * s; x1 = o1; x2 = o2;
                            if (kind == 0) { x1 = x1 * 0.125f; x2 = x2 * 0.125f; }
                        }
                        const int hc = (2 * bj + (wc >> 1)) * 64 + e0;
                        u32x2 w1, w2; w1.x = cvt_pk_bf16(x1[0], x1[1]); w1.y = cvt_pk_bf16(x1[2], x1[3]); w2.x = cvt_pk_bf16(x2[0], x2[1]); w2.y = cvt_pk_bf16(x2[2], x2[3]);
                        *(u32x2*)(dst + (size_t)row * 256 + hc) = w1; *(u32x2*)(dst + (size_t)row * 256 + hc + 32) = w2;
                        if (kind >= 1 && kvb) { float* kp = kvb + (kind - 1) * 256 + hc; *(f32x4*)kp = x1; *(f32x4*)(kp + 32) = x2; }
                    }
                    asm volatile("" ::: "memory");
                }
        } else {
            const int cg0 = (u.pn - 15) * 256 + cw0;
#pragma unroll
            for (int bj = 0; bj < 2; ++bj)
#pragma unroll
                for (int n = 0; n < 2; ++n) { const f32x4 bv = *(const f32x4*)(bgate + cg0 + bj * 128 + n * 32);
#pragma unroll
                    for (int ai = 0; ai < 2; ++ai)
#pragma unroll
                        for (int m = 0; m < 4; ++m) { const f32x4 v = acc[ai][bj][m][n] + bv; f32x4 s;
#pragma unroll
                            for (int j = 0; j < 4; ++j) s[j] = __builtin_amdgcn_rcpf(1.0f + __expf(-v[j]));
                            u32x2 w; w.x = cvt_pk_bf16(s[0], s[1]); w.y = cvt_pk_bf16(s[2], s[3]);
                            *(u32x2*)(gates + (size_t)(row0 + ai * 128 + m * 16) * 2048 + cg0 + bj * 128 + n * 32) = w; } }
        }
    }
};
struct Epi3 {
    static constexpr int PERM = 1;
    bf16_t* mix; const bf16_t* gates; int second;
    __device__ __forceinline__ void operator()(const f32x4 (&acc)[2][2][4][2], const Unit& u, int wr, int wc, int fr, int fq) const {
        const int row0 = u.pm * 256 + wr * 64 + fr, col0 = u.pn * 256 + wc * 32 + 8 * fq;
#pragma unroll
        for (int ai = 0; ai < 2; ++ai)
#pragma unroll
            for (int m = 0; m < 4; ++m) { const int row = row0 + ai * 128 + m * 16;
#pragma unroll
                for (int bj = 0; bj < 2; ++bj) { const int c = col0 + bj * 128;
                    const u32x4 g = *(const u32x4*)(gates + (size_t)row * 2048 + second * 1024 + c);
                    f32x4 v0 = acc[ai][bj][m][0], v1 = acc[ai][bj][m][1];
                    v0 = v0 * (f32x4){bflo(g.x), bfhi(g.x), bflo(g.y), bfhi(g.y)}; v1 = v1 * (f32x4){bflo(g.z), bfhi(g.z), bflo(g.w), bfhi(g.w)};
                    bf16_t* mp = mix + (size_t)row * 1024 + c;
                    if (second) { const u32x4 o = *(const u32x4*)mp; v0 = v0 + (f32x4){bflo(o.x), bfhi(o.x), bflo(o.y), bfhi(o.y)}; v1 = v1 + (f32x4){bflo(o.z), bfhi(o.z), bflo(o.w), bfhi(o.w)}; }
                    u32x4 w; w.x = cvt_pk_bf16(v0[0], v0[1]); w.y = cvt_pk_bf16(v0[2], v0[3]); w.z = cvt_pk_bf16(v1[0], v1[1]); w.w = cvt_pk_bf16(v1[2], v1[3]);
                    *(u32x4*)mp = w; }
                asm volatile("" ::: "memory"); }
    }
};
struct EpiRes {
    static constexpr int PERM = 0;
    const float* resA; const float* resB; float* pre;
    __device__ __forceinline__ void operator()(const f32x4 (&acc)[2][2][4][2], const Unit& u, int wr, int wc, int fr, int fq) const {
        const int row0 = u.pm * 256 + wr * 64 + fr, col0 = u.pn * 256 + wc * 32 + 4 * fq;
        const float* res = (u.pm * 256 < MP) ? resA : resB;
#pragma unroll
        for (int ai = 0; ai < 2; ++ai)
#pragma unroll
            for (int m = 0; m < 4; ++m) { const size_t off = (size_t)(row0 + ai * 128 + m * 16) * 1024 + col0;
#pragma unroll
                for (int bj = 0; bj < 2; ++bj)
#pragma unroll
                    for (int n = 0; n < 2; ++n) { const f32x4 r = *(const f32x4*)(res + off + bj * 128 + n * 16); *(f32x4*)(pre + off + bj * 128 + n * 16) = r * ALPHA + acc[ai][bj][m][n]; }
                asm volatile("" ::: "memory"); }
    }
};
struct EpiHid {
    static constexpr int PERM = 1;
    bf16_t* hid;
    __device__ __forceinline__ void operator()(const f32x4 (&acc)[2][2][4][2], const Unit& u, int wr, int wc, int fr, int fq) const {
        const int row0 = u.pm * 256 + wr * 64 + fr, col0 = u.pn * 256 + wc * 32 + 8 * fq;
#pragma unroll
        for (int ai = 0; ai < 2; ++ai)
#pragma unroll
            for (int m = 0; m < 4; ++m) { bf16_t* rp = hid + (size_t)(row0 + ai * 128 + m * 16) * FF + col0;
#pragma unroll
                for (int bj = 0; bj < 2; ++bj) { f32x4 v0 = acc[ai][bj][m][0], v1 = acc[ai][bj][m][1];
#pragma unroll
                    for (int j = 0; j < 4; ++j) { const float a = fmaxf(v0[j], 0.f), b = fmaxf(v1[j], 0.f); v0[j] = a * a; v1[j] = b * b; }
                    u32x4 w; w.x = cvt_pk_bf16(v0[0], v0[1]); w.y = cvt_pk_bf16(v0[2], v0[3]); w.z = cvt_pk_bf16(v1[0], v1[1]); w.w = cvt_pk_bf16(v1[2], v1[3]);
                    *(u32x4*)(rp + bj * 128) = w; } }
    }
};

__device__ __forceinline__ void transpose_item(const float* W, int K, int N, bf16_t* WT, LAS float* scr, int item, int lane) {
    const int nblk = N / 32, kb = item / nblk, nb = item % nblk, k0 = 64 * kb, n0 = 32 * nb;
#pragma unroll 8
    for (int i = 0; i < 32; ++i) { const int kk = 2 * i + (lane >> 5); scr[kk * 33 + (lane & 31)] = W[(size_t)(k0 + kk) * N + n0 + (lane & 31)]; }
    asm volatile("s_waitcnt lgkmcnt(0)" ::: "memory");
    const int c = lane & 7;
#pragma unroll
    for (int j = 0; j < 4; ++j) { const int n = (lane >> 3) + 8 * j; const LAS float* s = scr + (8 * c) * 33 + n;
        u32x4 o; o.x = cvt_pk_bf16(s[0 * 33], s[1 * 33]); o.y = cvt_pk_bf16(s[2 * 33], s[3 * 33]); o.z = cvt_pk_bf16(s[4 * 33], s[5 * 33]); o.w = cvt_pk_bf16(s[6 * 33], s[7 * 33]);
        *(u32x4*)(WT + (size_t)(n0 + n) * K + k0 + 8 * c) = o; }
    asm volatile("s_waitcnt lgkmcnt(0)" ::: "memory");
}

__device__ __forceinline__ void phase_prep(const Params& p, LAS unsigned char* lds) {
    const int tid = threadIdx.x, lane = tid & 63, wave = tid >> 6;
    const size_t gt = (size_t)blockIdx.x * NT + tid, GT = (size_t)gridDim.x * NT;
    unsigned char* ws = p.ws;
    { bf16_t* xb = (bf16_t*)(ws + WS_XB);
      for (size_t i = gt; i < (size_t)M * D / 8; i += GT) {
          const float* src = (i < (size_t)MP * D / 8) ? p.in[0] + i * 8 : p.in[1] + (i - (size_t)MP * D / 8) * 8;
          const f32x4 a = ((const f32x4*)src)[0], b = ((const f32x4*)src)[1];
          u32x4 o; o.x = cvt_pk_bf16(a[0], a[1]); o.y = cvt_pk_bf16(a[2], a[3]); o.z = cvt_pk_bf16(b[0], b[1]); o.w = cvt_pk_bf16(b[2], b[3]);
          *(u32x4*)(xb + i * 8) = o; } }
    { float* rt = (float*)(ws + WS_ROPE);
      for (size_t i = gt; i < (size_t)4096 * 32; i += GT) { const int pos = (int)(i >> 5), f = (int)(i & 31);
          const float inv = 1.0f / exp2f((float)f * (13.287712379549449f / 32.0f));
          const float ang = (float)pos * inv;
          const double rev = (double)ang * 0.15915494309189535; const float fr = (float)(rev - floor(rev));
          rt[2 * i] = __builtin_amdgcn_cosf(fr); rt[2 * i + 1] = __builtin_amdgcn_sinf(fr); } }
    { LAS float* scr = (LAS float*)(lds + wave * 16384);
      const int gw = blockIdx.x * 8 + wave, NGW = gridDim.x * 8;
      constexpr int I_IN = (D / 64) * (NIN / 32), I_C = (DC / 64) * (D / 32), I_A = (256 / 64) * (D / 32), I_O = (D / 64) * (D / 32), I_UP = (D / 64) * (FF / 32), I_DN = (FF / 64) * (D / 32);
      constexpr int NITEMS = I_IN + I_C + I_A + I_O + I_UP + I_DN;
      for (int it = gw; it < NITEMS; it += NGW) { int r = it;
          if (r < I_IN) { transpose_item(p.in[6], D, NIN, (bf16_t*)(ws + WS_WIN), scr, r, lane); continue; } r -= I_IN;
          if (r < I_C) { transpose_item(p.in[9], DC, D, (bf16_t*)(ws + WS_WC), scr, r, lane); continue; } r -= I_C;
          if (r < I_A) { transpose_item(p.in[10], 256, D, (bf16_t*)(ws + WS_WA), scr, r, lane); continue; } r -= I_A;
          if (r < I_O) { transpose_item(p.in[11], D, D, (bf16_t*)(ws + WS_WO), scr, r, lane); continue; } r -= I_O;
          if (r < I_UP) { transpose_item(p.in[14], D, FF, (bf16_t*)(ws + WS_WUP), scr, r, lane); continue; } r -= I_UP;
          transpose_item(p.in[15], FF, D, (bf16_t*)(ws + WS_WDN), scr, r, lane); } }
}

constexpr int KS_STRIDE = 144;
constexpr int VT_STRIDE = 528;
constexpr int KS_OFF = 0, VT_OFF = 256 * KS_STRIDE;
__device__ __forceinline__ void attn_prompt_item(const Params& p, LAS unsigned char* lds, int item) {
    const int tid = threadIdx.x, lane = tid & 63, w = tid >> 6, fr = lane & 15, s = lane >> 4;
    const int g = item >> 9, rem = item & 511, nb = rem >> 7, rem2 = rem & 127, h = rem2 >> 5, rb = rem2 & 31;
    const int dsh = 2 * g, d = 1 << dsh, nbk = 32 >> dsh, r = rb / nbk, b = rb - r * nbk;
    const bf16_t* qb = (const bf16_t*)(p.ws + WS_QKV) + (size_t)(3 * g) * M * 256;
    const bf16_t* kb = qb + (size_t)M * 256; const bf16_t* vb = kb + (size_t)M * 256;
    const size_t rowbase = (size_t)nb * SEQ + r;
    const int i0 = 128 * (b - 1);
#pragma unroll
    for (int ii = 0; ii < 4; ++ii) { const int c = tid + NT * ii, kl = c >> 3, ch = c & 7; int ik = i0 + kl; ik = ik < 0 ? 0 : ik;
        const u32x4 v = *(const u32x4*)(kb + (rowbase + (size_t)ik * d) * 256 + h * 64 + ch * 8);
        *(LAS u32x4*)(lds + KS_OFF + kl * KS_STRIDE + ch * 16) = v; }
#pragma unroll
    for (int ii = 0; ii < 4; ++ii) { const int c = tid + NT * ii, kl = c & 255, ch = c >> 8; int ik = i0 + kl; ik = ik < 0 ? 0 : ik;
        const u32x4 v = *(const u32x4*)(vb + (rowbase + (size_t)ik * d) * 256 + h * 64 + ch * 8);
        LAS bf16_t* vt = (LAS bf16_t*)(lds + VT_OFF + (ch * 8) * VT_STRIDE) + kl;
        vt[0 * (VT_STRIDE / 2)] = (bf16_t)(v.x & 0xffff); vt[1 * (VT_STRIDE / 2)] = (bf16_t)(v.x >> 16);
        vt[2 * (VT_STRIDE / 2)] = (bf16_t)(v.y & 0xffff); vt[3 * (VT_STRIDE / 2)] = (bf16_t)(v.y >> 16);
        vt[4 * (VT_STRIDE / 2)] = (bf16_t)(v.z & 0xffff); vt[5 * (VT_STRIDE / 2)] = (bf16_t)(v.z >> 16);
        vt[6 * (VT_STRIDE / 2)] = (bf16_t)(v.w & 0xffff); vt[7 * (VT_STRIDE / 2)] = (bf16_t)(v.w >> 16); }
    const int iq = 128 * b + 16 * w + fr; const size_t qrow = rowbase + (size_t)iq * d;
    const bf16x8 q0 = *(const bf16x8*)(qb + qrow * 256 + h * 64 + 8 * s), q1 = *(const bf16x8*)(qb + qrow * 256 + h * 64 + 32 + 8 * s);
    __syncthreads();
    f32x4 sc[9];
#pragma unroll
    for (int j = 0; j < 9; ++j) {
        const LAS unsigned char* kp = lds + KS_OFF + (16 * (w + j) + fr) * KS_STRIDE + s * 16;
        const bf16x8 k0 = *(const LAS bf16x8*)kp, k1 = *(const LAS bf16x8*)(kp + 64);
        f32x4 a = {0.f, 0.f, 0.f, 0.f};
        a = __builtin_amdgcn_mfma_f32_16x16x32_bf16(k0, q0, a, 0, 0, 0);
        a = __builtin_amdgcn_mfma_f32_16x16x32_bf16(k1, q1, a, 0, 0, 0);
        sc[j] = a;
    }
    float mx = -INFINITY;
#pragma unroll
    for (int j = 0; j < 9; ++j)
#pragma unroll
        for (int i = 0; i < 4; ++i) { const int dist = 128 - 16 * j + fr - 4 * s - i; const int kl = 16 * (w + j) + 4 * s + i;
            const bool ok = (dist >= 0) && (dist <= 128) && (b > 0 || kl >= 128);
            sc[j][i] = ok ? sc[j][i] : -INFINITY; mx = fmaxf(mx, sc[j][i]); }
    mx = fmaxf(mx, __shfl_xor(mx, 16)); mx = fmaxf(mx, __shfl_xor(mx, 32));
    float sum = 0.f;
#pragma unroll
    for (int j = 0; j < 9; ++j)
#pragma unroll
        for (int i = 0; i < 4; ++i) { const float e = __expf(sc[j][i] - mx); sc[j][i] = e; sum += e; }
    sum += __shfl_xor(sum, 16); sum += __shfl_xor(sum, 32);
    f32x4 o[4];
#pragma unroll
    for (int dt = 0; dt < 4; ++dt) o[dt] = (f32x4){0.f, 0.f, 0.f, 0.f};
#pragma unroll
    for (int j = 0; j < 9; ++j) {
        u32x2 pw; pw.x = cvt_pk_bf16(sc[j][0], sc[j][1]); pw.y = cvt_pk_bf16(sc[j][2], sc[j][3]);
        const bf16x4 pf = __builtin_bit_cast(bf16x4, pw);
#pragma unroll
        for (int dt = 0; dt < 4; ++dt) {
            const bf16x4 vf = *(const LAS bf16x4*)(lds + VT_OFF + (16 * dt + fr) * VT_STRIDE + (16 * (w + j) + 4 * s) * 2);
            o[dt] = __builtin_amdgcn_mfma_f32_16x16x16bf16_1k(vf, pf, o[dt], 0, 0, 0);
        }
    }
    const float inv = 1.0f / sum;
    bf16_t* og = (bf16_t*)(p.ws + WS_OG) + (size_t)g * M * 256 + qrow * 256 + h * 64;
#pragma unroll
    for (int dt = 0; dt < 4; ++dt) { u32x2 ww; ww.x = cvt_pk_bf16(o[dt][0] * inv, o[dt][1] * inv); ww.y = cvt_pk_bf16(o[dt][2] * inv, o[dt][3] * inv); *(u32x2*)(og + 16 * dt + 4 * s) = ww; }
    if (s == 0) ((float*)(p.ws + WS_LSE))[((size_t)g * M + qrow) * 4 + h] = mx + __logf(sum);
    __syncthreads();
}

__device__ __forceinline__ void attn_sample_unit(const Params& p, LAS unsigned char* lds, int unit) {
    const int lane = threadIdx.x & 63, w = threadIdx.x >> 6;
    LAS float* qs = (LAS float*)(lds + w * 1024);
    LAS float* ps = qs + 64;
    const int t = unit & 7, h = (unit >> 3) & 3, g = (unit >> 5) % 3, n = unit / 96;
    const int d = 1 << (2 * g), W = 128 * d;
    const size_t row = (size_t)MP + n * 8 + t;
    const bf16_t* qb = (const bf16_t*)(p.ws + WS_QKV) + (size_t)(3 * g) * M * 256;
    const bf16_t* kb = qb + (size_t)M * 256; const bf16_t* vb = kb + (size_t)M * 256;
    const float* cache = p.in[3 + g] + (size_t)n * W * 512;
    qs[lane] = bf1(qb[row * 256 + h * 64 + lane]);
    asm volatile("s_waitcnt lgkmcnt(0)" ::: "memory");
    float sv[3]; float mx = -INFINITY;
#pragma unroll
    for (int rr = 0; rr < 3; ++rr) {
        const int j = lane + 64 * rr; float a = -INFINITY;
        if (j <= 128) {
            const int idx = W + t - j * d; a = 0.f;
            if (idx >= W) { const bf16_t* kp = kb + ((size_t)MP + n * 8 + (idx - W)) * 256 + h * 64;
#pragma unroll
                for (int c = 0; c < 8; ++c) { const u32x4 v = ((const u32x4*)kp)[c]; const LAS f32x4* qq = (const LAS f32x4*)(qs + 8 * c); const f32x4 qa = qq[0], qc = qq[1];
                    a += bflo(v.x) * qa[0] + bfhi(v.x) * qa[1] + bflo(v.y) * qa[2] + bfhi(v.y) * qa[3] + bflo(v.z) * qc[0] + bfhi(v.z) * qc[1] + bflo(v.w) * qc[2] + bfhi(v.w) * qc[3]; }
            } else { const float* kp = cache + (size_t)idx * 512 + h * 64;
#pragma unroll
                for (int c = 0; c < 16; ++c) { const f32x4 v = ((const f32x4*)kp)[c]; const f32x4 qa = *(const LAS f32x4*)(qs + 4 * c); a += v[0] * qa[0] + v[1] * qa[1] + v[2] * qa[2] + v[3] * qa[3]; }
            }
        }
        sv[rr] = a; mx = fmaxf(mx, a);
    }
    mx = wave_max(mx);
    float sum = 0.f;
#pragma unroll
    for (int rr = 0; rr < 3; ++rr) { const int j = lane + 64 * rr; const float e = (j <= 128) ? __expf(sv[rr] - mx) : 0.f; sum += e; if (j < 132) ps[j] = e; }
    sum = wave_sum(sum);
    asm volatile("s_waitcnt lgkmcnt(0)" ::: "memory");
    const int ks = lane >> 4, dq = lane & 15;
    f32x4 o = {0.f, 0.f, 0.f, 0.f};
#pragma unroll 4
    for (int jj = 0; jj < 33; ++jj) {
        const int j = 4 * jj + ks;
        if (j <= 128) {
            const int idx = W + t - j * d; const float pj = ps[j]; f32x4 v;
            if (idx >= W) { const u32x2 vv = *(const u32x2*)(vb + ((size_t)MP + n * 8 + (idx - W)) * 256 + h * 64 + 4 * dq); v = (f32x4){bflo(vv.x), bfhi(vv.x), bflo(vv.y), bfhi(vv.y)}; }
            else v = *(const f32x4*)(cache + (size_t)idx * 512 + 256 + h * 64 + 4 * dq);
            o = o + v * pj;
        }
    }
#pragma unroll
    for (int i = 0; i < 4; ++i) { o[i] += __shfl_xor(o[i], 16); o[i] += __shfl_xor(o[i], 32); }
    const float inv = 1.0f / sum;
    if (ks == 0) { u32x2 ww; ww.x = cvt_pk_bf16(o[0] * inv, o[1] * inv); ww.y = cvt_pk_bf16(o[2] * inv, o[3] * inv);
        *(u32x2*)((bf16_t*)(p.ws + WS_OG) + (size_t)g * M * 256 + row * 256 + h * 64 + 4 * dq) = ww; }
    if (lane == 0) ((float*)(p.ws + WS_LSE))[((size_t)g * M + row) * 4 + h] = mx + __logf(sum);
    asm volatile("s_waitcnt lgkmcnt(0)" ::: "memory");
}

__device__ __forceinline__ void load_u8(const bf16_t* zc, size_t row, int c, float (&u)[8]) {
    const u32x4 a = *(const u32x4*)(zc + row * 1536 + 512 + c), b = *(const u32x4*)(zc + row * 1536 + 1024 + c);
    u[0] = bflo(a.x) * bflo(b.x); u[1] = bfhi(a.x) * bfhi(b.x); u[2] = bflo(a.y) * bflo(b.y); u[3] = bfhi(a.y) * bfhi(b.y);
    u[4] = bflo(a.z) * bflo(b.z); u[5] = bfhi(a.z) * bfhi(b.z); u[6] = bflo(a.w) * bflo(b.w); u[7] = bfhi(a.w) * bfhi(b.w);
}
__device__ __forceinline__ void phase_conv(const Params& p) {
    const bf16_t* zc = (const bf16_t*)(p.ws + WS_ZC); bf16_t* yc = (bf16_t*)(p.ws + WS_YC);
    const float* cw = p.in[8]; const float* st = p.in[2];
    const size_t gt = (size_t)blockIdx.x * NT + threadIdx.x, GT = (size_t)gridDim.x * NT;
    for (size_t i = gt; i < (size_t)M * 64; i += GT) {
        const size_t row = i >> 6; const int c = (int)(i & 63) * 8;
        float u0[8], u1[8], u2[8];
        load_u8(zc, row, c, u2);
        int tpos; int nb = 0; const bool prm = row < MP;
        if (prm) tpos = (int)(row & 4095); else { const int rs = (int)(row - MP); nb = rs >> 3; tpos = rs & 7; }
        if (tpos >= 1) load_u8(zc, row - 1, c, u1);
        else if (prm) {
#pragma unroll
            for (int e = 0; e < 8; ++e) u1[e] = 0.f; }
        else { const f32x4 a = *(const f32x4*)(st + ((size_t)nb * 2 + 1) * 512 + c), b = *(const f32x4*)(st + ((size_t)nb * 2 + 1) * 512 + c + 4);
            u1[0] = a[0]; u1[1] = a[1]; u1[2] = a[2]; u1[3] = a[3]; u1[4] = b[0]; u1[5] = b[1]; u1[6] = b[2]; u1[7] = b[3]; }
        if (tpos >= 2) load_u8(zc, row - 2, c, u0);
        else if (prm) {
#pragma unroll
            for (int e = 0; e < 8; ++e) u0[e] = 0.f; }
        else { const int si = tpos;
            const f32x4 a = *(const f32x4*)(st + ((size_t)nb * 2 + si) * 512 + c), b = *(const f32x4*)(st + ((size_t)nb * 2 + si) * 512 + c + 4);
            u0[0] = a[0]; u0[1] = a[1]; u0[2] = a[2]; u0[3] = a[3]; u0[4] = b[0]; u0[5] = b[1]; u0[6] = b[2]; u0[7] = b[3]; }
        const u32x4 bb = *(const u32x4*)(zc + row * 1536 + c);
        const float Bv[8] = {bflo(bb.x), bfhi(bb.x), bflo(bb.y), bfhi(bb.y), bflo(bb.z), bfhi(bb.z), bflo(bb.w), bfhi(bb.w)};
        float y[8];
#pragma unroll
        for (int e = 0; e < 8; ++e) y[e] = Bv[e] * (cw[c + e] * u0[e] + cw[512 + c + e] * u1[e] + cw[1024 + c + e] * u2[e]);
        u32x4 o; o.x = cvt_pk_bf16(y[0], y[1]); o.y = cvt_pk_bf16(y[2], y[3]); o.z = cvt_pk_bf16(y[4], y[5]); o.w = cvt_pk_bf16(y[6], y[7]);
        *(u32x4*)(yc + row * 512 + c) = o;
        float* so = nullptr;
        if (prm) { if (tpos >= SEQ - 2) so = p.out + O_CP + ((size_t)(row >> 12) * 2 + (tpos - (SEQ - 2))) * 512 + c; }
        else if (tpos >= 6) so = p.out + O_CS + ((size_t)nb * 2 + (tpos - 6)) * 512 + c;
        if (so) { *(f32x4*)so = (f32x4){u2[0], u2[1], u2[2], u2[3]}; *(f32x4*)(so + 4) = (f32x4){u2[4], u2[5], u2[6], u2[7]}; }
    }
}

__device__ __forceinline__ void phase_copy(const Params& p) {
    const size_t gt = (size_t)blockIdx.x * NT + threadIdx.x, GT = (size_t)gridDim.x * NT;
#pragma unroll 1
    for (int g = 0; g < 3; ++g) {
        const int W = 128 << (2 * g);
        const f32x4* src = (const f32x4*)p.in[3 + g]; f32x4* dst = (f32x4*)(p.out + (g == 0 ? O_KVS0 : (g == 1 ? O_KVS1 : O_KVS2)));
        const size_t per = (size_t)(W - 8) * 128, full = (size_t)W * 128, tot = per * 128;
        for (size_t i = gt; i < tot; i += GT) { const size_t n = i / per, r = i - n * per;
            const f32x4 v = __builtin_nontemporal_load(src + n * full + 1024 + r);
            __builtin_nontemporal_store(v, dst + n * full + r); }
    }
}

__device__ __forceinline__ void phase_merge(const Params& p) {
    const bf16_t* og = (const bf16_t*)(p.ws + WS_OG); const float* lse = (const float*)(p.ws + WS_LSE); bf16_t* ya = (bf16_t*)(p.ws + WS_YA);
    const size_t gt = (size_t)blockIdx.x * NT + threadIdx.x, GT = (size_t)gridDim.x * NT;
    for (size_t i = gt; i < (size_t)M * 32; i += GT) {
        const size_t row = i >> 5; const int c = (int)(i & 31) * 8, h = c >> 6;
        const float l0 = lse[row * 4 + h], l1 = lse[((size_t)M + row) * 4 + h], l2 = lse[((size_t)2 * M + row) * 4 + h];
        const float mx = fmaxf(l0, fmaxf(l1, l2)); float w0 = __expf(l0 - mx), w1 = __expf(l1 - mx), w2 = __expf(l2 - mx); const float inv = 1.0f / (w0 + w1 + w2); w0 *= inv; w1 *= inv; w2 *= inv;
        const u32x4 a = *(const u32x4*)(og + row * 256 + c), b = *(const u32x4*)(og + ((size_t)M + row) * 256 + c), cc = *(const u32x4*)(og + ((size_t)2 * M + row) * 256 + c);
        u32x4 o;
        o.x = cvt_pk_bf16(w0 * bflo(a.x) + w1 * bflo(b.x) + w2 * bflo(cc.x), w0 * bfhi(a.x) + w1 * bfhi(b.x) + w2 * bfhi(cc.x));
        o.y = cvt_pk_bf16(w0 * bflo(a.y) + w1 * bflo(b.y) + w2 * bflo(cc.y), w0 * bfhi(a.y) + w1 * bfhi(b.y) + w2 * bfhi(cc.y));
        o.z = cvt_pk_bf16(w0 * bflo(a.z) + w1 * bflo(b.z) + w2 * bflo(cc.z), w0 * bfhi(a.z) + w1 * bfhi(b.z) + w2 * bfhi(cc.z));
        o.w = cvt_pk_bf16(w0 * bflo(a.w) + w1 * bflo(b.w) + w2 * bflo(cc.w), w0 * bfhi(a.w) + w1 * bfhi(b.w) + w2 * bfhi(cc.w));
        *(u32x4*)(ya + row * 256 + c) = o;
    }
}

template <bool FINAL>
__device__ __forceinline__ void phase_ln(const Params& p, const float* gam, const float* bet) {
    const int lane = threadIdx.x & 63, w = threadIdx.x >> 6;
    const float* pre = (const float*)(p.ws + WS_PRE);
    f32x4 gv[4], bv[4];
#pragma unroll
    for (int j = 0; j < 4; ++j) { gv[j] = ((const f32x4*)gam)[lane + 64 * j]; bv[j] = ((const f32x4*)bet)[lane + 64 * j]; }
    for (int row = blockIdx.x * 8 + w; row < M; row += gridDim.x * 8) {
        const f32x4* xr = (const f32x4*)(pre + (size_t)row * 1024) + lane;
        f32x4 v[4]; float s = 0.f;
#pragma unroll
        for (int j = 0; j < 4; ++j) { v[j] = xr[64 * j]; s += (v[j][0] + v[j][1]) + (v[j][2] + v[j][3]); }
        const float mean = wave_sum(s) * (1.f / 1024.f); float s2 = 0.f;
#pragma unroll
        for (int j = 0; j < 4; ++j) { v[j] = v[j] - mean; s2 += (v[j][0] * v[j][0] + v[j][1] * v[j][1]) + (v[j][2] * v[j][2] + v[j][3] * v[j][3]); }
        const float rstd = 1.f / sqrtf(wave_sum(s2) * (1.f / 1024.f) + LN_EPS);
#pragma unroll
        for (int j = 0; j < 4; ++j) { const f32x4 y = v[j] * rstd * gv[j] + bv[j];
            if (FINAL) { ((f32x4*)(p.out + (size_t)row * 1024))[lane + 64 * j] = y; }
            else { ((f32x4*)(p.ws + WS_X1F + (size_t)row * 4096))[lane + 64 * j] = y;
                u32x2 ww; ww.x = cvt_pk_bf16(y[0], y[1]); ww.y = cvt_pk_bf16(y[2], y[3]); ((u32x2*)(p.ws + WS_X1B + (size_t)row * 2048))[lane + 64 * j] = ww; } }
    }
}

constexpr int N_PHASES = 10;
__global__ void __launch_bounds__(NT, 2) fwd_kernel(Params p) {
    extern __shared__ __attribute__((aligned(16))) unsigned char smem[];
    LAS unsigned char* lds = (LAS unsigned char*)smem;
    unsigned char* ws = p.ws;
    const int G = gridDim.x, bx = blockIdx.x;
#if MK_MULTI
#define SYNC() do {} while (0)
#else
    cg::grid_group grid = cg::this_grid();
#define SYNC() do { __builtin_amdgcn_fence(__ATOMIC_RELEASE, "agent"); asm volatile("s_waitcnt vmcnt(0) lgkmcnt(0)" ::: "memory"); grid.sync(); \
        __builtin_amdgcn_fence(__ATOMIC_ACQUIRE, "agent"); asm volatile("s_waitcnt vmcnt(0)" ::: "memory"); } while (0)
#endif
#define IN(k) (p.ph_lo <= (k) && (k) < p.ph_hi)
    if (IN(0)) { phase_prep(p, lds); __syncthreads(); SYNC(); }
    if (IN(1)) {
        pg8::Gemm g{(const bf16_t*)(ws + WS_XB), (const bf16_t*)(ws + WS_WIN), M, NIN, D}; pg8::StaticOrder S; S.init(M, NIN, G, bx);
        Epi1 E{(bf16_t*)(ws + WS_ZC), (bf16_t*)(ws + WS_QKV), (bf16_t*)(ws + WS_GATE), p.in[7], (const float*)(ws + WS_ROPE), p.out};
        pg8::gemm_phase<Epi1, pg8::StaticOrder, true, true>(lds, g, S, E);
        SYNC();
    }
    if (IN(2)) {
        for (int it = bx; it < 1536; it += G) attn_prompt_item(p, lds, it);
        for (int it = bx; it < 1536; it += G) attn_sample_unit(p, lds, it * 8 + (threadIdx.x >> 6));
        phase_conv(p);
        phase_copy(p);
        __syncthreads();
        SYNC();
    }
    if (IN(3)) { phase_merge(p); SYNC(); }
    if (IN(4)) {
        { pg8::Gemm g{(const bf16_t*)(ws + WS_YC), (const bf16_t*)(ws + WS_WC), M, D, DC}; pg8::StaticOrder S; S.init(M, D, G, bx);
          Epi3 E{(bf16_t*)(ws + WS_MIX), (const bf16_t*)(ws + WS_GATE), 0};
          pg8::gemm_phase<Epi3, pg8::StaticOrder, true, true>(lds, g, S, E); }
        { pg8::Gemm g{(const bf16_t*)(ws + WS_YA), (const bf16_t*)(ws + WS_WA), M, D, 256}; pg8::StaticOrder S; S.init(M, D, G, bx);
          Epi3 E{(bf16_t*)(ws + WS_MIX), (const bf16_t*)(ws + WS_GATE), 1};
          pg8::gemm_phase<Epi3, pg8::StaticOrder, true, true>(lds, g, S, E); }
        SYNC();
    }
    if (IN(5)) {
        pg8::Gemm g{(const bf16_t*)(ws + WS_MIX), (const bf16_t*)(ws + WS_WO), M, D, D}; pg8::StaticOrder S; S.init(M, D, G, bx);
        EpiRes E{p.in[0], p.in[1] - (size_t)MP * D, (float*)(ws + WS_PRE)};
        pg8::gemm_phase<EpiRes, pg8::StaticOrder, true, true>(lds, g, S, E);
        SYNC();
    }
    if (IN(6)) { phase_ln<false>(p, p.in[12], p.in[13]); SYNC(); }
    if (IN(7)) {
        pg8::Gemm g{(const bf16_t*)(ws + WS_X1B), (const bf16_t*)(ws + WS_WUP), M, FF, D}; pg8::StaticOrder S; S.init(M, FF, G, bx);
        EpiHid E{(bf16_t*)(ws + WS_HID)};
        pg8::gemm_phase<EpiHid, pg8::StaticOrder, true, true>(lds, g, S, E);
        SYNC();
    }
    if (IN(8)) {
        pg8::Gemm g{(const bf16_t*)(ws + WS_HID), (const bf16_t*)(ws + WS_WDN), M, D, FF}; pg8::StaticOrder S; S.init(M, D, G, bx);
        EpiRes E{(const float*)(ws + WS_X1F), (const float*)(ws + WS_X1F), (float*)(ws + WS_PRE)};
        pg8::gemm_phase<EpiRes, pg8::StaticOrder, true, true>(lds, g, S, E);
        SYNC();
    }
    if (IN(9)) { phase_ln<true>(p, p.in[16], p.in[17]); }
#ifdef DUMP
    if (IN(20)) { const size_t gt = (size_t)blockIdx.x * NT + threadIdx.x, GT = (size_t)gridDim.x * NT;
        for (size_t i = gt; i < (size_t)M * 1024; i += GT) { const size_t row = i >> 10, c = i & 1023; float v;
            if (DUMP == 1) { v = bf1(((const bf16_t*)(ws + WS_GATE))[row * 2048 + c]) + bf1(((const bf16_t*)(ws + WS_GATE))[row * 2048 + 1024 + c]) + bf1(((const bf16_t*)(ws + WS_ZC))[row * 1536 + c]) + bf1(((const bf16_t*)(ws + WS_ZC))[row * 1536 + 512 + c]);
                for (int sl = 0; sl < 9; ++sl) v += (float)(sl + 1) * bf1(((const bf16_t*)(ws + WS_QKV))[((size_t)sl * M + row) * 256 + (c & 255)]); }
            else if (DUMP == 2) { v = bf1(((const bf16_t*)(ws + WS_YC))[row * 512 + (c & 511)]);
                for (int sl = 0; sl < 3; ++sl) v += (float)(sl + 1) * bf1(((const bf16_t*)(ws + WS_OG))[((size_t)sl * M + row) * 256 + (c & 255)]) + ((const float*)(ws + WS_LSE))[((size_t)sl * M + row) * 4 + (c & 3)]; }
            else if (DUMP == 3) v = bf1(((const bf16_t*)(ws + WS_YA))[row * 256 + (c & 255)]);
            else if (DUMP == 4) v = bf1(((const bf16_t*)(ws + WS_MIX))[i]);
            else if (DUMP == 5 || DUMP == 8) v = ((const float*)(ws + WS_PRE))[i];
            else if (DUMP == 6) v = ((const float*)(ws + WS_X1F))[i];
            else { const bf16_t* hp = (const bf16_t*)(ws + WS_HID) + row * 4096 + c; v = bf1(hp[0]) + bf1(hp[1024]) + bf1(hp[2048]) + bf1(hp[3072]); }
            p.out[i] = v; } }
#endif
#undef IN
#undef SYNC
}

extern "C" void kernel_launch(void* const* d_in, const int* in_sizes, int n_in, void* d_out, int out_size, void* d_ws, size_t ws_size, hipStream_t stream) {
    static int grid = 0;
    if (grid == 0) {
        if (n_in != 18 || (size_t)out_size != O_END || ws_size < WS_END) { fprintf(stderr, "kernel_launch: unexpected shapes (n_in %d out %d ws %zu need %zu)\n", n_in, out_size, ws_size, (size_t)WS_END); grid = -1; return; }
        int dev = 0, cus = 0, per_cu = 0;
        (void)hipGetDevice(&dev); (void)hipDeviceGetAttribute(&cus, hipDeviceAttributeMultiprocessorCount, dev);
        if (hipFuncSetAttribute((const void*)fwd_kernel, hipFuncAttributeMaxDynamicSharedMemorySize, LDS_BYTES) != hipSuccess) { fprintf(stderr, "kernel_launch: hipFuncSetAttribute failed\n"); grid = -1; return; }
        if (hipOccupancyMaxActiveBlocksPerMultiprocessor(&per_cu, (const void*)fwd_kernel, NT, LDS_BYTES) != hipSuccess || per_cu < 1) { fprintf(stderr, "kernel_launch: occupancy query says %d\n", per_cu); per_cu = 1; }
        (void)hipGetLastError();
        grid = cus * 1;
    }
    if (grid < 0) return;
    Params p{};
    for (int i = 0; i < 18; ++i) p.in[i] = (const float*)d_in[i];
    p.out = (float*)d_out; p.ws = (unsigned char*)d_ws;
#if MK_MULTI
#ifdef DUMP
    for (int k = 0; k <= DUMP; ++k) { p.ph_lo = k; p.ph_hi = k + 1; hipLaunchKernelGGL(fwd_kernel, dim3(grid), dim3(NT), LDS_BYTES, stream, p); }
    p.ph_lo = 20; p.ph_hi = 21; hipLaunchKernelGGL(fwd_kernel, dim3(grid), dim3(NT), LDS_BYTES, stream, p);
#else
    for (int k = 0; k < N_PHASES; ++k) { p.ph_lo = k; p.ph_hi = k + 1; hipLaunchKernelGGL(fwd_kernel, dim3(grid), dim3(NT), LDS_BYTES, stream, p); }
#endif
#else
    p.ph_lo = 0; p.ph_hi = N_PHASES;
    void* args[] = {&p};
    hipError_t e = hipLaunchCooperativeKernel((const void*)fwd_kernel, dim3(grid), dim3(NT), args, LDS_BYTES, stream);
    if (e != hipSuccess) fprintf(stderr, "cooperative launch failed: %s (grid %d)\n", hipGetErrorString(e), grid);
#endif
}
```

```cpp
#include <hip/hip_runtime.h>
#include <hip/hip_cooperative_groups.h>
#include <cstdio>
#include <cstdint>
namespace cg = cooperative_groups;

#ifndef MK_MULTI
#define MK_MULTI 0
#define DUP -1
#endif

namespace pg8 {
#define PG8_LAS __attribute__((address_space(3)))
typedef unsigned short bf16_t;
typedef short bf16x8 __attribute__((ext_vector_type(8)));
typedef float f32x4 __attribute__((ext_vector_type(4)));
typedef unsigned u32x4 __attribute__((ext_vector_type(4)));
typedef unsigned u32x2 __attribute__((ext_vector_type(2)));
constexpr int BM = 256, BK = 64, HALF = 128, HTB = HALF * BK * 2, STAGE_BYTES = 8 * HTB, NXCD = 8, WGM = 8;

__host__ __device__ __forceinline__ int lds_byte(int r, int c) { const int st = (r >> 4) * 2 + (c >> 5), rr = r & 15, cc = c & 31, ob = rr * 64 + cc * 2; return st * 1024 + (ob ^ (((ob >> 9) & 1) << 5)); }
__host__ __device__ __forceinline__ void stage_rc(int b, int& R, int& C) { const int st = b / 1024, sb = b % 1024, swz = sb ^ (((sb >> 9) & 1) << 5); R = (st >> 1) * 16 + swz / 64; C = (st & 1) * 32 + (swz % 64) / 2; }
__host__ __device__ __forceinline__ int perm32(int rho) { const int n = rho >> 4, i = rho & 15; return 8 * (i >> 2) + 4 * n + (i & 3); }
__host__ __device__ __forceinline__ int swap45(int v) { return (v & 15) | ((v & 16) << 1) | ((v & 32) >> 1); }

struct Unit { int pm, pn; };
struct Gemm { const bf16_t* A; const bf16_t* Bt; int M, N, K; };

struct StaticOrder {
    int nM, nN, nwg, G, c;
    __host__ __device__ void init(int M, int N, int G_, int c_) { nM = M / BM; nN = N / BM; nwg = nM * nN; G = G_; c = c_; }
    __host__ __device__ bool next(int i, Unit& u) const {
        const long L = (long)i * G + c; if (L >= nwg) return false;
        int wgid = (int)L; { const int q = nwg / NXCD, r = nwg % NXCD, xcd = wgid % NXCD, off = wgid / NXCD; wgid = (xcd < r ? xcd * (q + 1) : r * (q + 1) + (xcd - r) * q) + off; }
        const int nig = WGM * nN, gid = wgid / nig, fm = gid * WGM, gsz = (nM - fm) < WGM ? (nM - fm) : WGM;
        u.pm = fm + ((wgid % nig) % gsz); u.pn = (wgid % nig) / gsz; return true;
    }
    __device__ __forceinline__ void a_ready(const Unit&) const {}
    __device__ __forceinline__ void done(const Unit&) const {}
};

typedef float cvt_f32x2 __attribute__((ext_vector_type(2)));
typedef __bf16 cvt_bf16x2 __attribute__((ext_vector_type(2)));
__device__ __forceinline__ unsigned cvt_pk_bf16(float lo, float hi) { const cvt_f32x2 v = {lo, hi}; const cvt_bf16x2 b = __builtin_convertvector(v, cvt_bf16x2); return __builtin_bit_cast(unsigned, b); }

template <class Epi, class Sched, bool ALIGN_EPI = false, bool SP2 = false>
__device__ __forceinline__ void gemm_phase(PG8_LAS unsigned char* lds, const Gemm g, const Sched& S, const Epi& E) {
    const int tid = threadIdx.x, wid = __builtin_amdgcn_readfirstlane(tid >> 6), lane = tid & 63, wr = wid >> 2, wc = wid & 3, fr = lane & 15, fq = lane >> 4;
    const int K = g.K, nt = K / BK;
    unsigned voffA[2], voffB[2];
#pragma unroll
    for (int i = 0; i < 2; ++i) { int R, C; stage_rc(tid * 16 + i * 8192, R, C);
        const int Rb = Epi::PERM == 1 ? ((R & ~31) + perm32(R & 31)) : (Epi::PERM == 2 ? ((R & ~63) + swap45(R & 63)) : R);
        voffA[i] = (unsigned)(R * K + C) * 2u; voffB[i] = (unsigned)(Rb * K + C) * 2u; }
    const size_t kstep = (size_t)(BK * 2);
    const size_t hstep = (size_t)HALF * K * 2;
    const size_t tstep = 2 * hstep;
    const unsigned ldsw = (unsigned)wid * 1024u;
    const int aoff = lds_byte(wr * 64 + fr, fq * 8), boff = lds_byte(wc * 32 + fr, fq * 8);
#define PG8_SA(b, h) (((b) * 2 + (h)) * HTB)
#define PG8_SB(b, h) ((4 + (b) * 2 + (h)) * HTB)
#define PG8_STAGE(bufoff, gbase, voff) do { _Pragma("unroll") for (int _i = 0; _i < 2; ++_i) \
        __builtin_amdgcn_global_load_lds((const unsigned*)((const char*)(gbase) + (voff)[_i]), (PG8_LAS unsigned*)(lds + (bufoff) + ldsw + _i * 8192), 16, 0, 0); } while (0)
#define PG8_LDA(dst, b, h) do { _Pragma("unroll") for (int m = 0; m < 4; ++m) _Pragma("unroll") for (int k = 0; k < 2; ++k) dst[m][k] = *(const PG8_LAS bf16x8*)(lds + PG8_SA(b, h) + aoff + m * 2048 + k * 1024); } while (0)
#define PG8_LDB(dst, b, h) do { _Pragma("unroll") for (int n = 0; n < 2; ++n) _Pragma("unroll") for (int k = 0; k < 2; ++k) dst[n][k] = *(const PG8_LAS bf16x8*)(lds + PG8_SB(b, h) + boff + n * 2048 + k * 1024); } while (0)
#define PG8_MMA(ai, bj, At, Bt) do { __builtin_amdgcn_s_setprio(1); _Pragma("unroll") for (int m = 0; m < 4; ++m) _Pragma("unroll") for (int n = 0; n < 2; ++n) _Pragma("unroll") for (int k = 0; k < 2; ++k) \
        acc[ai][bj][m][n] = __builtin_amdgcn_mfma_f32_16x16x32_bf16(Bt[n][k], At[m][k], acc[ai][bj][m][n], 0, 0, 0); __builtin_amdgcn_s_setprio(0); } while (0)
#define PG8_WAIT_V(n) asm volatile("s_waitcnt vmcnt(" #n ")" ::: "memory")
#define PG8_WAIT_L(n) asm volatile("s_waitcnt lgkmcnt(" #n ")" ::: "memory")
#define PG8_BAR __builtin_amdgcn_s_barrier()
#define PG8_SCHED __builtin_amdgcn_sched_barrier(0)
    Unit cur, nxt; int ui = 0;
    if (!S.next(0, cur)) return;
    f32x4 acc[2][2][4][2];
#pragma unroll
    for (int a = 0; a < 2; ++a)
#pragma unroll
        for (int b = 0; b < 2; ++b)
#pragma unroll
            for (int m = 0; m < 4; ++m)
#pragma unroll
                for (int n = 0; n < 2; ++n) acc[a][b][m][n] = (f32x4){0.f, 0.f, 0.f, 0.f};
    bf16x8 At[4][2], B0[2][2], B1[2][2];
    const char* cA = (const char*)g.A + (size_t)cur.pm * tstep; const char* cB = (const char*)g.Bt + (size_t)cur.pn * tstep;
    S.a_ready(cur);
    if constexpr (SP2) {
        PG8_STAGE(PG8_SB(0, 0), cB, voffB); PG8_STAGE(PG8_SB(0, 1), cB + hstep, voffB); PG8_STAGE(PG8_SA(0, 0), cA, voffA); PG8_STAGE(PG8_SA(0, 1), cA + hstep, voffA);
        if (wr == 1) PG8_BAR;
        PG8_WAIT_V(2); PG8_BAR;
        PG8_STAGE(PG8_SB(1, 0), cB + kstep, voffB); PG8_STAGE(PG8_SA(1, 0), cA + kstep, voffA); PG8_STAGE(PG8_SB(1, 1), cB + hstep + kstep, voffB);
        PG8_WAIT_V(6); PG8_BAR;
    } else {
        PG8_STAGE(PG8_SB(0, 0), cB, voffB); PG8_STAGE(PG8_SA(0, 0), cA, voffA); PG8_STAGE(PG8_SB(0, 1), cB + hstep, voffB); PG8_STAGE(PG8_SA(0, 1), cA + hstep, voffA);
        if (wr == 1) PG8_BAR;
        PG8_WAIT_V(4); PG8_BAR;
        PG8_STAGE(PG8_SB(1, 0), cB + kstep, voffB); PG8_STAGE(PG8_SA(1, 0), cA + kstep, voffA); PG8_STAGE(PG8_SB(1, 1), cB + hstep + kstep, voffB);
        PG8_WAIT_V(6); PG8_BAR;
    }
    for (;;) {
        const bool has_next = S.next(ui + 1, nxt);
        const char* nA = has_next ? (const char*)g.A + (size_t)nxt.pm * tstep : cA; const char* nB = has_next ? (const char*)g.Bt + (size_t)nxt.pn * tstep : cB;
        for (int t = 0; t < nt; t += 2) {
            const bool last = (t == nt - 2);
            const char* a1 = cA + (size_t)(t + 1) * kstep;
            const char* a2 = last ? nA : cA + (size_t)(t + 2) * kstep; const char* b2 = last ? nB : cB + (size_t)(t + 2) * kstep;
            const char* a3 = a2 + kstep; const char* b3 = b2 + kstep;
            if (last && has_next) S.a_ready(nxt);
            if constexpr (SP2) {
            PG8_LDB(B0, 0, 0); PG8_LDB(B1, 0, 1); PG8_SCHED; PG8_LDA(At, 0, 0); PG8_STAGE(PG8_SA(1, 1), a1 + hstep, voffA);
            PG8_WAIT_V(8); PG8_WAIT_L(0); PG8_BAR; PG8_MMA(0, 0, At, B0); PG8_MMA(0, 1, At, B1); PG8_BAR; PG8_SCHED;
            PG8_LDA(At, 0, 1); PG8_STAGE(PG8_SB(0, 0), b2, voffB); PG8_STAGE(PG8_SB(0, 1), b2 + hstep, voffB); PG8_STAGE(PG8_SA(0, 0), a2, voffA);
            PG8_WAIT_V(8); PG8_WAIT_L(0); PG8_BAR; PG8_MMA(1, 0, At, B0); PG8_MMA(1, 1, At, B1); PG8_BAR; PG8_SCHED;
            PG8_LDB(B0, 1, 0); PG8_LDB(B1, 1, 1); PG8_SCHED; PG8_LDA(At, 1, 0); PG8_STAGE(PG8_SA(0, 1), a2 + hstep, voffA);
            PG8_WAIT_V(8); PG8_WAIT_L(0); PG8_BAR; PG8_MMA(0, 0, At, B0); PG8_MMA(0, 1, At, B1); PG8_BAR; PG8_SCHED;
            PG8_LDA(At, 1, 1); PG8_STAGE(PG8_SB(1, 0), b3, voffB); PG8_STAGE(PG8_SB(1, 1), b3 + hstep, voffB); PG8_STAGE(PG8_SA(1, 0), a3, voffA);
            PG8_WAIT_V(8); PG8_WAIT_L(0); PG8_BAR; PG8_MMA(1, 0, At, B0); PG8_MMA(1, 1, At, B1); PG8_BAR; PG8_SCHED;
            } else {
            PG8_LDB(B0, 0, 0); PG8_SCHED; PG8_LDA(At, 0, 0); PG8_STAGE(PG8_SA(1, 1), a1 + hstep, voffA);
            PG8_WAIT_L(8); PG8_BAR; PG8_WAIT_L(0); PG8_MMA(0, 0, At, B0); PG8_BAR; PG8_SCHED;
            PG8_LDB(B1, 0, 1); PG8_STAGE(PG8_SB(0, 0), b2, voffB);
            PG8_BAR; PG8_WAIT_L(0); PG8_MMA(0, 1, At, B1); PG8_BAR;
            PG8_LDA(At, 0, 1); PG8_STAGE(PG8_SA(0, 0), a2, voffA);
            PG8_BAR; PG8_WAIT_L(0); PG8_MMA(1, 0, At, B0); PG8_BAR; PG8_SCHED;
            PG8_STAGE(PG8_SB(0, 1), b2 + hstep, voffB);
            PG8_WAIT_V(6); PG8_BAR; PG8_MMA(1, 1, At, B1); PG8_BAR;
            PG8_LDB(B0, 1, 0); PG8_SCHED; PG8_LDA(At, 1, 0); PG8_STAGE(PG8_SA(0, 1), a2 + hstep, voffA);
            PG8_WAIT_L(8); PG8_BAR; PG8_WAIT_L(0); PG8_MMA(0, 0, At, B0); PG8_BAR; PG8_SCHED;
            PG8_LDB(B1, 1, 1); PG8_STAGE(PG8_SB(1, 0), b3, voffB);
            PG8_BAR; PG8_WAIT_L(0); PG8_MMA(0, 1, At, B1); PG8_BAR;
            PG8_LDA(At, 1, 1); PG8_STAGE(PG8_SA(1, 0), a3, voffA);
            PG8_BAR; PG8_WAIT_L(0); PG8_MMA(1, 0, At, B0); PG8_BAR; PG8_SCHED;
            PG8_STAGE(PG8_SB(1, 1), b3 + hstep, voffB);
            PG8_WAIT_V(6); PG8_BAR; PG8_MMA(1, 1, At, B1); PG8_BAR;
            }
        }
        if constexpr (ALIGN_EPI) { if (wr == 0) PG8_BAR; }
        E(acc, cur, wr, wc, fr, fq);
        if (!has_next) break;
#pragma unroll
        for (int a = 0; a < 2; ++a)
#pragma unroll
            for (int b = 0; b < 2; ++b)
#pragma unroll
                for (int m = 0; m < 4; ++m)
#pragma unroll
                    for (int n = 0; n < 2; ++n) acc[a][b][m][n] = (f32x4){0.f, 0.f, 0.f, 0.f};
        cur = nxt; cA = nA; cB = nB; ++ui;
        if constexpr (ALIGN_EPI) { if (wr == 1) PG8_BAR; }
    }
    PG8_WAIT_V(0);
    if constexpr (!ALIGN_EPI) { if (wr == 0) PG8_BAR; }
    PG8_BAR;
#undef PG8_SA
#undef PG8_SB
#undef PG8_STAGE
#undef PG8_LDA
#undef PG8_LDB
#undef PG8_MMA
#undef PG8_WAIT_V
#undef PG8_WAIT_L
#undef PG8_BAR
#undef PG8_SCHED
}
}

using pg8::bf16_t; using pg8::f32x4; using pg8::u32x4; using pg8::u32x2; using pg8::bf16x8; using pg8::cvt_pk_bf16;
#define LAS __attribute__((address_space(3)))
typedef short bf16x4 __attribute__((ext_vector_type(4)));
typedef float f32x2 __attribute__((ext_vector_type(2)));
constexpr int D = 1024, SEQ = 4096, MP = 16384, MS = 1024, M = MP + MS, NIN = 5888, DC = 512, FF = 4096;
constexpr int NT = 512;
constexpr float ALPHA = 1.189207115002721f;
constexpr float LN_EPS = 1e-5f;
constexpr int LDS_BYTES = pg8::STAGE_BYTES + 16;

constexpr size_t WS_XB = 0;
constexpr size_t WS_WIN = WS_XB + (size_t)M * D * 2;
constexpr size_t WS_WC = WS_WIN + (size_t)NIN * D * 2;
constexpr size_t WS_WA = WS_WC + (size_t)1024 * 512 * 2;
constexpr size_t WS_WO = WS_WA + (size_t)1024 * 256 * 2;
constexpr size_t WS_WUP = WS_WO + (size_t)1024 * 1024 * 2;
constexpr size_t WS_WDN = WS_WUP + (size_t)4096 * 1024 * 2;
constexpr size_t WS_ROPE = WS_WDN + (size_t)4096 * 1024 * 2;
constexpr size_t WS_ZC = WS_ROPE + (size_t)4096 * 32 * 8;
constexpr size_t WS_QKV = WS_ZC + (size_t)M * 1536 * 2;
constexpr size_t WS_GATE = WS_QKV + (size_t)9 * M * 256 * 2;
constexpr size_t WS_OG = WS_GATE + (size_t)M * 2048 * 2;
constexpr size_t WS_LSE = WS_OG + (size_t)3 * M * 256 * 2;
constexpr size_t WS_YC = WS_LSE + (size_t)3 * M * 4 * 4;
constexpr size_t WS_YA = WS_YC + (size_t)M * 512 * 2;
constexpr size_t WS_MIX = WS_YA + (size_t)M * 256 * 2;
constexpr size_t WS_PRE = WS_MIX + (size_t)M * 1024 * 2;
constexpr size_t WS_X1F = WS_PRE + (size_t)M * 1024 * 4;
constexpr size_t WS_X1B = WS_X1F + (size_t)M * 1024 * 4;
constexpr size_t WS_HID = WS_X1B + (size_t)M * 1024 * 2;
constexpr size_t WS_BAR = WS_HID + (size_t)M * 4096 * 2;
constexpr size_t WS_END = WS_BAR + 16384;

constexpr size_t O_YP = 0;
constexpr size_t O_YS = O_YP + (size_t)MP * D;
constexpr size_t O_CP = O_YS + (size_t)MS * D;
constexpr size_t O_KVP0 = O_CP + 4 * 2 * 512;
constexpr size_t O_KVP1 = O_KVP0 + (size_t)4 * 128 * 512;
constexpr size_t O_KVP2 = O_KVP1 + (size_t)4 * 512 * 512;
constexpr size_t O_CS = O_KVP2 + (size_t)4 * 2048 * 512;
constexpr size_t O_KVS0 = O_CS + (size_t)128 * 2 * 512;
constexpr size_t O_KVS1 = O_KVS0 + (size_t)128 * 128 * 512;
constexpr size_t O_KVS2 = O_KVS1 + (size_t)128 * 512 * 512;
constexpr size_t O_END = O_KVS2 + (size_t)128 * 2048 * 512;

struct Params { const float* in[18]; float* out; unsigned char* ws; int ph_lo, ph_hi; };

__device__ __forceinline__ float bflo(unsigned w) { return __builtin_bit_cast(float, w << 16); }
__device__ __forceinline__ float bfhi(unsigned w) { return __builtin_bit_cast(float, w & 0xffff0000u); }
__device__ __forceinline__ float bf1(bf16_t h) { return __builtin_bit_cast(float, (unsigned)h << 16); }
__device__ __forceinline__ float wave_sum(float v) {
#pragma unroll
    for (int o = 1; o < 64; o <<= 1) v += __shfl_xor(v, o);
    return v;
}
__device__ __forceinline__ float wave_max(float v) {
#pragma unroll
    for (int o = 1; o < 64; o <<= 1) v = fmaxf(v, __shfl_xor(v, o));
    return v;
}

using pg8::Unit;
struct Epi1 {
    static constexpr int PERM = 2;
    bf16_t* zc; bf16_t* qkv; bf16_t* gates; const float* bgate; const float* rope; float* out;
    __device__ __forceinline__ void operator()(const f32x4 (&acc)[2][2][4][2], const Unit& u, int wr, int wc, int fr, int fq) const {
        const int row0 = u.pm * 256 + wr * 64 + fr;
        const int cw0 = 64 * (wc >> 1) + 16 * (wc & 1) + 4 * fq;
        if (u.pn < 6) {
#pragma unroll
            for (int ai = 0; ai < 2; ++ai)
#pragma unroll
                for (int m = 0; m < 4; ++m) { bf16_t* rp = zc + (size_t)(row0 + ai * 128 + m * 16) * 1536 + u.pn * 256 + cw0;
#pragma unroll
                    for (int bj = 0; bj < 2; ++bj)
#pragma unroll
                        for (int n = 0; n < 2; ++n) { const f32x4 v = acc[ai][bj][m][n]; u32x2 w; w.x = cvt_pk_bf16(v[0], v[1]); w.y = cvt_pk_bf16(v[2], v[3]); *(u32x2*)(rp + bj * 128 + n * 32) = w; } }
        } else if (u.pn < 15) {
            const int t = u.pn - 6, gi = t / 3, kind = t - 3 * gi;
            bf16_t* dst = qkv + (size_t)(gi * 3 + kind) * M * 256;
            const int Wk = 128 << (2 * gi);
            float* okp = out + (gi == 0 ? O_KVP0 : (gi == 1 ? O_KVP1 : O_KVP2));
            float* oks = out + (gi == 0 ? O_KVS0 : (gi == 1 ? O_KVS1 : O_KVS2));
            const int e0 = 16 * (wc & 1) + 4 * fq;
#pragma unroll
            for (int ai = 0; ai < 2; ++ai)
#pragma unroll
                for (int m = 0; m < 4; ++m) {
                    const int row = row0 + ai * 128 + m * 16;
                    int pos; float* kvb = nullptr;
                    if (row < MP) { const int nb = row >> 12, p = row & 4095; pos = p; const int pk = p - (SEQ - Wk); if (pk >= 0) kvb = okp + ((size_t)(nb * Wk + pk) * 2) * 256; }
                    else { const int rs = row - MP, nb = rs >> 3, tt = rs & 7; pos = 2048 + tt; kvb = oks + ((size_t)(nb * Wk + Wk - 8 + tt) * 2) * 256; }
                    f32x4 cs0 = {1.f, 0.f, 1.f, 0.f}, cs1 = {1.f, 0.f, 1.f, 0.f};
                    if (kind < 2) { const f32x4* rp = (const f32x4*)(rope + ((size_t)pos * 32 + e0) * 2); cs0 = rp[0]; cs1 = rp[1]; }
#pragma unroll
                    for (int bj = 0; bj < 2; ++bj) {
                        f32x4 x1 = acc[ai][bj][m][0], x2 = acc[ai][bj][m][1];
                        if (kind < 2) {
                            const f32x4 c = {cs0[0], cs0[2], cs1[0], cs1[2]}, s = {cs0[1], cs0[3], cs1[1], cs1[3]};
                            const f32x4 o1 = x1 * c - x2 * s, o2 = x2 * c + x1 * s; x1 = o1; x2 = o2;
                            if (kind == 0) { x1 = x1 * 0.125f; x2 = x2 * 0.125f; }
                        }
                        const int hc = (2 * bj + (wc >> 1)) * 64 + e0;
                        u32x2 w1, w2; w1.x = cvt_pk_bf16(x1[0], x1[1]); w1.y = cvt_pk_bf16(x1[2], x1[3]); w2.x = cvt_pk_bf16(x2[0], x2[1]); w2.y = cvt_pk_bf16(x2[2], x2[3]);
                        *(u32x2*)(dst + (size_t)row * 256 + hc) = w1; *(u32x2*)(dst + (size_t)row * 256 + hc + 32) = w2;
                        if (kind >= 1 && kvb) { float* kp = kvb + (kind - 1) * 256 + hc; *(f32x4*)kp = x1; *(f32x4*)(kp + 32) = x2; }
                    }
                    asm volatile("" ::: "memory");
                }
        } else {
            const int cg0 = (u.pn - 15) * 256 + cw0;
#pragma unroll
            for (int bj = 0; bj < 2; ++bj)
#pragma unroll
                for (int n = 0; n < 2; ++n) { const f32x4 bv = *(const f32x4*)(bgate + cg0 + bj * 128 + n * 32);
#pragma unroll
                    for (int ai = 0; ai < 2; ++ai)
#pragma unroll
                        for (int m = 0; m < 4; ++m) { const f32x4 v = acc[ai][bj][m][n] + bv; f32x4 s;
#pragma unroll
                            for (int j = 0; j < 4; ++j) s[j] = __builtin_amdgcn_rcpf(1.0f + __expf(-v[j]));
                            u32x2 w; w.x = cvt_pk_bf16(s[0], s[1]); w.y = cvt_pk_bf16(s[2], s[3]);
                            *(u32x2*)(gates + (size_t)(row0 + ai * 128 + m * 16) * 2048 + cg0 + bj * 128 + n * 32) = w; } }
        }
    }
};
struct Epi3 {
    static constexpr int PERM = 1;
    bf16_t* mix; const bf16_t* gates; int second;
    __device__ __forceinline__ void operator()(const f32x4 (&acc)[2][2][4][2], const Unit& u, int wr, int wc, int fr, int fq) const {
        const int row0 = u.pm * 256 + wr * 64 + fr, col0 = u.pn * 256 + wc * 32 + 8 * fq;
#pragma unroll
        for (int ai = 0; ai < 2; ++ai)
#pragma unroll
            for (int m = 0; m < 4; ++m) { const int row = row0 + ai * 128 + m * 16;
#pragma unroll
                for (int bj = 0; bj < 2; ++bj) { const int c = col0 + bj * 128;
                    const u32x4 g = *(const u32x4*)(gates + (size_t)row * 2048 + second * 1024 + c);
                    f32x4 v0 = acc[ai][bj][m][0], v1 = acc[ai][bj][m][1];
                    v0 = v0 * (f32x4){bflo(g.x), bfhi(g.x), bflo(g.y), bfhi(g.y)}; v1 = v1 * (f32x4){bflo(g.z), bfhi(g.z), bflo(g.w), bfhi(g.w)};
                    bf16_t* mp = mix + (size_t)row * 1024 + c;
                    if (second) { const u32x4 o = *(const u32x4*)mp; v0 = v0 + (f32x4){bflo(o.x), bfhi(o.x), bflo(o.y), bfhi(o.y)}; v1 = v1 + (f32x4){bflo(o.z), bfhi(o.z), bflo(o.w), bfhi(o.w)}; }
                    u32x4 w; w.x = cvt_pk_bf16(v0[0], v0[1]); w.y = cvt_pk_bf16(v0[2], v0[3]); w.z = cvt_pk_bf16(v1[0], v1[1]); w.w = cvt_pk_bf16(v1[2], v1[3]);
                    *(u32x4*)mp = w; }
                asm volatile("" ::: "memory"); }
    }
};
struct EpiRes {
    static constexpr int PERM = 0;
    const float* resA; const float* resB; float* pre;
    __device__ __forceinline__ void operator()(const f32x4 (&acc)[2][2][4][2], const Unit& u, int wr, int wc, int fr, int fq) const {
        const int row0 = u.pm * 256 + wr * 64 + fr, col0 = u.pn * 256 + wc * 32 + 4 * fq;
        const float* res = (u.pm * 256 < MP) ? resA : resB;
#pragma unroll
        for (int ai = 0; ai < 2; ++ai)
#pragma unroll
            for (int m = 0; m < 4; ++m) { const size_t off = (size_t)(row0 + ai * 128 + m * 16) * 1024 + col0;
#pragma unroll
                for (int bj = 0; bj < 2; ++bj)
#pragma unroll
                    for (int n = 0; n < 2; ++n) { const f32x4 r = *(const f32x4*)(res + off + bj * 128 + n * 16); *(f32x4*)(pre + off + bj * 128 + n * 16) = r * ALPHA + acc[ai][bj][m][n]; }
                asm volatile("" ::: "memory"); }
    }
};
struct EpiHid {
    static constexpr int PERM = 1;
    bf16_t* hid;
    __device__ __forceinline__ void operator()(const f32x4 (&acc)[2][2][4][2], const Unit& u, int wr, int wc, int fr, int fq) const {
        const int row0 = u.pm * 256 + wr * 64 + fr, col0 = u.pn * 256 + wc * 32 + 8 * fq;
#pragma unroll
        for (int ai = 0; ai < 2; ++ai)
#pragma unroll
            for (int m = 0; m < 4; ++m) { bf16_t* rp = hid + (size_t)(row0 + ai * 128 + m * 16) * FF + col0;
#pragma unroll
                for (int bj = 0; bj < 2; ++bj) { f32x4 v0 = acc[ai][bj][m][0], v1 = acc[ai][bj][m][1];
#pragma unroll
                    for (int j = 0; j < 4; ++j) { const float a = fmaxf(v0[j], 0.f), b = fmaxf(v1[j], 0.f); v0[j] = a * a; v1[j] = b * b; }
                    u32x4 w; w.x = cvt_pk_bf16(v0[0], v0[1]); w.y = cvt_pk_bf16(v0[2], v0[3]); w.z = cvt_pk_bf16(v1[0], v1[1]); w.w = cvt_pk_bf16(v1[2], v1[3]);
                    *(u32x4*)(rp + bj * 128) = w; } }
    }
};

__device__ __forceinline__ void transpose_item(const float* W, int K, int N, bf16_t* WT, LAS float* scr, int item, int lane) {
    const int nblk = N / 32, kb = item / nblk, nb = item % nblk, k0 = 64 * kb, n0 = 32 * nb;
#pragma unroll 8
    for (int i = 0; i < 32; ++i) { const int kk = 2 * i + (lane >> 5); scr[kk * 33 + (lane & 31)] = W[(size_t)(k0 + kk) * N + n0 + (lane & 31)]; }
    asm volatile("s_waitcnt lgkmcnt(0)" ::: "memory");
    const int c = lane & 7;
#pragma unroll
    for (int j = 0; j < 4; ++j) { const int n = (lane >> 3) + 8 * j; const LAS float* s = scr + (8 * c) * 33 + n;
        u32x4 o; o.x = cvt_pk_bf16(s[0 * 33], s[1 * 33]); o.y = cvt_pk_bf16(s[2 * 33], s[3 * 33]); o.z = cvt_pk_bf16(s[4 * 33], s[5 * 33]); o.w = cvt_pk_bf16(s[6 * 33], s[7 * 33]);
        *(u32x4*)(WT + (size_t)(n0 + n) * K + k0 + 8 * c) = o; }
    asm volatile("s_waitcnt lgkmcnt(0)" ::: "memory");
}

__device__ __forceinline__ void phase_prep(const Params& p, LAS unsigned char* lds) {
    const int tid = threadIdx.x, lane = tid & 63, wave = tid >> 6;
    const size_t gt = (size_t)blockIdx.x * NT + tid, GT = (size_t)gridDim.x * NT;
    unsigned char* ws = p.ws;
    { bf16_t* xb = (bf16_t*)(ws + WS_XB); constexpr size_t NCH = (size_t)M * D / 8, NP = (size_t)MP * D / 8;
      for (size_t i0 = gt; i0 < NCH; i0 += 4 * GT) {
          f32x4 a[4], b[4];
#pragma unroll
          for (int k = 0; k < 4; ++k) { const size_t i = i0 + k * GT; if (i < NCH) { const float* src = (i < NP) ? p.in[0] + i * 8 : p.in[1] + (i - NP) * 8; a[k] = ((const f32x4*)src)[0]; b[k] = ((const f32x4*)src)[1]; } }
#pragma unroll
          for (int k = 0; k < 4; ++k) { const size_t i = i0 + k * GT; if (i < NCH) { u32x4 o; o.x = cvt_pk_bf16(a[k][0], a[k][1]); o.y = cvt_pk_bf16(a[k][2], a[k][3]); o.z = cvt_pk_bf16(b[k][0], b[k][1]); o.w = cvt_pk_bf16(b[k][2], b[k][3]);
              *(u32x4*)(xb + i * 8) = o; } } } }
    { float* rt = (float*)(ws + WS_ROPE);
      for (size_t i = gt; i < (size_t)4096 * 32; i += GT) { const int pos = (int)(i >> 5), f = (int)(i & 31);
          const float inv = 1.0f / exp2f((float)f * (13.287712379549449f / 32.0f));
          const float ang = (float)pos * inv;
          const double rev = (double)ang * 0.15915494309189535; const float fr = (float)(rev - floor(rev));
          rt[2 * i] = __builtin_amdgcn_cosf(fr); rt[2 * i + 1] = __builtin_amdgcn_sinf(fr); } }
    { LAS float* scr = (LAS float*)(lds + wave * 16384);
      const int gw = blockIdx.x * 8 + wave, NGW = gridDim.x * 8;
      constexpr int I_IN = (D / 64) * (NIN / 32), I_C = (DC / 64) * (D / 32), I_A = (256 / 64) * (D / 32), I_O = (D / 64) * (D / 32), I_UP = (D / 64) * (FF / 32), I_DN = (FF / 64) * (D / 32);
      constexpr int NITEMS = I_IN + I_C + I_A + I_O + I_UP + I_DN;
      for (int it = gw; it < NITEMS; it += NGW) { int r = it;
          if (r < I_IN) { transpose_item(p.in[6], D, NIN, (bf16_t*)(ws + WS_WIN), scr, r, lane); continue; } r -= I_IN;
          if (r < I_C) { transpose_item(p.in[9], DC, D, (bf16_t*)(ws + WS_WC), scr, r, lane); continue; } r -= I_C;
          if (r < I_A) { transpose_item(p.in[10], 256, D, (bf16_t*)(ws + WS_WA), scr, r, lane); continue; } r -= I_A;
          if (r < I_O) { transpose_item(p.in[11], D, D, (bf16_t*)(ws + WS_WO), scr, r, lane); continue; } r -= I_O;
          if (r < I_UP) { transpose_item(p.in[14], D, FF, (bf16_t*)(ws + WS_WUP), scr, r, lane); continue; } r -= I_UP;
          transpose_item(p.in[15], FF, D, (bf16_t*)(ws + WS_WDN), scr, r, lane); } }
}

constexpr int KS_STRIDE = 144;
constexpr int VT_STRIDE = 528;
constexpr int KS_OFF = 0, VT_OFF = 256 * KS_STRIDE;
__device__ __forceinline__ void attn_prompt_item(const Params& p, LAS unsigned char* lds, int item) {
    const int tid = threadIdx.x, lane = tid & 63, w = tid >> 6, fr = lane & 15, s = lane >> 4;
    const int g = item >> 9, rem = item & 511, nb = rem >> 7, rem2 = rem & 127, h = rem2 >> 5, rb = rem2 & 31;
    const int dsh = 2 * g, d = 1 << dsh, nbk = 32 >> dsh, r = rb / nbk, b = rb - r * nbk;
    const bf16_t* qb = (const bf16_t*)(p.ws + WS_QKV) + (size_t)(3 * g) * M * 256;
    const bf16_t* kb = qb + (size_t)M * 256; const bf16_t* vb = kb + (size_t)M * 256;
    const size_t rowbase = (size_t)nb * SEQ + r;
    const int i0 = 128 * (b - 1);
#pragma unroll
    for (int ii = 0; ii < 4; ++ii) { const int c = tid + NT * ii, kl = c >> 3, ch = c & 7; int ik = i0 + kl; ik = ik < 0 ? 0 : ik;
        const u32x4 v = *(const u32x4*)(kb + (rowbase + (size_t)ik * d) * 256 + h * 64 + ch * 8);
        *(LAS u32x4*)(lds + KS_OFF + kl * KS_STRIDE + ch * 16) = v; }
#pragma unroll
    for (int ii = 0; ii < 4; ++ii) { const int c = tid + NT * ii, kl = c & 255, ch = c >> 8; int ik = i0 + kl; ik = ik < 0 ? 0 : ik;
        const u32x4 v = *(const u32x4*)(vb + (rowbase + (size_t)ik * d) * 256 + h * 64 + ch * 8);
        LAS bf16_t* vt = (LAS bf16_t*)(lds + VT_OFF + (ch * 8) * VT_STRIDE) + kl;
        vt[0 * (VT_STRIDE / 2)] = (bf16_t)(v.x & 0xffff); vt[1 * (VT_STRIDE / 2)] = (bf16_t)(v.x >> 16);
        vt[2 * (VT_STRIDE / 2)] = (bf16_t)(v.y & 0xffff); vt[3 * (VT_STRIDE / 2)] = (bf16_t)(v.y >> 16);
        vt[4 * (VT_STRIDE / 2)] = (bf16_t)(v.z & 0xffff); vt[5 * (VT_STRIDE / 2)] = (bf16_t)(v.z >> 16);
        vt[6 * (VT_STRIDE / 2)] = (bf16_t)(v.w & 0xffff); vt[7 * (VT_STRIDE / 2)] = (bf16_t)(v.w >> 16); }
    const int iq = 128 * b + 16 * w + fr; const size_t qrow = rowbase + (size_t)iq * d;
    const bf16x8 q0 = *(const bf16x8*)(qb + qrow * 256 + h * 64 + 8 * s), q1 = *(const bf16x8*)(qb + qrow * 256 + h * 64 + 32 + 8 * s);
    __syncthreads();
    f32x4 sc[9];
#pragma unroll
    for (int j = 0; j < 9; ++j) {
        const LAS unsigned char* kp = lds + KS_OFF + (16 * (w + j) + fr) * KS_STRIDE + s * 16;
        const bf16x8 k0 = *(const LAS bf16x8*)kp, k1 = *(const LAS bf16x8*)(kp + 64);
        f32x4 a = {0.f, 0.f, 0.f, 0.f};
        a = __builtin_amdgcn_mfma_f32_16x16x32_bf16(k0, q0, a, 0, 0, 0);
        a = __builtin_amdgcn_mfma_f32_16x16x32_bf16(k1, q1, a, 0, 0, 0);
        sc[j] = a;
    }
    float mx = -INFINITY;
#pragma unroll
    for (int j = 0; j < 9; ++j)
#pragma unroll
        for (int i = 0; i < 4; ++i) { const int dist = 128 - 16 * j + fr - 4 * s - i; const int kl = 16 * (w + j) + 4 * s + i;
            const bool ok = (dist >= 0) && (dist <= 128) && (b > 0 || kl >= 128);
            sc[j][i] = ok ? sc[j][i] : -INFINITY; mx = fmaxf(mx, sc[j][i]); }
    mx = fmaxf(mx, __shfl_xor(mx, 16)); mx = fmaxf(mx, __shfl_xor(mx, 32));
    float sum = 0.f;
#pragma unroll
    for (int j = 0; j < 9; ++j)
#pragma unroll
        for (int i = 0; i < 4; ++i) { const float e = __expf(sc[j][i] - mx); sc[j][i] = e; sum += e; }
    sum += __shfl_xor(sum, 16); sum += __shfl_xor(sum, 32);
    f32x4 o[4];
#pragma unroll
    for (int dt = 0; dt < 4; ++dt) o[dt] = (f32x4){0.f, 0.f, 0.f, 0.f};
#pragma unroll
    for (int j = 0; j < 9; ++j) {
        u32x2 pw; pw.x = cvt_pk_bf16(sc[j][0], sc[j][1]); pw.y = cvt_pk_bf16(sc[j][2], sc[j][3]);
        const bf16x4 pf = __builtin_bit_cast(bf16x4, pw);
#pragma unroll
        for (int dt = 0; dt < 4; ++dt) {
            const bf16x4 vf = *(const LAS bf16x4*)(lds + VT_OFF + (16 * dt + fr) * VT_STRIDE + (16 * (w + j) + 4 * s) * 2);
            o[dt] = __builtin_amdgcn_mfma_f32_16x16x16bf16_1k(vf, pf, o[dt], 0, 0, 0);
        }
    }
    const float inv = 1.0f / sum;
    bf16_t* og = (bf16_t*)(p.ws + WS_OG) + (size_t)g * M * 256 + qrow * 256 + h * 64;
#pragma unroll
    for (int dt = 0; dt < 4; ++dt) { u32x2 ww; ww.x = cvt_pk_bf16(o[dt][0] * inv, o[dt][1] * inv); ww.y = cvt_pk_bf16(o[dt][2] * inv, o[dt][3] * inv); *(u32x2*)(og + 16 * dt + 4 * s) = ww; }
    if (s == 0) ((float*)(p.ws + WS_LSE))[((size_t)g * M + qrow) * 4 + h] = mx + __logf(sum);
    __syncthreads();
}

__device__ __forceinline__ void attn_sample_unit(const Params& p, LAS unsigned char* lds, int unit) {
    const int lane = threadIdx.x & 63, w = threadIdx.x >> 6;
    LAS float* qs = (LAS float*)(lds + w * 1024);
    LAS float* ps = qs + 64;
    const int t = unit & 7, h = (unit >> 3) & 3, g = (unit >> 5) % 3, n = unit / 96;
    const int d = 1 << (2 * g), W = 128 * d;
    const size_t row = (size_t)MP + n * 8 + t;
    const bf16_t* qb = (const bf16_t*)(p.ws + WS_QKV) + (size_t)(3 * g) * M * 256;
    const bf16_t* kb = qb + (size_t)M * 256; const bf16_t* vb = kb + (size_t)M * 256;
    const float* cache = p.in[3 + g] + (size_t)n * W * 512;
    qs[lane] = bf1(qb[row * 256 + h * 64 + lane]);
    asm volatile("s_waitcnt lgkmcnt(0)" ::: "memory");
    float sv[3]; float mx = -INFINITY;
#pragma unroll
    for (int rr = 0; rr < 3; ++rr) {
        const int j = lane + 64 * rr; float a = -INFINITY;
        if (j <= 128) {
            const int idx = W + t - j * d; a = 0.f;
            if (idx >= W) { const bf16_t* kp = kb + ((size_t)MP + n * 8 + (idx - W)) * 256 + h * 64;
#pragma unroll
                for (int c = 0; c < 8; ++c) { const u32x4 v = ((const u32x4*)kp)[c]; const LAS f32x4* qq = (const LAS f32x4*)(qs + 8 * c); const f32x4 qa = qq[0], qc = qq[1];
                    a += bflo(v.x) * qa[0] + bfhi(v.x) * qa[1] + bflo(v.y) * qa[2] + bfhi(v.y) * qa[3] + bflo(v.z) * qc[0] + bfhi(v.z) * qc[1] + bflo(v.w) * qc[2] + bfhi(v.w) * qc[3]; }
            } else { const float* kp = cache + (size_t)idx * 512 + h * 64;
#pragma unroll
                for (int c = 0; c < 16; ++c) { const f32x4 v = ((const f32x4*)kp)[c]; const f32x4 qa = *(const LAS f32x4*)(qs + 4 * c); a += v[0] * qa[0] + v[1] * qa[1] + v[2] * qa[2] + v[3] * qa[3]; }
            }
        }
        sv[rr] = a; mx = fmaxf(mx, a);
    }
    mx = wave_max(mx);
    float sum = 0.f;
#pragma unroll
    for (int rr = 0; rr < 3; ++rr) { const int j = lane + 64 * rr; const float e = (j <= 128) ? __expf(sv[rr] - mx) : 0.f; sum += e; if (j < 132) ps[j] = e; }
    sum = wave_sum(sum);
    asm volatile("s_waitcnt lgkmcnt(0)" ::: "memory");
    const int ks = lane >> 4, dq = lane & 15;
    f32x4 o = {0.f, 0.f, 0.f, 0.f};
#pragma unroll 4
    for (int jj = 0; jj < 33; ++jj) {
        const int j = 4 * jj + ks;
        if (j <= 128) {
            const int idx = W + t - j * d; const float pj = ps[j]; f32x4 v;
            if (idx >= W) { const u32x2 vv = *(const u32x2*)(vb + ((size_t)MP + n * 8 + (idx - W)) * 256 + h * 64 + 4 * dq); v = (f32x4){bflo(vv.x), bfhi(vv.x), bflo(vv.y), bfhi(vv.y)}; }
            else v = *(const f32x4*)(cache + (size_t)idx * 512 + 256 + h * 64 + 4 * dq);
            o = o + v * pj;
        }
    }
#pragma unroll
    for (int i = 0; i < 4; ++i) { o[i] += __shfl_xor(o[i], 16); o[i] += __shfl_xor(o[i], 32); }
    const float inv = 1.0f / sum;
    if (ks == 0) { u32x2 ww; ww.x = cvt_pk_bf16(o[0] * inv, o[1] * inv); ww.y = cvt_pk_bf16(o[2] * inv, o[3] * inv);
        *(u32x2*)((bf16_t*)(p.ws + WS_OG) + (size_t)g * M * 256 + row * 256 + h * 64 + 4 * dq) = ww; }
    if (lane == 0) ((float*)(p.ws + WS_LSE))[((size_t)g * M + row) * 4 + h] = mx + __logf(sum);
    asm volatile("s_waitcnt lgkmcnt(0)" ::: "memory");
}

__device__ __forceinline__ void load_u8(const bf16_t* zc, size_t row, int c, float (&u)[8]) {
    const u32x4 a = *(const u32x4*)(zc + row * 1536 + 512 + c), b = *(const u32x4*)(zc + row * 1536 + 1024 + c);
    u[0] = bflo(a.x) * bflo(b.x); u[1] = bfhi(a.x) * bfhi(b.x); u[2] = bflo(a.y) * bflo(b.y); u[3] = bfhi(a.y) * bfhi(b.y);
    u[4] = bflo(a.z) * bflo(b.z); u[5] = bfhi(a.z) * bfhi(b.z); u[6] = bflo(a.w) * bflo(b.w); u[7] = bfhi(a.w) * bfhi(b.w);
}
__device__ __forceinline__ void phase_conv(const Params& p) {
    const bf16_t* zc = (const bf16_t*)(p.ws + WS_ZC); bf16_t* yc = (bf16_t*)(p.ws + WS_YC);
    const float* cw = p.in[8]; const float* st = p.in[2];
    const size_t gt = (size_t)blockIdx.x * NT + threadIdx.x, GT = (size_t)gridDim.x * NT;
    for (size_t i = gt; i < (size_t)M * 64; i += GT) {
        const size_t row = i >> 6; const int c = (int)(i & 63) * 8;
        float u0[8], u1[8], u2[8];
        load_u8(zc, row, c, u2);
        int tpos; int nb = 0; const bool prm = row < MP;
        if (prm) tpos = (int)(row & 4095); else { const int rs = (int)(row - MP); nb = rs >> 3; tpos = rs & 7; }
        if (tpos >= 1) load_u8(zc, row - 1, c, u1);
        else if (prm) {
#pragma unroll
            for (int e = 0; e < 8; ++e) u1[e] = 0.f; }
        else { const f32x4 a = *(const f32x4*)(st + ((size_t)nb * 2 + 1) * 512 + c), b = *(const f32x4*)(st + ((size_t)nb * 2 + 1) * 512 + c + 4);
            u1[0] = a[0]; u1[1] = a[1]; u1[2] = a[2]; u1[3] = a[3]; u1[4] = b[0]; u1[5] = b[1]; u1[6] = b[2]; u1[7] = b[3]; }
        if (tpos >= 2) load_u8(zc, row - 2, c, u0);
        else if (prm) {
#pragma unroll
            for (int e = 0; e < 8; ++e) u0[e] = 0.f; }
        else { const int si = tpos;
            const f32x4 a = *(const f32x4*)(st + ((size_t)nb * 2 + si) * 512 + c), b = *(const f32x4*)(st + ((size_t)nb * 2 + si) * 512 + c + 4);
            u0[0] = a[0]; u0[1] = a[1]; u0[2] = a[2]; u0[3] = a[3]; u0[4] = b[0]; u0[5] = b[1]; u0[6] = b[2]; u0[7] = b[3]; }
        const u32x4 bb = *(const u32x4*)(zc + row * 1536 + c);
        const float Bv[8] = {bflo(bb.x), bfhi(bb.x), bflo(bb.y), bfhi(bb.y), bflo(bb.z), bfhi(bb.z), bflo(bb.w), bfhi(bb.w)};
        float y[8];
#pragma unroll
        for (int e = 0; e < 8; ++e) y[e] = Bv[e] * (cw[c + e] * u0[e] + cw[512 + c + e] * u1[e] + cw[1024 + c + e] * u2[e]);
        u32x4 o; o.x = cvt_pk_bf16(y[0], y[1]); o.y = cvt_pk_bf16(y[2], y[3]); o.z = cvt_pk_bf16(y[4], y[5]); o.w = cvt_pk_bf16(y[6], y[7]);
        *(u32x4*)(yc + row * 512 + c) = o;
        float* so = nullptr;
        if (prm) { if (tpos >= SEQ - 2) so = p.out + O_CP + ((size_t)(row >> 12) * 2 + (tpos - (SEQ - 2))) * 512 + c; }
        else if (tpos >= 6) so = p.out + O_CS + ((size_t)nb * 2 + (tpos - 6)) * 512 + c;
        if (so) { *(f32x4*)so = (f32x4){u2[0], u2[1], u2[2], u2[3]}; *(f32x4*)(so + 4) = (f32x4){u2[4], u2[5], u2[6], u2[7]}; }
    }
}

constexpr int CP_PIECE = 8192;
constexpr int CP_UNITS_N = 2 + 8 + 32;
constexpr int CP_UNITS = 128 * CP_UNITS_N;
__device__ __forceinline__ void copy_unit(const Params& p, int unit) {
    const int n = unit / CP_UNITS_N, q = unit - n * CP_UNITS_N;
    const int g = q < 2 ? 0 : (q < 10 ? 1 : 2), piece = q - (g == 0 ? 0 : (g == 1 ? 2 : 10));
    const int W = 128 << (2 * g);
    const size_t per = (size_t)(W - 8) * 128, full = (size_t)W * 128;
    const f32x4* src = (const f32x4*)p.in[3 + g] + n * full + 1024 + (size_t)piece * CP_PIECE;
    f32x4* dst = (f32x4*)(p.out + (g == 0 ? O_KVS0 : (g == 1 ? O_KVS1 : O_KVS2))) + n * full + (size_t)piece * CP_PIECE;
    const int cnt = (int)((per - (size_t)piece * CP_PIECE) < (size_t)CP_PIECE ? (per - (size_t)piece * CP_PIECE) : (size_t)CP_PIECE);
    const int tid = threadIdx.x;
#pragma unroll
    for (int u = 0; u < 2; ++u) {
        f32x4 v[8];
#pragma unroll
        for (int k = 0; k < 8; ++k) { const int idx = tid + (u * 8 + k) * NT; if (idx < cnt) v[k] = __builtin_nontemporal_load(src + idx); }
#pragma unroll
        for (int k = 0; k < 8; ++k) { const int idx = tid + (u * 8 + k) * NT; if (idx < cnt) __builtin_nontemporal_store(v[k], dst + idx); }
    }
}
__device__ __forceinline__ void phase_copy(const Params& p) {
    for (int u = blockIdx.x; u < CP_UNITS; u += gridDim.x) copy_unit(p, u);
}

__device__ __forceinline__ void phase_merge(const Params& p) {
    const bf16_t* og = (const bf16_t*)(p.ws + WS_OG); const float* lse = (const float*)(p.ws + WS_LSE); bf16_t* ya = (bf16_t*)(p.ws + WS_YA);
    const size_t gt = (size_t)blockIdx.x * NT + threadIdx.x, GT = (size_t)gridDim.x * NT;
    for (size_t i = gt; i < (size_t)M * 32; i += GT) {
        const size_t row = i >> 5; const int c = (int)(i & 31) * 8, h = c >> 6;
        const float l0 = lse[row * 4 + h], l1 = lse[((size_t)M + row) * 4 + h], l2 = lse[((size_t)2 * M + row) * 4 + h];
        const float mx = fmaxf(l0, fmaxf(l1, l2)); float w0 = __expf(l0 - mx), w1 = __expf(l1 - mx), w2 = __expf(l2 - mx); const float inv = 1.0f / (w0 + w1 + w2); w0 *= inv; w1 *= inv; w2 *= inv;
        const u32x4 a = *(const u32x4*)(og + row * 256 + c), b = *(const u32x4*)(og + ((size_t)M + row) * 256 + c), cc = *(const u32x4*)(og + ((size_t)2 * M + row) * 256 + c);
        u32x4 o;
        o.x = cvt_pk_bf16(w0 * bflo(a.x) + w1 * bflo(b.x) + w2 * bflo(cc.x), w0 * bfhi(a.x) + w1 * bfhi(b.x) + w2 * bfhi(cc.x));
        o.y = cvt_pk_bf16(w0 * bflo(a.y) + w1 * bflo(b.y) + w2 * bflo(cc.y), w0 * bfhi(a.y) + w1 * bfhi(b.y) + w2 * bfhi(cc.y));
        o.z = cvt_pk_bf16(w0 * bflo(a.z) + w1 * bflo(b.z) + w2 * bflo(cc.z), w0 * bfhi(a.z) + w1 * bfhi(b.z) + w2 * bfhi(cc.z));
        o.w = cvt_pk_bf16(w0 * bflo(a.w) + w1 * bflo(b.w) + w2 * bflo(cc.w), w0 * bfhi(a.w) + w1 * bfhi(b.w) + w2 * bfhi(cc.w));
        *(u32x4*)(ya + row * 256 + c) = o;
    }
}

template <bool FINAL>
__device__ __forceinline__ void phase_ln(const Params& p, const float* gam, const float* bet) {
    const int lane = threadIdx.x & 63, w = threadIdx.x >> 6;
    const float* pre = (const float*)(p.ws + WS_PRE);
    f32x4 gv[4], bv[4];
#pragma unroll
    for (int j = 0; j < 4; ++j) { gv[j] = ((const f32x4*)gam)[lane + 64 * j]; bv[j] = ((const f32x4*)bet)[lane + 64 * j]; }
    for (int row = blockIdx.x * 8 + w; row < M; row += gridDim.x * 8) {
        const f32x4* xr = (const f32x4*)(pre + (size_t)row * 1024) + lane;
        f32x4 v[4]; float s = 0.f;
#pragma unroll
        for (int j = 0; j < 4; ++j) { v[j] = xr[64 * j]; s += (v[j][0] + v[j][1]) + (v[j][2] + v[j][3]); }
        const float mean = wave_sum(s) * (1.f / 1024.f); float s2 = 0.f;
#pragma unroll
        for (int j = 0; j < 4; ++j) { v[j] = v[j] - mean; s2 += (v[j][0] * v[j][0] + v[j][1] * v[j][1]) + (v[j][2] * v[j][2] + v[j][3] * v[j][3]); }
        const float rstd = 1.f / sqrtf(wave_sum(s2) * (1.f / 1024.f) + LN_EPS);
#pragma unroll
        for (int j = 0; j < 4; ++j) { const f32x4 y = v[j] * rstd * gv[j] + bv[j];
            if (FINAL) { ((f32x4*)(p.out + (size_t)row * 1024))[lane + 64 * j] = y; }
            else { ((f32x4*)(p.ws + WS_X1F + (size_t)row * 4096))[lane + 64 * j] = y;
                u32x2 ww; ww.x = cvt_pk_bf16(y[0], y[1]); ww.y = cvt_pk_bf16(y[2], y[3]); ((u32x2*)(p.ws + WS_X1B + (size_t)row * 2048))[lane + 64 * j] = ww; } }
    }
}


#define XB_TMO      128
#define XB_XCNT(j)  (256  + 64 * (j))
#define XB_XSUB(j)  (1280 + 64 * (j))
#define XB_XGEN(j)  (2304 + 64 * (j))
#define XB_TOP      3328
#define XB_TOPGEN   3392
#define XCD_BAR_WORDS 3456
#define XB_SPIN_CAP (1u << 18)
__device__ __forceinline__ unsigned xb_ld(unsigned* p)              { return __hip_atomic_load(p, __ATOMIC_RELAXED, __HIP_MEMORY_SCOPE_AGENT); }
__device__ __forceinline__ unsigned xb_add(unsigned* p, unsigned v) { return __hip_atomic_fetch_add(p, v, __ATOMIC_RELAXED, __HIP_MEMORY_SCOPE_AGENT); }
__device__ __forceinline__ unsigned xb_xcc_id() { return (unsigned)__builtin_amdgcn_s_getreg((3 << 11) | 20) & 0xFu; }
#define XB_SPIN(cond, bar) do { unsigned _sp = 0; while (cond) { __builtin_amdgcn_s_sleep(1); \
    if ((++_sp & 255u) == 0u) { if (xb_ld(&(bar)[XB_TMO])) break; if (_sp > XB_SPIN_CAP) { atomicAdd(&(bar)[XB_TMO], 1u); break; } } } } while (0)
struct XcdBarrier { unsigned* bar; unsigned x; volatile LAS unsigned* st; };
__device__ __forceinline__ XcdBarrier xcd_barrier_post(unsigned* bar, volatile LAS unsigned* st) {
    XcdBarrier b; b.bar = bar; b.x = xb_xcc_id(); b.st = st;
    if (threadIdx.x == 0) (void)xb_add(&bar[XB_XCNT(b.x)], 1u);
    return b;
}
__device__ __forceinline__ void xcd_barrier_complete(unsigned* bar, unsigned x, unsigned& nloc, unsigned& nx) {
    const unsigned G = gridDim.x * gridDim.y * gridDim.z;
    unsigned sum, cnt, mine, sp = 0u;
    for (;;) {
        sum = 0u; cnt = 0u; mine = 0u;
#pragma unroll
        for (unsigned j = 0; j < 16; ++j) { const unsigned c = xb_ld(&bar[XB_XCNT(j)]); sum += c; cnt += (c > 0u) ? 1u : 0u; mine = (j == x) ? c : mine; }
        if (sum == G) break;
        __builtin_amdgcn_s_sleep(1);
        if ((++sp & 255u) == 0u) { if (xb_ld(&bar[XB_TMO])) break; if (sp > XB_SPIN_CAP) { atomicAdd(&bar[XB_TMO], 1u); break; } }
    }
    nloc = mine > 0u ? mine : 1u; nx = cnt > 0u ? cnt : 1u;
}
__device__ __forceinline__ void xcd_barrier(const XcdBarrier& b) {
    asm volatile("s_waitcnt vmcnt(0)" ::: "memory");
    __syncthreads();
    if (threadIdx.x == 0) {
        unsigned* bar = b.bar;
        __builtin_amdgcn_s_waitcnt(0);
        unsigned nloc = b.st[0], nx = b.st[1];
        if (nloc == 0u) { xcd_barrier_complete(bar, b.x, nloc, nx); b.st[0] = nloc; b.st[1] = nx; }
        const unsigned old = xb_add(&bar[XB_XSUB(b.x)], 1u);
        const unsigned gen = old / nloc;
        if (old + 1u == (gen + 1u) * nloc) {
            __builtin_amdgcn_fence(__ATOMIC_RELEASE, "agent");
            asm volatile("s_waitcnt vmcnt(0)" ::: "memory");
            const unsigned og = xb_add(&bar[XB_TOP], 1u);
            const unsigned tg = og / nx;
            if (og + 1u == (tg + 1u) * nx) xb_add(&bar[XB_TOPGEN], 1u);
            else XB_SPIN(xb_ld(&bar[XB_TOPGEN]) == tg, bar);
            __builtin_amdgcn_fence(__ATOMIC_ACQUIRE, "agent");
            xb_add(&bar[XB_XGEN(b.x)], 1u);
            asm volatile("s_waitcnt vmcnt(0)" ::: "memory");
        } else {
            XB_SPIN(xb_ld(&bar[XB_XGEN(b.x)]) == gen, bar);
            __builtin_amdgcn_fence(__ATOMIC_ACQUIRE, "agent");
            asm volatile("s_waitcnt vmcnt(0)" ::: "memory");
        }
    }
    __syncthreads();
}

constexpr int N_PHASES = 10;
__global__ void __launch_bounds__(NT, 2) fwd_kernel(Params p) {
    extern __shared__ __attribute__((aligned(16))) unsigned char smem[];
    LAS unsigned char* lds = (LAS unsigned char*)smem;
    unsigned char* ws = p.ws;
    const int G = gridDim.x, bx = blockIdx.x;
#if MK_MULTI
#define SYNC() do {} while (0)
#else
    cg::grid_group grid = cg::this_grid();
    if (p.ph_lo < 0) grid.sync();
    volatile LAS unsigned* xst = (volatile LAS unsigned*)(lds + pg8::STAGE_BYTES);
    if (threadIdx.x < 4) xst[threadIdx.x] = 0u;
    __syncthreads();
    const XcdBarrier xbar = xcd_barrier_post((unsigned*)(ws + WS_BAR), xst);
#define SYNC1() xcd_barrier(xbar)
#define SYNC() do { SYNC1(); if (DUP == 30) SYNC1(); } while (0)
#endif
#ifndef DUP
#define DUP -1
#endif
#define IN(k) (p.ph_lo <= (k) && (k) < p.ph_hi)
#define REP(k) for (int rep_ = 0; rep_ < ((DUP) == (k) ? 2 : 1); ++rep_)
    if (IN(0)) { REP(0) { phase_prep(p, lds); __syncthreads(); } SYNC(); }
    if (IN(1)) {
        REP(1) {
        pg8::Gemm g{(const bf16_t*)(ws + WS_XB), (const bf16_t*)(ws + WS_WIN), M, NIN, D}; pg8::StaticOrder S; S.init(M, NIN, G, bx);
        Epi1 E{(bf16_t*)(ws + WS_ZC), (bf16_t*)(ws + WS_QKV), (bf16_t*)(ws + WS_GATE), p.in[7], (const float*)(ws + WS_ROPE), p.out};
        pg8::gemm_phase<Epi1, pg8::StaticOrder, true, true>(lds, g, S, E);
        }
        SYNC();
    }
    if (IN(2)) {
        REP(2) {
        REP(21) for (int it = bx; it < 1536; it += G) attn_prompt_item(p, lds, it);
        REP(22) for (int it = bx; it < 1536; it += G) attn_sample_unit(p, lds, it * 8 + (threadIdx.x >> 6));
        REP(23) phase_conv(p);
        REP(24) phase_copy(p);
        __syncthreads();
        }
        SYNC();
    }
    if (IN(3)) { REP(3) phase_merge(p); SYNC(); }
    if (IN(4)) {
        REP(4) {
        { pg8::Gemm g{(const bf16_t*)(ws + WS_YC), (const bf16_t*)(ws + WS_WC), M, D, DC}; pg8::StaticOrder S; S.init(M, D, G, bx);
          Epi3 E{(bf16_t*)(ws + WS_MIX), (const bf16_t*)(ws + WS_GATE), 0};
          pg8::gemm_phase<Epi3, pg8::StaticOrder, true, true>(lds, g, S, E); }
        { pg8::Gemm g{(const bf16_t*)(ws + WS_YA), (const bf16_t*)(ws + WS_WA), M, D, 256}; pg8::StaticOrder S; S.init(M, D, G, bx);
          Epi3 E{(bf16_t*)(ws + WS_MIX), (const bf16_t*)(ws + WS_GATE), 1};
          pg8::gemm_phase<Epi3, pg8::StaticOrder, true, true>(lds, g, S, E); }
        }
        SYNC();
    }
    if (IN(5)) {
        REP(5) {
        pg8::Gemm g{(const bf16_t*)(ws + WS_MIX), (const bf16_t*)(ws + WS_WO), M, D, D}; pg8::StaticOrder S; S.init(M, D, G, bx);
        EpiRes E{p.in[0], p.in[1] - (size_t)MP * D, (float*)(ws + WS_PRE)};
        pg8::gemm_phase<EpiRes, pg8::StaticOrder, true, true>(lds, g, S, E);
        }
        SYNC();
    }
    if (IN(6)) { REP(6) phase_ln<false>(p, p.in[12], p.in[13]); SYNC(); }
    if (IN(7)) {
        REP(7) {
        pg8::Gemm g{(const bf16_t*)(ws + WS_X1B), (const bf16_t*)(ws + WS_WUP), M, FF, D}; pg8::StaticOrder S; S.init(M, FF, G, bx);
        EpiHid E{(bf16_t*)(ws + WS_HID)};
        pg8::gemm_phase<EpiHid, pg8::StaticOrder, true, true>(lds, g, S, E);
        }
        SYNC();
    }
    if (IN(8)) {
        REP(8) {
        pg8::Gemm g{(const bf16_t*)(ws + WS_HID), (const bf16_t*)(ws + WS_WDN), M, D, FF}; pg8::StaticOrder S; S.init(M, D, G, bx);
        EpiRes E{(const float*)(ws + WS_X1F), (const float*)(ws + WS_X1F), (float*)(ws + WS_PRE)};
        pg8::gemm_phase<EpiRes, pg8::StaticOrder, true, true>(lds, g, S, E);
        }
        SYNC();
    }
    if (IN(9)) { REP(9) phase_ln<true>(p, p.in[16], p.in[17]); }
#ifdef DUMP
    if (IN(20)) { const size_t gt = (size_t)blockIdx.x * NT + threadIdx.x, GT = (size_t)gridDim.x * NT;
        for (size_t i = gt; i < (size_t)M * 1024; i += GT) { const size_t row = i >> 10, c = i & 1023; float v;
            if (DUMP == 1) { v = bf1(((const bf16_t*)(ws + WS_GATE))[row * 2048 + c]) + bf1(((const bf16_t*)(ws + WS_GATE))[row * 2048 + 1024 + c]) + bf1(((const bf16_t*)(ws + WS_ZC))[row * 1536 + c]) + bf1(((const bf16_t*)(ws + WS_ZC))[row * 1536 + 512 + c]);
                for (int sl = 0; sl < 9; ++sl) v += (float)(sl + 1) * bf1(((const bf16_t*)(ws + WS_QKV))[((size_t)sl * M + row) * 256 + (c & 255)]); }
            else if (DUMP == 2) { v = bf1(((const bf16_t*)(ws + WS_YC))[row * 512 + (c & 511)]);
                for (int sl = 0; sl < 3; ++sl) v += (float)(sl + 1) * bf1(((const bf16_t*)(ws + WS_OG))[((size_t)sl * M + row) * 256 + (c & 255)]) + ((const float*)(ws + WS_LSE))[((size_t)sl * M + row) * 4 + (c & 3)]; }
            else if (DUMP == 3) v = bf1(((const bf16_t*)(ws + WS_YA))[row * 256 + (c & 255)]);
            else if (DUMP == 4) v = bf1(((const bf16_t*)(ws + WS_MIX))[i]);
            else if (DUMP == 5 || DUMP == 8) v = ((const float*)(ws + WS_PRE))[i];
            else if (DUMP == 6) v = ((const float*)(ws + WS_X1F))[i];
            else { const bf16_t* hp = (const bf16_t*)(ws + WS_HID) + row * 4096 + c; v = bf1(hp[0]) + bf1(hp[1024]) + bf1(hp[2048]) + bf1(hp[3072]); }
            p.out[i] = v; } }
#endif
#undef IN
#undef SYNC
}

extern "C" void kernel_launch(void* const* d_in, const int* in_sizes, int n_in, void* d_out, int out_size, void* d_ws, size_t ws_size, hipStream_t stream) {
    static int grid = 0;
    if (grid == 0) {
        if (n_in != 18 || (size_t)out_size != O_END || ws_size < WS_END) { fprintf(stderr, "kernel_launch: unexpected shapes (n_in %d out %d ws %zu need %zu)\n", n_in, out_size, ws_size, (size_t)WS_END); grid = -1; return; }
        int dev = 0, cus = 0, per_cu = 0;
        (void)hipGetDevice(&dev); (void)hipDeviceGetAttribute(&cus, hipDeviceAttributeMultiprocessorCount, dev);
        if (hipFuncSetAttribute((const void*)fwd_kernel, hipFuncAttributeMaxDynamicSharedMemorySize, LDS_BYTES) != hipSuccess) { fprintf(stderr, "kernel_launch: hipFuncSetAttribute failed\n"); grid = -1; return; }
        if (hipOccupancyMaxActiveBlocksPerMultiprocessor(&per_cu, (const void*)fwd_kernel, NT, LDS_BYTES) != hipSuccess || per_cu < 1) { fprintf(stderr, "kernel_launch: occupancy query says %d\n", per_cu); per_cu = 1; }
        (void)hipGetLastError();
        grid = cus * 1;
    }
    if (grid < 0) return;
    Params p{};
    for (int i = 0; i < 18; ++i) p.in[i] = (const float*)d_in[i];
    p.out = (float*)d_out; p.ws = (unsigned char*)d_ws;
#if MK_MULTI
#ifdef DUMP
    for (int k = 0; k <= DUMP; ++k) { p.ph_lo = k; p.ph_hi = k + 1; hipLaunchKernelGGL(fwd_kernel, dim3(grid), dim3(NT), LDS_BYTES, stream, p); }
    p.ph_lo = 20; p.ph_hi = 21; hipLaunchKernelGGL(fwd_kernel, dim3(grid), dim3(NT), LDS_BYTES, stream, p);
#else
    for (int k = 0; k < N_PHASES; ++k) { p.ph_lo = k; p.ph_hi = k + 1; hipLaunchKernelGGL(fwd_kernel, dim3(grid), dim3(NT), LDS_BYTES, stream, p); }
#endif
#else
    p.ph_lo = 0; p.ph_hi = N_PHASES;
    if (hipMemsetAsync((char*)d_ws + WS_BAR, 0, 16384, stream) != hipSuccess) { fprintf(stderr, "kernel_launch: memset of the barrier words failed\n"); return; }
    void* args[] = {&p};
    hipError_t e = hipLaunchCooperativeKernel((const void*)fwd_kernel, dim3(grid), dim3(NT), args, LDS_BYTES, stream);
    if (e != hipSuccess) fprintf(stderr, "cooperative launch failed: %s (grid %d)\n", hipGetErrorString(e), grid);
#endif
}
```

```cpp
#include <hip/hip_runtime.h>
#include <hip/hip_cooperative_groups.h>
#include <cstdio>
#include <cstdint>
namespace cg = cooperative_groups;

#ifndef MK_MULTI
#define MK_MULTI 0
#define DUP -1
#endif

__device__ __forceinline__ int fresh_tid() { return threadIdx.x; }
namespace pg8 {
#define PG8_LAS __attribute__((address_space(3)))
typedef unsigned short bf16_t;
typedef short bf16x8 __attribute__((ext_vector_type(8)));
typedef float f32x4 __attribute__((ext_vector_type(4)));
typedef unsigned u32x4 __attribute__((ext_vector_type(4)));
typedef unsigned u32x2 __attribute__((ext_vector_type(2)));
constexpr int BM = 256, BK = 64, HALF = 128, HTB = HALF * BK * 2, STAGE_BYTES = 8 * HTB, NXCD = 8, WGM = 8;

__host__ __device__ __forceinline__ int lds_byte(int r, int c) { const int st = (r >> 4) * 2 + (c >> 5), rr = r & 15, cc = c & 31, ob = rr * 64 + cc * 2; return st * 1024 + (ob ^ (((ob >> 9) & 1) << 5)); }
__host__ __device__ __forceinline__ void stage_rc(int b, int& R, int& C) { const int st = b / 1024, sb = b % 1024, swz = sb ^ (((sb >> 9) & 1) << 5); R = (st >> 1) * 16 + swz / 64; C = (st & 1) * 32 + (swz % 64) / 2; }
__host__ __device__ __forceinline__ int perm32(int rho) { const int n = rho >> 4, i = rho & 15; return 8 * (i >> 2) + 4 * n + (i & 3); }
__host__ __device__ __forceinline__ int swap45(int v) { return (v & 15) | ((v & 16) << 1) | ((v & 32) >> 1); }

struct Unit { int pm, pn; };
struct Gemm { const bf16_t* A; const bf16_t* Bt; int M, N, K; };

struct StaticOrder {
    int nM, nN, nwg, G, c;
    __host__ __device__ void init(int M, int N, int G_, int c_) { nM = M / BM; nN = N / BM; nwg = nM * nN; G = G_; c = c_; }
    __host__ __device__ bool next(int i, Unit& u) const {
        const long L = (long)i * G + c; if (L >= nwg) return false;
        int wgid = (int)L; { const int q = nwg / NXCD, r = nwg % NXCD, xcd = wgid % NXCD, off = wgid / NXCD; wgid = (xcd < r ? xcd * (q + 1) : r * (q + 1) + (xcd - r) * q) + off; }
        const int nig = WGM * nN, gid = wgid / nig, fm = gid * WGM, gsz = (nM - fm) < WGM ? (nM - fm) : WGM;
        u.pm = fm + ((wgid % nig) % gsz); u.pn = (wgid % nig) / gsz; return true;
    }
    __device__ __forceinline__ void a_ready(const Unit&) const {}
    __device__ __forceinline__ void done(const Unit&) const {}
};

typedef float cvt_f32x2 __attribute__((ext_vector_type(2)));
typedef __bf16 cvt_bf16x2 __attribute__((ext_vector_type(2)));
__device__ __forceinline__ unsigned cvt_pk_bf16(float lo, float hi) { const cvt_f32x2 v = {lo, hi}; const cvt_bf16x2 b = __builtin_convertvector(v, cvt_bf16x2); return __builtin_bit_cast(unsigned, b); }

template <class Epi, class Sched, bool ALIGN_EPI = false, bool SP2 = false>
__device__ __forceinline__ void gemm_phase(PG8_LAS unsigned char* lds, const Gemm g, const Sched& S, const Epi& E) {
    const int tid = fresh_tid(), wid = __builtin_amdgcn_readfirstlane(tid >> 6), lane = tid & 63, wr = wid >> 2, wc = wid & 3, fr = lane & 15, fq = lane >> 4;
    const int K = g.K, nt = K / BK;
    unsigned voffA[2], voffB[2];
#pragma unroll
    for (int i = 0; i < 2; ++i) { int R, C; stage_rc(tid * 16 + i * 8192, R, C);
        const int Rb = Epi::PERM == 1 ? ((R & ~31) + perm32(R & 31)) : (Epi::PERM == 2 ? ((R & ~63) + swap45(R & 63)) : R);
        voffA[i] = (unsigned)(R * K + C) * 2u; voffB[i] = (unsigned)(Rb * K + C) * 2u; }
    const size_t kstep = (size_t)(BK * 2);
    const size_t hstep = (size_t)HALF * K * 2;
    const size_t tstep = 2 * hstep;
    const unsigned ldsw = (unsigned)wid * 1024u;
    const int aoff = lds_byte(wr * 64 + fr, fq * 8), boff = lds_byte(wc * 32 + fr, fq * 8);
#define PG8_SA(b, h) (((b) * 2 + (h)) * HTB)
#define PG8_SB(b, h) ((4 + (b) * 2 + (h)) * HTB)
#define PG8_STAGE(bufoff, gbase, voff) do { _Pragma("unroll") for (int _i = 0; _i < 2; ++_i) \
        __builtin_amdgcn_global_load_lds((const unsigned*)((const char*)(gbase) + (voff)[_i]), (PG8_LAS unsigned*)(lds + (bufoff) + ldsw + _i * 8192), 16, 0, 0); } while (0)
#define PG8_LDA(dst, b, h) do { _Pragma("unroll") for (int m = 0; m < 4; ++m) _Pragma("unroll") for (int k = 0; k < 2; ++k) dst[m][k] = *(const PG8_LAS bf16x8*)(lds + PG8_SA(b, h) + aoff + m * 2048 + k * 1024); } while (0)
#define PG8_LDB(dst, b, h) do { _Pragma("unroll") for (int n = 0; n < 2; ++n) _Pragma("unroll") for (int k = 0; k < 2; ++k) dst[n][k] = *(const PG8_LAS bf16x8*)(lds + PG8_SB(b, h) + boff + n * 2048 + k * 1024); } while (0)
#define PG8_MMA(ai, bj, At, Bt) do { __builtin_amdgcn_s_setprio(1); _Pragma("unroll") for (int m = 0; m < 4; ++m) _Pragma("unroll") for (int n = 0; n < 2; ++n) _Pragma("unroll") for (int k = 0; k < 2; ++k) \
        acc[ai][bj][m][n] = __builtin_amdgcn_mfma_f32_16x16x32_bf16(Bt[n][k], At[m][k], acc[ai][bj][m][n], 0, 0, 0); __builtin_amdgcn_s_setprio(0); } while (0)
#define PG8_WAIT_V(n) asm volatile("s_waitcnt vmcnt(" #n ")" ::: "memory")
#define PG8_WAIT_L(n) asm volatile("s_waitcnt lgkmcnt(" #n ")" ::: "memory")
#define PG8_BAR __builtin_amdgcn_s_barrier()
#define PG8_SCHED __builtin_amdgcn_sched_barrier(0)
    Unit cur, nxt; int ui = 0;
    if (!S.next(0, cur)) return;
    f32x4 acc[2][2][4][2];
#pragma unroll
    for (int a = 0; a < 2; ++a)
#pragma unroll
        for (int b = 0; b < 2; ++b)
#pragma unroll
            for (int m = 0; m < 4; ++m)
#pragma unroll
                for (int n = 0; n < 2; ++n) acc[a][b][m][n] = (f32x4){0.f, 0.f, 0.f, 0.f};
    bf16x8 At[4][2], B0[2][2], B1[2][2];
    const char* cA = (const char*)g.A + (size_t)cur.pm * tstep; const char* cB = (const char*)g.Bt + (size_t)cur.pn * tstep;
    S.a_ready(cur);
    if constexpr (SP2) {
        PG8_STAGE(PG8_SB(0, 0), cB, voffB); PG8_STAGE(PG8_SB(0, 1), cB + hstep, voffB); PG8_STAGE(PG8_SA(0, 0), cA, voffA); PG8_STAGE(PG8_SA(0, 1), cA + hstep, voffA);
        if (wr == 1) PG8_BAR;
        PG8_WAIT_V(2); PG8_BAR;
        PG8_STAGE(PG8_SB(1, 0), cB + kstep, voffB); PG8_STAGE(PG8_SA(1, 0), cA + kstep, voffA); PG8_STAGE(PG8_SB(1, 1), cB + hstep + kstep, voffB);
        PG8_WAIT_V(6); PG8_BAR;
    } else {
        PG8_STAGE(PG8_SB(0, 0), cB, voffB); PG8_STAGE(PG8_SA(0, 0), cA, voffA); PG8_STAGE(PG8_SB(0, 1), cB + hstep, voffB); PG8_STAGE(PG8_SA(0, 1), cA + hstep, voffA);
        if (wr == 1) PG8_BAR;
        PG8_WAIT_V(4); PG8_BAR;
        PG8_STAGE(PG8_SB(1, 0), cB + kstep, voffB); PG8_STAGE(PG8_SA(1, 0), cA + kstep, voffA); PG8_STAGE(PG8_SB(1, 1), cB + hstep + kstep, voffB);
        PG8_WAIT_V(6); PG8_BAR;
    }
    for (;;) {
        const bool has_next = S.next(ui + 1, nxt);
        const char* nA = has_next ? (const char*)g.A + (size_t)nxt.pm * tstep : cA; const char* nB = has_next ? (const char*)g.Bt + (size_t)nxt.pn * tstep : cB;
        for (int t = 0; t < nt; t += 2) {
            const bool last = (t == nt - 2);
            const char* a1 = cA + (size_t)(t + 1) * kstep;
            const char* a2 = last ? nA : cA + (size_t)(t + 2) * kstep; const char* b2 = last ? nB : cB + (size_t)(t + 2) * kstep;
            const char* a3 = a2 + kstep; const char* b3 = b2 + kstep;
            if (last && has_next) S.a_ready(nxt);
            if constexpr (SP2) {
            PG8_LDB(B0, 0, 0); PG8_LDB(B1, 0, 1); PG8_SCHED; PG8_LDA(At, 0, 0); PG8_STAGE(PG8_SA(1, 1), a1 + hstep, voffA);
            PG8_WAIT_V(8); PG8_WAIT_L(0); PG8_BAR; PG8_MMA(0, 0, At, B0); PG8_MMA(0, 1, At, B1); PG8_BAR; PG8_SCHED;
            PG8_LDA(At, 0, 1); PG8_STAGE(PG8_SB(0, 0), b2, voffB); PG8_STAGE(PG8_SB(0, 1), b2 + hstep, voffB); PG8_STAGE(PG8_SA(0, 0), a2, voffA);
            PG8_WAIT_V(8); PG8_WAIT_L(0); PG8_BAR; PG8_MMA(1, 0, At, B0); PG8_MMA(1, 1, At, B1); PG8_BAR; PG8_SCHED;
            PG8_LDB(B0, 1, 0); PG8_LDB(B1, 1, 1); PG8_SCHED; PG8_LDA(At, 1, 0); PG8_STAGE(PG8_SA(0, 1), a2 + hstep, voffA);
            PG8_WAIT_V(8); PG8_WAIT_L(0); PG8_BAR; PG8_MMA(0, 0, At, B0); PG8_MMA(0, 1, At, B1); PG8_BAR; PG8_SCHED;
            PG8_LDA(At, 1, 1); PG8_STAGE(PG8_SB(1, 0), b3, voffB); PG8_STAGE(PG8_SB(1, 1), b3 + hstep, voffB); PG8_STAGE(PG8_SA(1, 0), a3, voffA);
            PG8_WAIT_V(8); PG8_WAIT_L(0); PG8_BAR; PG8_MMA(1, 0, At, B0); PG8_MMA(1, 1, At, B1); PG8_BAR; PG8_SCHED;
            } else {
            PG8_LDB(B0, 0, 0); PG8_SCHED; PG8_LDA(At, 0, 0); PG8_STAGE(PG8_SA(1, 1), a1 + hstep, voffA);
            PG8_WAIT_L(8); PG8_BAR; PG8_WAIT_L(0); PG8_MMA(0, 0, At, B0); PG8_BAR; PG8_SCHED;
            PG8_LDB(B1, 0, 1); PG8_STAGE(PG8_SB(0, 0), b2, voffB);
            PG8_BAR; PG8_WAIT_L(0); PG8_MMA(0, 1, At, B1); PG8_BAR;
            PG8_LDA(At, 0, 1); PG8_STAGE(PG8_SA(0, 0), a2, voffA);
            PG8_BAR; PG8_WAIT_L(0); PG8_MMA(1, 0, At, B0); PG8_BAR; PG8_SCHED;
            PG8_STAGE(PG8_SB(0, 1), b2 + hstep, voffB);
            PG8_WAIT_V(6); PG8_BAR; PG8_MMA(1, 1, At, B1); PG8_BAR;
            PG8_LDB(B0, 1, 0); PG8_SCHED; PG8_LDA(At, 1, 0); PG8_STAGE(PG8_SA(0, 1), a2 + hstep, voffA);
            PG8_WAIT_L(8); PG8_BAR; PG8_WAIT_L(0); PG8_MMA(0, 0, At, B0); PG8_BAR; PG8_SCHED;
            PG8_LDB(B1, 1, 1); PG8_STAGE(PG8_SB(1, 0), b3, voffB);
            PG8_BAR; PG8_WAIT_L(0); PG8_MMA(0, 1, At, B1); PG8_BAR;
            PG8_LDA(At, 1, 1); PG8_STAGE(PG8_SA(1, 0), a3, voffA);
            PG8_BAR; PG8_WAIT_L(0); PG8_MMA(1, 0, At, B0); PG8_BAR; PG8_SCHED;
            PG8_STAGE(PG8_SB(1, 1), b3 + hstep, voffB);
            PG8_WAIT_V(6); PG8_BAR; PG8_MMA(1, 1, At, B1); PG8_BAR;
            }
        }
        if constexpr (ALIGN_EPI) { if (wr == 0) PG8_BAR; }
        E(acc, cur, wr, wc, fr, fq);
        if (!has_next) break;
#pragma unroll
        for (int a = 0; a < 2; ++a)
#pragma unroll
            for (int b = 0; b < 2; ++b)
#pragma unroll
                for (int m = 0; m < 4; ++m)
#pragma unroll
                    for (int n = 0; n < 2; ++n) acc[a][b][m][n] = (f32x4){0.f, 0.f, 0.f, 0.f};
        cur = nxt; cA = nA; cB = nB; ++ui;
        if constexpr (ALIGN_EPI) { if (wr == 1) PG8_BAR; }
    }
    PG8_WAIT_V(0);
    if constexpr (!ALIGN_EPI) { if (wr == 0) PG8_BAR; }
    PG8_BAR;
#undef PG8_SA
#undef PG8_SB
#undef PG8_STAGE
#undef PG8_LDA
#undef PG8_LDB
#undef PG8_MMA
#undef PG8_WAIT_V
#undef PG8_WAIT_L
#undef PG8_BAR
#undef PG8_SCHED
}
}

using pg8::bf16_t; using pg8::f32x4; using pg8::u32x4; using pg8::u32x2; using pg8::bf16x8; using pg8::cvt_pk_bf16;
#define LAS __attribute__((address_space(3)))
typedef short bf16x4 __attribute__((ext_vector_type(4)));
typedef float f32x2 __attribute__((ext_vector_type(2)));
constexpr int D = 1024, SEQ = 4096, MP = 16384, MS = 1024, M = MP + MS, NIN = 5888, DC = 512, FF = 4096;
constexpr int NT = 512;
constexpr float ALPHA = 1.189207115002721f;
constexpr float LN_EPS = 1e-5f;
constexpr int LDS_BYTES = pg8::STAGE_BYTES + 16;

constexpr size_t WS_XB = 0;
constexpr size_t WS_WIN = WS_XB + (size_t)M * D * 2;
constexpr size_t WS_WC = WS_WIN + (size_t)NIN * D * 2;
constexpr size_t WS_WA = WS_WC + (size_t)1024 * 512 * 2;
constexpr size_t WS_WO = WS_WA + (size_t)1024 * 256 * 2;
constexpr size_t WS_WUP = WS_WO + (size_t)1024 * 1024 * 2;
constexpr size_t WS_WDN = WS_WUP + (size_t)4096 * 1024 * 2;
constexpr size_t WS_ROPE = WS_WDN + (size_t)4096 * 1024 * 2;
constexpr size_t WS_ZC = WS_ROPE + (size_t)4096 * 32 * 8;
constexpr size_t WS_QKV = WS_ZC + (size_t)M * 1536 * 2;
constexpr size_t WS_GATE = WS_QKV + (size_t)9 * M * 256 * 2;
constexpr size_t WS_OG = WS_GATE + (size_t)M * 2048 * 2;
constexpr size_t WS_LSE = WS_OG + (size_t)3 * M * 256 * 2;
constexpr size_t WS_YC = WS_LSE + (size_t)3 * M * 4 * 4;
constexpr size_t WS_YA = WS_YC + (size_t)M * 512 * 2;
constexpr size_t WS_MIX = WS_YA + (size_t)M * 256 * 2;
constexpr size_t WS_PRE = WS_MIX + (size_t)M * 1024 * 2;
constexpr size_t WS_X1F = WS_PRE + (size_t)M * 1024 * 4;
constexpr size_t WS_X1B = WS_X1F + (size_t)M * 1024 * 4;
constexpr size_t WS_HID = WS_X1B + (size_t)M * 1024 * 2;
constexpr size_t WS_BAR = WS_HID + (size_t)M * 4096 * 2;
constexpr size_t WS_OGS = WS_BAR + 16384;
constexpr size_t WS_LSES = WS_OGS + (size_t)6 * MS * 256 * 2;
constexpr size_t WS_END = WS_LSES + (size_t)6 * MS * 4 * 4;

constexpr size_t O_YP = 0;
constexpr size_t O_YS = O_YP + (size_t)MP * D;
constexpr size_t O_CP = O_YS + (size_t)MS * D;
constexpr size_t O_KVP0 = O_CP + 4 * 2 * 512;
constexpr size_t O_KVP1 = O_KVP0 + (size_t)4 * 128 * 512;
constexpr size_t O_KVP2 = O_KVP1 + (size_t)4 * 512 * 512;
constexpr size_t O_CS = O_KVP2 + (size_t)4 * 2048 * 512;
constexpr size_t O_KVS0 = O_CS + (size_t)128 * 2 * 512;
constexpr size_t O_KVS1 = O_KVS0 + (size_t)128 * 128 * 512;
constexpr size_t O_KVS2 = O_KVS1 + (size_t)128 * 512 * 512;
constexpr size_t O_END = O_KVS2 + (size_t)128 * 2048 * 512;

struct Params { const float* in[18]; float* out; unsigned char* ws; int ph_lo, ph_hi; };

__device__ __forceinline__ float bflo(unsigned w) { return __builtin_bit_cast(float, w << 16); }
__device__ __forceinline__ float bfhi(unsigned w) { return __builtin_bit_cast(float, w & 0xffff0000u); }
__device__ __forceinline__ float bf1(bf16_t h) { return __builtin_bit_cast(float, (unsigned)h << 16); }
__device__ __forceinline__ float wave_sum(float v) {
#pragma unroll
    for (int o = 1; o < 64; o <<= 1) v += __shfl_xor(v, o);
    return v;
}
__device__ __forceinline__ float wave_max(float v) {
#pragma unroll
    for (int o = 1; o < 64; o <<= 1) v = fmaxf(v, __shfl_xor(v, o));
    return v;
}

using pg8::Unit;
struct Epi1 {
    static constexpr int PERM = 2;
    bf16_t* zc; bf16_t* qkv; bf16_t* gates; const float* bgate; const float* rope; float* out;
    __device__ __forceinline__ void operator()(const f32x4 (&acc)[2][2][4][2], const Unit& u, int wr, int wc, int fr, int fq) const {
        const int row0 = u.pm * 256 + wr * 64 + fr;
        const int cw0 = 64 * (wc >> 1) + 16 * (wc & 1) + 4 * fq;
        if (u.pn < 6) {
#pragma unroll
            for (int ai = 0; ai < 2; ++ai)
#pragma unroll
                for (int m = 0; m < 4; ++m) { bf16_t* rp = zc + (size_t)(row0 + ai * 128 + m * 16) * 1536 + u.pn * 256 + cw0;
#pragma unroll
                    for (int bj = 0; bj < 2; ++bj)
#pragma unroll
                        for (int n = 0; n < 2; ++n) { const f32x4 v = acc[ai][bj][m][n]; u32x2 w; w.x = cvt_pk_bf16(v[0], v[1]); w.y = cvt_pk_bf16(v[2], v[3]); *(u32x2*)(rp + bj * 128 + n * 32) = w; } }
        } else if (u.pn < 15) {
            const int t = u.pn - 6, gi = t / 3, kind = t - 3 * gi;
            bf16_t* dst = qkv + (size_t)(gi * 3 + kind) * M * 256;
            const int Wk = 128 << (2 * gi);
            float* okp = out + (gi == 0 ? O_KVP0 : (gi == 1 ? O_KVP1 : O_KVP2));
            float* oks = out + (gi == 0 ? O_KVS0 : (gi == 1 ? O_KVS1 : O_KVS2));
            const int e0 = 16 * (wc & 1) + 4 * fq;
#pragma unroll
            for (int ai = 0; ai < 2; ++ai)
#pragma unroll
                for (int m = 0; m < 4; ++m) {
                    const int row = row0 + ai * 128 + m * 16;
                    int pos; float* kvb = nullptr;
                    if (row < MP) { const int nb = row >> 12, p = row & 4095; pos = p; const int pk = p - (SEQ - Wk); if (pk >= 0) kvb = okp + ((size_t)(nb * Wk + pk) * 2) * 256; }
                    else { const int rs = row - MP, nb = rs >> 3, tt = rs & 7; pos = 2048 + tt; kvb = oks + ((size_t)(nb * Wk + Wk - 8 + tt) * 2) * 256; }
                    f32x4 cs0 = {1.f, 0.f, 1.f, 0.f}, cs1 = {1.f, 0.f, 1.f, 0.f};
                    if (kind < 2) { const f32x4* rp = (const f32x4*)(rope + ((size_t)pos * 32 + e0) * 2); cs0 = rp[0]; cs1 = rp[1]; }
#pragma unroll
                    for (int bj = 0; bj < 2; ++bj) {
                        f32x4 x1 = acc[ai][bj][m][0], x2 = acc[ai][bj][m][1];
                        if (kind < 2) {
                            const f32x4 c = {cs0[0], cs0[2], cs1[0], cs1[2]}, s = {cs0[1], cs0[3], cs1[1], cs1[3]};
                            const f32x4 o1 = x1 * c - x2 * s, o2 = x2 * c + x1 * s; x1 = o1; x2 = o2;
                            if (kind == 0) { x1 = x1 * 0.125f; x2 = x2 * 0.125f; }
                        }
                        const int hc = (2 * bj + (wc >> 1)) * 64 + e0;
                        u32x2 w1, w2; w1.x = cvt_pk_bf16(x1[0], x1[1]); w1.y = cvt_pk_bf16(x1[2], x1[3]); w2.x = cvt_pk_bf16(x2[0], x2[1]); w2.y = cvt_pk_bf16(x2[2], x2[3]);
                        *(u32x2*)(dst + (size_t)row * 256 + hc) = w1; *(u32x2*)(dst + (size_t)row * 256 + hc + 32) = w2;
                        if (kind >= 1 && kvb) { float* kp = kvb + (kind - 1) * 256 + hc; *(f32x4*)kp = x1; *(f32x4*)(kp + 32) = x2; }
                    }
                    asm volatile("" ::: "memory");
                }
        } else {
            const int cg0 = (u.pn - 15) * 256 + cw0;
#pragma unroll
            for (int bj = 0; bj < 2; ++bj)
#pragma unroll
                for (int n = 0; n < 2; ++n) { const f32x4 bv = *(const f32x4*)(bgate + cg0 + bj * 128 + n * 32);
#pragma unroll
                    for (int ai = 0; ai < 2; ++ai)
#pragma unroll
                        for (int m = 0; m < 4; ++m) { const f32x4 v = acc[ai][bj][m][n] + bv; f32x4 s;
#pragma unroll
                            for (int j = 0; j < 4; ++j) s[j] = __builtin_amdgcn_rcpf(1.0f + __expf(-v[j]));
                            u32x2 w; w.x = cvt_pk_bf16(s[0], s[1]); w.y = cvt_pk_bf16(s[2], s[3]);
                            *(u32x2*)(gates + (size_t)(row0 + ai * 128 + m * 16) * 2048 + cg0 + bj * 128 + n * 32) = w; } }
        }
    }
};
struct Epi3 {
    static constexpr int PERM = 1;
    bf16_t* mix; const bf16_t* gates; int second;
    __device__ __forceinline__ void operator()(const f32x4 (&acc)[2][2][4][2], const Unit& u, int wr, int wc, int fr, int fq) const {
        const int row0 = u.pm * 256 + wr * 64 + fr, col0 = u.pn * 256 + wc * 32 + 8 * fq;
#pragma unroll
        for (int ai = 0; ai < 2; ++ai)
#pragma unroll
            for (int m = 0; m < 4; ++m) { const int row = row0 + ai * 128 + m * 16;
#pragma unroll
                for (int bj = 0; bj < 2; ++bj) { const int c = col0 + bj * 128;
                    const u32x4 g = *(const u32x4*)(gates + (size_t)row * 2048 + second * 1024 + c);
                    f32x4 v0 = acc[ai][bj][m][0], v1 = acc[ai][bj][m][1];
                    v0 = v0 * (f32x4){bflo(g.x), bfhi(g.x), bflo(g.y), bfhi(g.y)}; v1 = v1 * (f32x4){bflo(g.z), bfhi(g.z), bflo(g.w), bfhi(g.w)};
                    bf16_t* mp = mix + (size_t)row * 1024 + c;
                    if (second) { const u32x4 o = *(const u32x4*)mp; v0 = v0 + (f32x4){bflo(o.x), bfhi(o.x), bflo(o.y), bfhi(o.y)}; v1 = v1 + (f32x4){bflo(o.z), bfhi(o.z), bflo(o.w), bfhi(o.w)}; }
                    u32x4 w; w.x = cvt_pk_bf16(v0[0], v0[1]); w.y = cvt_pk_bf16(v0[2], v0[3]); w.z = cvt_pk_bf16(v1[0], v1[1]); w.w = cvt_pk_bf16(v1[2], v1[3]);
                    *(u32x4*)mp = w; }
                asm volatile("" ::: "memory"); }
    }
};
struct EpiRes {
    static constexpr int PERM = 0;
    const float* resA; const float* resB; float* pre;
    __device__ __forceinline__ void operator()(const f32x4 (&acc)[2][2][4][2], const Unit& u, int wr, int wc, int fr, int fq) const {
        const int row0 = u.pm * 256 + wr * 64 + fr, col0 = u.pn * 256 + wc * 32 + 4 * fq;
        const float* res = (u.pm * 256 < MP) ? resA : resB;
#pragma unroll
        for (int ai = 0; ai < 2; ++ai)
#pragma unroll
            for (int m = 0; m < 4; ++m) { const size_t off = (size_t)(row0 + ai * 128 + m * 16) * 1024 + col0;
#pragma unroll
                for (int bj = 0; bj < 2; ++bj)
#pragma unroll
                    for (int n = 0; n < 2; ++n) { const f32x4 r = *(const f32x4*)(res + off + bj * 128 + n * 16); *(f32x4*)(pre + off + bj * 128 + n * 16) = r * ALPHA + acc[ai][bj][m][n]; }
                asm volatile("" ::: "memory"); }
    }
};
struct EpiHid {
    static constexpr int PERM = 1;
    bf16_t* hid;
    __device__ __forceinline__ void operator()(const f32x4 (&acc)[2][2][4][2], const Unit& u, int wr, int wc, int fr, int fq) const {
        const int row0 = u.pm * 256 + wr * 64 + fr, col0 = u.pn * 256 + wc * 32 + 8 * fq;
#pragma unroll
        for (int ai = 0; ai < 2; ++ai)
#pragma unroll
            for (int m = 0; m < 4; ++m) { bf16_t* rp = hid + (size_t)(row0 + ai * 128 + m * 16) * FF + col0;
#pragma unroll
                for (int bj = 0; bj < 2; ++bj) { f32x4 v0 = acc[ai][bj][m][0], v1 = acc[ai][bj][m][1];
#pragma unroll
                    for (int j = 0; j < 4; ++j) { const float a = fmaxf(v0[j], 0.f), b = fmaxf(v1[j], 0.f); v0[j] = a * a; v1[j] = b * b; }
                    u32x4 w; w.x = cvt_pk_bf16(v0[0], v0[1]); w.y = cvt_pk_bf16(v0[2], v0[3]); w.z = cvt_pk_bf16(v1[0], v1[1]); w.w = cvt_pk_bf16(v1[2], v1[3]);
                    *(u32x4*)(rp + bj * 128) = w; } }
    }
};

__device__ __forceinline__ void transpose_item(const float* W, int K, int N, bf16_t* WT, LAS float* scr, int item, int lane) {
    const int nblk = N / 32, kb = item / nblk, nb = item % nblk, k0 = 64 * kb, n0 = 32 * nb;
#pragma unroll 8
    for (int i = 0; i < 32; ++i) { const int kk = 2 * i + (lane >> 5); scr[kk * 33 + (lane & 31)] = W[(size_t)(k0 + kk) * N + n0 + (lane & 31)]; }
    asm volatile("s_waitcnt lgkmcnt(0)" ::: "memory");
    const int c = lane & 7;
#pragma unroll
    for (int j = 0; j < 4; ++j) { const int n = (lane >> 3) + 8 * j; const LAS float* s = scr + (8 * c) * 33 + n;
        u32x4 o; o.x = cvt_pk_bf16(s[0 * 33], s[1 * 33]); o.y = cvt_pk_bf16(s[2 * 33], s[3 * 33]); o.z = cvt_pk_bf16(s[4 * 33], s[5 * 33]); o.w = cvt_pk_bf16(s[6 * 33], s[7 * 33]);
        *(u32x4*)(WT + (size_t)(n0 + n) * K + k0 + 8 * c) = o; }
    asm volatile("s_waitcnt lgkmcnt(0)" ::: "memory");
}

__device__ __forceinline__ void phase_prep(const Params& p, LAS unsigned char* lds) {
    const int tid = fresh_tid(), lane = tid & 63, wave = tid >> 6;
    const size_t gt = (size_t)blockIdx.x * NT + tid, GT = (size_t)gridDim.x * NT;
    unsigned char* ws = p.ws;
    { bf16_t* xb = (bf16_t*)(ws + WS_XB); constexpr size_t NCH = (size_t)M * D / 8, NP = (size_t)MP * D / 8;
      for (size_t i0 = gt; i0 < NCH; i0 += 4 * GT) {
          f32x4 a[4], b[4];
#pragma unroll
          for (int k = 0; k < 4; ++k) { const size_t i = i0 + k * GT; if (i < NCH) { const float* src = (i < NP) ? p.in[0] + i * 8 : p.in[1] + (i - NP) * 8; a[k] = ((const f32x4*)src)[0]; b[k] = ((const f32x4*)src)[1]; } }
#pragma unroll
          for (int k = 0; k < 4; ++k) { const size_t i = i0 + k * GT; if (i < NCH) { u32x4 o; o.x = cvt_pk_bf16(a[k][0], a[k][1]); o.y = cvt_pk_bf16(a[k][2], a[k][3]); o.z = cvt_pk_bf16(b[k][0], b[k][1]); o.w = cvt_pk_bf16(b[k][2], b[k][3]);
              *(u32x4*)(xb + i * 8) = o; } } } }
    { float* rt = (float*)(ws + WS_ROPE);
      for (size_t i = gt; i < (size_t)4096 * 32; i += GT) { const int pos = (int)(i >> 5), f = (int)(i & 31);
          const float inv = 1.0f / exp2f((float)f * (13.287712379549449f / 32.0f));
          const float ang = (float)pos * inv;
          const double rev = (double)ang * 0.15915494309189535; const float fr = (float)(rev - floor(rev));
          rt[2 * i] = __builtin_amdgcn_cosf(fr); rt[2 * i + 1] = __builtin_amdgcn_sinf(fr); } }
    { LAS float* scr = (LAS float*)(lds + wave * 16384);
      const int gw = blockIdx.x * 8 + wave, NGW = gridDim.x * 8;
      constexpr int I_IN = (D / 64) * (NIN / 32), I_C = (DC / 64) * (D / 32), I_A = (256 / 64) * (D / 32), I_O = (D / 64) * (D / 32), I_UP = (D / 64) * (FF / 32), I_DN = (FF / 64) * (D / 32);
      constexpr int NITEMS = I_IN + I_C + I_A + I_O + I_UP + I_DN;
      for (int it = gw; it < NITEMS; it += NGW) { int r = it;
          if (r < I_IN) { transpose_item(p.in[6], D, NIN, (bf16_t*)(ws + WS_WIN), scr, r, lane); continue; } r -= I_IN;
          if (r < I_C) { transpose_item(p.in[9], DC, D, (bf16_t*)(ws + WS_WC), scr, r, lane); continue; } r -= I_C;
          if (r < I_A) { transpose_item(p.in[10], 256, D, (bf16_t*)(ws + WS_WA), scr, r, lane); continue; } r -= I_A;
          if (r < I_O) { transpose_item(p.in[11], D, D, (bf16_t*)(ws + WS_WO), scr, r, lane); continue; } r -= I_O;
          if (r < I_UP) { transpose_item(p.in[14], D, FF, (bf16_t*)(ws + WS_WUP), scr, r, lane); continue; } r -= I_UP;
          transpose_item(p.in[15], FF, D, (bf16_t*)(ws + WS_WDN), scr, r, lane); } }
}

constexpr int KS_STRIDE = 144;
constexpr int VT_STRIDE = 528;
constexpr int KS_OFF = 0, VT_OFF = 256 * KS_STRIDE;
__device__ __forceinline__ void attn_prompt_item(const Params& p, LAS unsigned char* lds, int item) {
    const int tid = fresh_tid(), lane = tid & 63, w = tid >> 6, fr = lane & 15, s = lane >> 4;
    const int g = item >> 9, rem = item & 511, nb = rem >> 7, rem2 = rem & 127, h = rem2 >> 5, rb = rem2 & 31;
    const int dsh = 2 * g, d = 1 << dsh, nbk = 32 >> dsh, r = rb / nbk, b = rb - r * nbk;
    const bf16_t* qb = (const bf16_t*)(p.ws + WS_QKV) + (size_t)(3 * g) * M * 256;
    const bf16_t* kb = qb + (size_t)M * 256; const bf16_t* vb = kb + (size_t)M * 256;
    const size_t rowbase = (size_t)nb * SEQ + r;
    const int i0 = 128 * (b - 1);
#pragma unroll
    for (int ii = 0; ii < 4; ++ii) { const int c = tid + NT * ii, kl = c >> 3, ch = c & 7; int ik = i0 + kl; ik = ik < 0 ? 0 : ik;
        const u32x4 v = *(const u32x4*)(kb + (rowbase + (size_t)ik * d) * 256 + h * 64 + ch * 8);
        *(LAS u32x4*)(lds + KS_OFF + kl * KS_STRIDE + ch * 16) = v; }
#pragma unroll
    for (int ii = 0; ii < 4; ++ii) { const int c = tid + NT * ii, kl = c & 255, ch = c >> 8; int ik = i0 + kl; ik = ik < 0 ? 0 : ik;
        const u32x4 v = *(const u32x4*)(vb + (rowbase + (size_t)ik * d) * 256 + h * 64 + ch * 8);
        LAS bf16_t* vt = (LAS bf16_t*)(lds + VT_OFF + (ch * 8) * VT_STRIDE) + kl;
        vt[0 * (VT_STRIDE / 2)] = (bf16_t)(v.x & 0xffff); vt[1 * (VT_STRIDE / 2)] = (bf16_t)(v.x >> 16);
        vt[2 * (VT_STRIDE / 2)] = (bf16_t)(v.y & 0xffff); vt[3 * (VT_STRIDE / 2)] = (bf16_t)(v.y >> 16);
        vt[4 * (VT_STRIDE / 2)] = (bf16_t)(v.z & 0xffff); vt[5 * (VT_STRIDE / 2)] = (bf16_t)(v.z >> 16);
        vt[6 * (VT_STRIDE / 2)] = (bf16_t)(v.w & 0xffff); vt[7 * (VT_STRIDE / 2)] = (bf16_t)(v.w >> 16); }
    const int iq = 128 * b + 16 * w + fr; const size_t qrow = rowbase + (size_t)iq * d;
    const bf16x8 q0 = *(const bf16x8*)(qb + qrow * 256 + h * 64 + 8 * s), q1 = *(const bf16x8*)(qb + qrow * 256 + h * 64 + 32 + 8 * s);
    __syncthreads();
    f32x4 sc[9];
#pragma unroll
    for (int j = 0; j < 9; ++j) {
        const LAS unsigned char* kp = lds + KS_OFF + (16 * (w + j) + fr) * KS_STRIDE + s * 16;
        const bf16x8 k0 = *(const LAS bf16x8*)kp, k1 = *(const LAS bf16x8*)(kp + 64);
        f32x4 a = {0.f, 0.f, 0.f, 0.f};
        a = __builtin_amdgcn_mfma_f32_16x16x32_bf16(k0, q0, a, 0, 0, 0);
        a = __builtin_amdgcn_mfma_f32_16x16x32_bf16(k1, q1, a, 0, 0, 0);
        sc[j] = a;
    }
    float mx = -INFINITY;
#pragma unroll
    for (int j = 0; j < 9; ++j)
#pragma unroll
        for (int i = 0; i < 4; ++i) { const int dist = 128 - 16 * j + fr - 4 * s - i; const int kl = 16 * (w + j) + 4 * s + i;
            const bool ok = (dist >= 0) && (dist <= 128) && (b > 0 || kl >= 128);
            sc[j][i] = ok ? sc[j][i] : -INFINITY; mx = fmaxf(mx, sc[j][i]); }
    mx = fmaxf(mx, __shfl_xor(mx, 16)); mx = fmaxf(mx, __shfl_xor(mx, 32));
    float sum = 0.f;
#pragma unroll
    for (int j = 0; j < 9; ++j)
#pragma unroll
        for (int i = 0; i < 4; ++i) { const float e = __expf(sc[j][i] - mx); sc[j][i] = e; sum += e; }
    sum += __shfl_xor(sum, 16); sum += __shfl_xor(sum, 32);
    f32x4 o[4];
#pragma unroll
    for (int dt = 0; dt < 4; ++dt) o[dt] = (f32x4){0.f, 0.f, 0.f, 0.f};
#pragma unroll
    for (int j = 0; j < 9; ++j) {
        u32x2 pw; pw.x = cvt_pk_bf16(sc[j][0], sc[j][1]); pw.y = cvt_pk_bf16(sc[j][2], sc[j][3]);
        const bf16x4 pf = __builtin_bit_cast(bf16x4, pw);
#pragma unroll
        for (int dt = 0; dt < 4; ++dt) {
            const bf16x4 vf = *(const LAS bf16x4*)(lds + VT_OFF + (16 * dt + fr) * VT_STRIDE + (16 * (w + j) + 4 * s) * 2);
            o[dt] = __builtin_amdgcn_mfma_f32_16x16x16bf16_1k(vf, pf, o[dt], 0, 0, 0);
        }
    }
    const float inv = 1.0f / sum;
    bf16_t* og = (bf16_t*)(p.ws + WS_OG) + (size_t)g * M * 256 + qrow * 256 + h * 64;
#pragma unroll
    for (int dt = 0; dt < 4; ++dt) { u32x2 ww; ww.x = cvt_pk_bf16(o[dt][0] * inv, o[dt][1] * inv); ww.y = cvt_pk_bf16(o[dt][2] * inv, o[dt][3] * inv); *(u32x2*)(og + 16 * dt + 4 * s) = ww; }
    if (s == 0) ((float*)(p.ws + WS_LSE))[((size_t)g * M + qrow) * 4 + h] = mx + __logf(sum);
    __syncthreads();
}

__device__ __forceinline__ void attn_sample_unit(const Params& p, LAS unsigned char* lds, int unit) {
    const int tid = fresh_tid(), lane = tid & 63, w = tid >> 6, ks = lane >> 4, dq = lane & 15;
    LAS float* ps = (LAS float*)(lds + w * 1024);
    const int it_ = unit >> 3, h = w & 3, t = 2 * (it_ & 3) + (w >> 2), g = (it_ >> 2) % 3, n = it_ / 12;
    const int dsh = 2 * g, d = 1 << dsh, W = 128 << dsh;
    const int nnew = (t >> dsh) + 1, ncache = 129 - nnew, idx0 = W + t - nnew * d;
    const size_t row = (size_t)MP + n * 8 + t;
    const bf16_t* qb = (const bf16_t*)(p.ws + WS_QKV) + (size_t)(3 * g) * M * 256 + h * 64 + 4 * dq;
    const bf16_t* kb = qb + (size_t)M * 256; const bf16_t* vb = kb + (size_t)M * 256;
    const float* cache = p.in[3 + g] + (size_t)n * W * 512 + h * 64 + 4 * dq;
    const u32x2 qq = *(const u32x2*)(qb + row * 256);
    const f32x4 qv = {bflo(qq.x), bfhi(qq.x), bflo(qq.y), bfhi(qq.y)};
    const size_t step = (size_t)4 * d * 512;
    { const float* kp = cache + (size_t)(idx0 - ks * d) * 512;
#pragma unroll 8
      for (int jj = 0; jj < 32; ++jj) {
          const f32x4 k = *(const f32x4*)kp; kp -= step;
          float a = (k[0] * qv[0] + k[1] * qv[1]) + (k[2] * qv[2] + k[3] * qv[3]);
          a += __shfl_xor(a, 1); a += __shfl_xor(a, 2); a += __shfl_xor(a, 4); a += __shfl_xor(a, 8);
          if (dq == 0) ps[4 * jj + ks] = (4 * jj + ks < ncache) ? a : -INFINITY;
      } }
#pragma unroll
    for (int i = 0; i < 2; ++i) { const int l = ks + 4 * i, lc = l < nnew ? l : 0;
        const u32x2 kk = *(const u32x2*)(kb + ((size_t)MP + n * 8 + (t - lc * d)) * 256);
        float a = (bflo(kk.x) * qv[0] + bfhi(kk.x) * qv[1]) + (bflo(kk.y) * qv[2] + bfhi(kk.y) * qv[3]);
        a += __shfl_xor(a, 1); a += __shfl_xor(a, 2); a += __shfl_xor(a, 4); a += __shfl_xor(a, 8);
        if (dq == 0) ps[128 + l] = (l < nnew) ? a : -INFINITY; }
    asm volatile("s_waitcnt lgkmcnt(0)" ::: "memory");
    const float s0 = ps[lane], s1 = ps[lane + 64], s2 = lane < 8 ? ps[128 + lane] : -INFINITY;
    const float mx = wave_max(fmaxf(fmaxf(s0, s1), s2));
    const float e0 = __expf(s0 - mx), e1 = __expf(s1 - mx), e2 = __expf(s2 - mx);
    asm volatile("s_waitcnt lgkmcnt(0)" ::: "memory");
    ps[lane] = e0; ps[lane + 64] = e1; if (lane < 8) ps[128 + lane] = e2;
    const float sum = wave_sum(e0 + e1 + e2);
    asm volatile("s_waitcnt lgkmcnt(0)" ::: "memory");
    f32x4 o = {0.f, 0.f, 0.f, 0.f};
    { const float* vp = cache + 256 + (size_t)(idx0 - ks * d) * 512;
#pragma unroll 8
      for (int jj = 0; jj < 32; ++jj) { const f32x4 v = *(const f32x4*)vp; vp -= step; o = o + v * ps[4 * jj + ks]; } }
#pragma unroll
    for (int i = 0; i < 2; ++i) { const int l = ks + 4 * i, lc = l < nnew ? l : 0;
        const u32x2 vv = *(const u32x2*)(vb + ((size_t)MP + n * 8 + (t - lc * d)) * 256);
        o = o + (f32x4){bflo(vv.x), bfhi(vv.x), bflo(vv.y), bfhi(vv.y)} * ps[128 + l]; }
#pragma unroll
    for (int i = 0; i < 4; ++i) { o[i] += __shfl_xor(o[i], 16); o[i] += __shfl_xor(o[i], 32); }
    const float inv = 1.0f / sum;
    if (ks == 0) { u32x2 ww; ww.x = cvt_pk_bf16(o[0] * inv, o[1] * inv); ww.y = cvt_pk_bf16(o[2] * inv, o[3] * inv);
        *(u32x2*)((bf16_t*)(p.ws + WS_OG) + (size_t)g * M * 256 + row * 256 + h * 64 + 4 * dq) = ww; }
    if (lane == 0) ((float*)(p.ws + WS_LSE))[((size_t)g * M + row) * 4 + h] = mx + __logf(sum);
    asm volatile("s_waitcnt lgkmcnt(0)" ::: "memory");
}

__device__ __forceinline__ float dpp_add16(float a) {
    a += __builtin_bit_cast(float, __builtin_amdgcn_update_dpp(0, __builtin_bit_cast(int, a), 0xB1, 0xF, 0xF, false));
    a += __builtin_bit_cast(float, __builtin_amdgcn_update_dpp(0, __builtin_bit_cast(int, a), 0x4E, 0xF, 0xF, false));
    a += __builtin_bit_cast(float, __builtin_amdgcn_update_dpp(0, __builtin_bit_cast(int, a), 0x141, 0xF, 0xF, false));
    a += __builtin_bit_cast(float, __builtin_amdgcn_update_dpp(0, __builtin_bit_cast(int, a), 0x140, 0xF, 0xF, false));
    return a;
}
struct SoftAcc { float m, l; f32x4 o; };
__device__ __forceinline__ void soft_update4(SoftAcc& A, const float (&sc)[4], const f32x4 (&v)[4]) {
    const float mn = fmaxf(fmaxf(fmaxf(sc[0], sc[1]), fmaxf(sc[2], sc[3])), A.m);
    const float corr = __expf(A.m - mn);
    const float p0 = __expf(sc[0] - mn), p1 = __expf(sc[1] - mn), p2 = __expf(sc[2] - mn), p3 = __expf(sc[3] - mn);
    A.l = A.l * corr + ((p0 + p1) + (p2 + p3));
    A.o = A.o * corr + ((v[0] * p0 + v[1] * p1) + (v[2] * p2 + v[3] * p3));
    A.m = mn;
}
template <int GI>
__device__ __forceinline__ void sac_unit(const Params& p, int n, int kh) {
    constexpr int dsh = 2 * GI, d = 1 << dsh, W = 128 << dsh;
    const int tid = threadIdx.x, lane = tid & 63, w = tid >> 6, dq = lane & 15, h = lane >> 4;
    const int t = w, nnew = (t >> dsh) + 1, ncache = 129 - nnew, idx0 = W - d + (t & (d - 1));
    const size_t srow = (size_t)n * 8 + t, row = (size_t)MP + srow;
    const bf16_t* qb = (const bf16_t*)(p.ws + WS_QKV) + (size_t)(3 * GI) * M * 256 + lane * 4;
    const bf16_t* kb = qb + (size_t)M * 256; const bf16_t* vb = kb + (size_t)M * 256;
    const u32x2 qq = *(const u32x2*)(qb + row * 256);
    const f32x4 qv = {bflo(qq.x), bfhi(qq.x), bflo(qq.y), bfhi(qq.y)};
    const float* cbase = p.in[3 + GI] + (size_t)n * W * 512 + lane * 4;
    float* obase = p.out + (GI == 0 ? O_KVS0 : (GI == 1 ? O_KVS1 : O_KVS2)) + (size_t)n * W * 512 + lane * 4;
    SoftAcc A; A.m = -INFINITY; A.l = 0.f; A.o = (f32x4){0.f, 0.f, 0.f, 0.f};
    const int c0 = kh ? 0 : 64;
#pragma unroll 1
    for (int cc = 0; cc < 64; cc += 4) {
        f32x4 k[4], v[4], k2[4], v2[4];
#pragma unroll
        for (int i = 0; i < 4; ++i) { const float* rp = cbase + (size_t)(idx0 - (c0 + cc + i) * d) * 512;
            if (GI == 2) { k[i] = __builtin_nontemporal_load((const f32x4*)rp); v[i] = __builtin_nontemporal_load((const f32x4*)(rp + 256)); k2[i] = __builtin_nontemporal_load((const f32x4*)(rp + 8 * 512)); v2[i] = __builtin_nontemporal_load((const f32x4*)(rp + 8 * 512 + 256)); }
            else { k[i] = *(const f32x4*)rp; v[i] = *(const f32x4*)(rp + 256); } }
        float sc[4];
#pragma unroll
        for (int i = 0; i < 4; ++i) { const float a = dpp_add16((k[i][0] * qv[0] + k[i][1] * qv[1]) + (k[i][2] * qv[2] + k[i][3] * qv[3])); sc[i] = (c0 + cc + i < ncache) ? a : -INFINITY; }
        soft_update4(A, sc, v);
#pragma unroll
        for (int i = 0; i < 4; ++i) { const int idx = idx0 - (c0 + cc + i) * d;
            const bool mine = (GI == 2) ? true : (GI == 1 ? (w < 4) : ((idx & 7) == w));
            if (mine && idx >= 8) { float* op = obase + (size_t)(idx - 8) * 512; __builtin_nontemporal_store(k[i], (f32x4*)op); __builtin_nontemporal_store(v[i], (f32x4*)(op + 256)); }
            if (GI == 2) { float* op = obase + (size_t)idx * 512; __builtin_nontemporal_store(k2[i], (f32x4*)op); __builtin_nontemporal_store(v2[i], (f32x4*)(op + 256)); } }
    }
    if (kh) {
#pragma unroll
        for (int gq = 0; gq < 2; ++gq) {
            float sc[4]; f32x4 v[4];
#pragma unroll
            for (int i = 0; i < 4; ++i) { const int l = 4 * gq + i, lc = l < nnew ? l : 0; const size_t kr = ((size_t)MP + n * 8 + (t - lc * d)) * 256;
                const u32x2 kk = *(const u32x2*)(kb + kr), vv = *(const u32x2*)(vb + kr);
                const float a = dpp_add16((bflo(kk.x) * qv[0] + bfhi(kk.x) * qv[1]) + (bflo(kk.y) * qv[2] + bfhi(kk.y) * qv[3]));
                sc[i] = (l < nnew) ? a : -INFINITY; v[i] = (f32x4){bflo(vv.x), bfhi(vv.x), bflo(vv.y), bfhi(vv.y)}; }
            soft_update4(A, sc, v);
        }
    }
    const float inv = 1.0f / A.l; const int pg = 2 * GI + kh;
    u32x2 ww; ww.x = cvt_pk_bf16(A.o[0] * inv, A.o[1] * inv); ww.y = cvt_pk_bf16(A.o[2] * inv, A.o[3] * inv);
    *(u32x2*)((bf16_t*)(p.ws + WS_OGS) + ((size_t)pg * MS + srow) * 256 + lane * 4) = ww;
    if (dq == 0) ((float*)(p.ws + WS_LSES))[((size_t)pg * MS + srow) * 4 + h] = A.m + __logf(A.l);
}
__device__ __forceinline__ void phase_sample_attn_copy(const Params& p) {
    for (int u = blockIdx.x; u < 256; u += gridDim.x) { const int n = u >> 1, kh = u & 1; sac_unit<2>(p, n, kh); sac_unit<1>(p, n, kh); sac_unit<0>(p, n, kh); }
}

__device__ __forceinline__ void load_u8(const bf16_t* zc, size_t row, int c, float (&u)[8]) {
    const u32x4 a = *(const u32x4*)(zc + row * 1536 + 512 + c), b = *(const u32x4*)(zc + row * 1536 + 1024 + c);
    u[0] = bflo(a.x) * bflo(b.x); u[1] = bfhi(a.x) * bfhi(b.x); u[2] = bflo(a.y) * bflo(b.y); u[3] = bfhi(a.y) * bfhi(b.y);
    u[4] = bflo(a.z) * bflo(b.z); u[5] = bfhi(a.z) * bfhi(b.z); u[6] = bflo(a.w) * bflo(b.w); u[7] = bfhi(a.w) * bfhi(b.w);
}
__device__ __forceinline__ void phase_conv(const Params& p) {
    const bf16_t* zc = (const bf16_t*)(p.ws + WS_ZC); bf16_t* yc = (bf16_t*)(p.ws + WS_YC);
    const float* cw = p.in[8]; const float* st = p.in[2];
    const size_t gt = (size_t)blockIdx.x * NT + fresh_tid(), GT = (size_t)gridDim.x * NT;
    for (size_t i = gt; i < (size_t)M * 64; i += GT) {
        const size_t row = i >> 6; const int c = (int)(i & 63) * 8;
        float u0[8], u1[8], u2[8];
        load_u8(zc, row, c, u2);
        int tpos; int nb = 0; const bool prm = row < MP;
        if (prm) tpos = (int)(row & 4095); else { const int rs = (int)(row - MP); nb = rs >> 3; tpos = rs & 7; }
        if (tpos >= 1) load_u8(zc, row - 1, c, u1);
        else if (prm) {
#pragma unroll
            for (int e = 0; e < 8; ++e) u1[e] = 0.f; }
        else { const f32x4 a = *(const f32x4*)(st + ((size_t)nb * 2 + 1) * 512 + c), b = *(const f32x4*)(st + ((size_t)nb * 2 + 1) * 512 + c + 4);
            u1[0] = a[0]; u1[1] = a[1]; u1[2] = a[2]; u1[3] = a[3]; u1[4] = b[0]; u1[5] = b[1]; u1[6] = b[2]; u1[7] = b[3]; }
        if (tpos >= 2) load_u8(zc, row - 2, c, u0);
        else if (prm) {
#pragma unroll
            for (int e = 0; e < 8; ++e) u0[e] = 0.f; }
        else { const int si = tpos;
            const f32x4 a = *(const f32x4*)(st + ((size_t)nb * 2 + si) * 512 + c), b = *(const f32x4*)(st + ((size_t)nb * 2 + si) * 512 + c + 4);
            u0[0] = a[0]; u0[1] = a[1]; u0[2] = a[2]; u0[3] = a[3]; u0[4] = b[0]; u0[5] = b[1]; u0[6] = b[2]; u0[7] = b[3]; }
        const u32x4 bb = *(const u32x4*)(zc + row * 1536 + c);
        const float Bv[8] = {bflo(bb.x), bfhi(bb.x), bflo(bb.y), bfhi(bb.y), bflo(bb.z), bfhi(bb.z), bflo(bb.w), bfhi(bb.w)};
        float y[8];
#pragma unroll
        for (int e = 0; e < 8; ++e) y[e] = Bv[e] * (cw[c + e] * u0[e] + cw[512 + c + e] * u1[e] + cw[1024 + c + e] * u2[e]);
        u32x4 o; o.x = cvt_pk_bf16(y[0], y[1]); o.y = cvt_pk_bf16(y[2], y[3]); o.z = cvt_pk_bf16(y[4], y[5]); o.w = cvt_pk_bf16(y[6], y[7]);
        *(u32x4*)(yc + row * 512 + c) = o;
        float* so = nullptr;
        if (prm) { if (tpos >= SEQ - 2) so = p.out + O_CP + ((size_t)(row >> 12) * 2 + (tpos - (SEQ - 2))) * 512 + c; }
        else if (tpos >= 6) so = p.out + O_CS + ((size_t)nb * 2 + (tpos - 6)) * 512 + c;
        if (so) { *(f32x4*)so = (f32x4){u2[0], u2[1], u2[2], u2[3]}; *(f32x4*)(so + 4) = (f32x4){u2[4], u2[5], u2[6], u2[7]}; }
    }
}

constexpr int CP_PIECE = 8192;
constexpr int CP_UNITS_N = 2 + 8 + 32;
constexpr int CP_UNITS = 128 * CP_UNITS_N;
__device__ __forceinline__ void copy_unit(const Params& p, int unit) {
    const int n = unit / CP_UNITS_N, q = unit - n * CP_UNITS_N;
    const int g = q < 2 ? 0 : (q < 10 ? 1 : 2), piece = q - (g == 0 ? 0 : (g == 1 ? 2 : 10));
    const int W = 128 << (2 * g);
    const size_t per = (size_t)(W - 8) * 128, full = (size_t)W * 128;
    const f32x4* src = (const f32x4*)p.in[3 + g] + n * full + 1024 + (size_t)piece * CP_PIECE;
    f32x4* dst = (f32x4*)(p.out + (g == 0 ? O_KVS0 : (g == 1 ? O_KVS1 : O_KVS2))) + n * full + (size_t)piece * CP_PIECE;
    const int cnt = (int)((per - (size_t)piece * CP_PIECE) < (size_t)CP_PIECE ? (per - (size_t)piece * CP_PIECE) : (size_t)CP_PIECE);
    const int tid = fresh_tid();
#pragma unroll
    for (int u = 0; u < 2; ++u) {
        f32x4 v[8];
#pragma unroll
        for (int k = 0; k < 8; ++k) { const int idx = tid + (u * 8 + k) * NT; if (idx < cnt) v[k] = __builtin_nontemporal_load(src + idx); }
#pragma unroll
        for (int k = 0; k < 8; ++k) { const int idx = tid + (u * 8 + k) * NT; if (idx < cnt) __builtin_nontemporal_store(v[k], dst + idx); }
    }
}
__device__ __forceinline__ void phase_copy(const Params& p) {
    for (int u = blockIdx.x; u < CP_UNITS; u += gridDim.x) copy_unit(p, u);
}

template <int NG>
__device__ __forceinline__ void merge_rows(const bf16_t* og, const float* lse, size_t gstride_rows, size_t row, int c, bf16_t* dst) {
    const int h = c >> 6; float l[NG], mx = -INFINITY;
#pragma unroll
    for (int g = 0; g < NG; ++g) { l[g] = lse[((size_t)g * gstride_rows + row) * 4 + h]; mx = fmaxf(mx, l[g]); }
    float ws = 0.f;
#pragma unroll
    for (int g = 0; g < NG; ++g) { l[g] = __expf(l[g] - mx); ws += l[g]; }
    const float inv = 1.0f / ws; float acc[8];
#pragma unroll
    for (int e = 0; e < 8; ++e) acc[e] = 0.f;
#pragma unroll
    for (int g = 0; g < NG; ++g) { const u32x4 a = *(const u32x4*)(og + ((size_t)g * gstride_rows + row) * 256 + c); const float wg = l[g] * inv;
        acc[0] += wg * bflo(a.x); acc[1] += wg * bfhi(a.x); acc[2] += wg * bflo(a.y); acc[3] += wg * bfhi(a.y); acc[4] += wg * bflo(a.z); acc[5] += wg * bfhi(a.z); acc[6] += wg * bflo(a.w); acc[7] += wg * bfhi(a.w); }
    u32x4 o; o.x = cvt_pk_bf16(acc[0], acc[1]); o.y = cvt_pk_bf16(acc[2], acc[3]); o.z = cvt_pk_bf16(acc[4], acc[5]); o.w = cvt_pk_bf16(acc[6], acc[7]);
    *(u32x4*)dst = o;
}
__device__ __forceinline__ void phase_merge(const Params& p) {
    bf16_t* ya = (bf16_t*)(p.ws + WS_YA);
    const size_t gt = (size_t)blockIdx.x * NT + threadIdx.x, GT = (size_t)gridDim.x * NT;
    for (size_t i = gt; i < (size_t)M * 32; i += GT) {
        const size_t row = i >> 5; const int c = (int)(i & 31) * 8;
        if (row < MP) merge_rows<3>((const bf16_t*)(p.ws + WS_OG), (const float*)(p.ws + WS_LSE), M, row, c, ya + row * 256 + c);
        else merge_rows<6>((const bf16_t*)(p.ws + WS_OGS), (const float*)(p.ws + WS_LSES), MS, row - MP, c, ya + row * 256 + c);
    }
}

template <bool FINAL>
__device__ __forceinline__ void phase_ln(const Params& p, const float* gam, const float* bet) {
    const int tid = fresh_tid(), lane = tid & 63, w = tid >> 6;
    const float* pre = (const float*)(p.ws + WS_PRE);
    f32x4 gv[4], bv[4];
#pragma unroll
    for (int j = 0; j < 4; ++j) { gv[j] = ((const f32x4*)gam)[lane + 64 * j]; bv[j] = ((const f32x4*)bet)[lane + 64 * j]; }
    for (int row = blockIdx.x * 8 + w; row < M; row += gridDim.x * 8) {
        const f32x4* xr = (const f32x4*)(pre + (size_t)row * 1024) + lane;
        f32x4 v[4]; float s = 0.f;
#pragma unroll
        for (int j = 0; j < 4; ++j) { v[j] = xr[64 * j]; s += (v[j][0] + v[j][1]) + (v[j][2] + v[j][3]); }
        const float mean = wave_sum(s) * (1.f / 1024.f); float s2 = 0.f;
#pragma unroll
        for (int j = 0; j < 4; ++j) { v[j] = v[j] - mean; s2 += (v[j][0] * v[j][0] + v[j][1] * v[j][1]) + (v[j][2] * v[j][2] + v[j][3] * v[j][3]); }
        const float rstd = 1.f / sqrtf(wave_sum(s2) * (1.f / 1024.f) + LN_EPS);
#pragma unroll
        for (int j = 0; j < 4; ++j) { const f32x4 y = v[j] * rstd * gv[j] + bv[j];
            if (FINAL) { ((f32x4*)(p.out + (size_t)row * 1024))[lane + 64 * j] = y; }
            else { ((f32x4*)(p.ws + WS_X1F + (size_t)row * 4096))[lane + 64 * j] = y;
                u32x2 ww; ww.x = cvt_pk_bf16(y[0], y[1]); ww.y = cvt_pk_bf16(y[2], y[3]); ((u32x2*)(p.ws + WS_X1B + (size_t)row * 2048))[lane + 64 * j] = ww; } }
    }
}


#define XB_TMO      128
#define XB_XCNT(j)  (256  + 64 * (j))
#define XB_XSUB(j)  (1280 + 64 * (j))
#define XB_XGEN(j)  (2304 + 64 * (j))
#define XB_TOP      3328
#define XB_TOPGEN   3392
#define XCD_BAR_WORDS 3456
#define XB_SPIN_CAP (1u << 18)
__device__ __forceinline__ unsigned xb_ld(unsigned* p)              { return __hip_atomic_load(p, __ATOMIC_RELAXED, __HIP_MEMORY_SCOPE_AGENT); }
__device__ __forceinline__ unsigned xb_add(unsigned* p, unsigned v) { return __hip_atomic_fetch_add(p, v, __ATOMIC_RELAXED, __HIP_MEMORY_SCOPE_AGENT); }
__device__ __forceinline__ unsigned xb_xcc_id() { return (unsigned)__builtin_amdgcn_s_getreg((3 << 11) | 20) & 0xFu; }
#define XB_SPIN(cond, bar) do { unsigned _sp = 0; while (cond) { __builtin_amdgcn_s_sleep(1); \
    if ((++_sp & 255u) == 0u) { if (xb_ld(&(bar)[XB_TMO])) break; if (_sp > XB_SPIN_CAP) { atomicAdd(&(bar)[XB_TMO], 1u); break; } } } } while (0)
struct XcdBarrier { unsigned* bar; unsigned x; volatile LAS unsigned* st; };
__device__ __forceinline__ XcdBarrier xcd_barrier_post(unsigned* bar, volatile LAS unsigned* st) {
    XcdBarrier b; b.bar = bar; b.x = xb_xcc_id(); b.st = st;
    if (threadIdx.x == 0) (void)xb_add(&bar[XB_XCNT(b.x)], 1u);
    return b;
}
__device__ __forceinline__ void xcd_barrier_complete(unsigned* bar, unsigned x, unsigned& nloc, unsigned& nx) {
    const unsigned G = gridDim.x * gridDim.y * gridDim.z;
    unsigned sum, cnt, mine, sp = 0u;
    for (;;) {
        sum = 0u; cnt = 0u; mine = 0u;
#pragma unroll
        for (unsigned j = 0; j < 16; ++j) { const unsigned c = xb_ld(&bar[XB_XCNT(j)]); sum += c; cnt += (c > 0u) ? 1u : 0u; mine = (j == x) ? c : mine; }
        if (sum == G) break;
        __builtin_amdgcn_s_sleep(1);
        if ((++sp & 255u) == 0u) { if (xb_ld(&bar[XB_TMO])) break; if (sp > XB_SPIN_CAP) { atomicAdd(&bar[XB_TMO], 1u); break; } }
    }
    nloc = mine > 0u ? mine : 1u; nx = cnt > 0u ? cnt : 1u;
}
__device__ __forceinline__ void xcd_barrier(const XcdBarrier& b) {
    asm volatile("s_waitcnt vmcnt(0)" ::: "memory");
    __syncthreads();
    if (threadIdx.x == 0) {
        unsigned* bar = b.bar;
        __builtin_amdgcn_s_waitcnt(0);
        unsigned nloc = b.st[0], nx = b.st[1];
        if (nloc == 0u) { xcd_barrier_complete(bar, b.x, nloc, nx); b.st[0] = nloc; b.st[1] = nx; }
        const unsigned old = xb_add(&bar[XB_XSUB(b.x)], 1u);
        const unsigned gen = old / nloc;
        if (old + 1u == (gen + 1u) * nloc) {
            __builtin_amdgcn_fence(__ATOMIC_RELEASE, "agent");
            asm volatile("s_waitcnt vmcnt(0)" ::: "memory");
            const unsigned og = xb_add(&bar[XB_TOP], 1u);
            const unsigned tg = og / nx;
            if (og + 1u == (tg + 1u) * nx) xb_add(&bar[XB_TOPGEN], 1u);
            else XB_SPIN(xb_ld(&bar[XB_TOPGEN]) == tg, bar);
            __builtin_amdgcn_fence(__ATOMIC_ACQUIRE, "agent");
            xb_add(&bar[XB_XGEN(b.x)], 1u);
            asm volatile("s_waitcnt vmcnt(0)" ::: "memory");
        } else {
            XB_SPIN(xb_ld(&bar[XB_XGEN(b.x)]) == gen, bar);
            __builtin_amdgcn_fence(__ATOMIC_ACQUIRE, "agent");
            asm volatile("s_waitcnt vmcnt(0)" ::: "memory");
        }
    }
    __syncthreads();
}

constexpr int N_PHASES = 10;
__global__ void __launch_bounds__(NT, 2) fwd_kernel(Params p) {
    extern __shared__ __attribute__((aligned(16))) unsigned char smem[];
    LAS unsigned char* lds = (LAS unsigned char*)smem;
    unsigned char* ws = p.ws;
    const int G = gridDim.x, bx = blockIdx.x;
#if MK_MULTI
#define SYNC() do {} while (0)
#else
    cg::grid_group grid = cg::this_grid();
    if (p.ph_lo < 0) grid.sync();
    volatile LAS unsigned* xst = (volatile LAS unsigned*)(lds + pg8::STAGE_BYTES);
    if (threadIdx.x < 4) xst[threadIdx.x] = 0u;
    __syncthreads();
    const XcdBarrier xbar = xcd_barrier_post((unsigned*)(ws + WS_BAR), xst);
#define SYNC1() xcd_barrier(xbar)
#define SYNC() do { SYNC1(); if (DUP == 30) SYNC1(); } while (0)
#endif
#ifndef DUP
#define DUP -1
#endif
#define IN(k) (p.ph_lo <= (k) && (k) < p.ph_hi)
#define REP(k) for (int rep_ = 0; rep_ < ((DUP) == (k) ? 2 : 1); ++rep_)
    if (IN(0)) { REP(0) { phase_prep(p, lds); __syncthreads(); } SYNC(); }
    if (IN(1)) {
        REP(1) {
        pg8::Gemm g{(const bf16_t*)(ws + WS_XB), (const bf16_t*)(ws + WS_WIN), M, NIN, D}; pg8::StaticOrder S; S.init(M, NIN, G, bx);
        Epi1 E{(bf16_t*)(ws + WS_ZC), (bf16_t*)(ws + WS_QKV), (bf16_t*)(ws + WS_GATE), p.in[7], (const float*)(ws + WS_ROPE), p.out};
        pg8::gemm_phase<Epi1, pg8::StaticOrder, true, true>(lds, g, S, E);
        }
        SYNC();
    }
    if (IN(2)) {
        REP(2) {
        REP(21) for (int it = bx; it < 1536; it += G) attn_prompt_item(p, lds, it);
        REP(23) phase_conv(p);
        REP(22) phase_sample_attn_copy(p);
        __syncthreads();
        }
        SYNC();
    }
    if (IN(3)) { REP(3) phase_merge(p); SYNC(); }
    if (IN(4)) {
        REP(4) {
        { pg8::Gemm g{(const bf16_t*)(ws + WS_YC), (const bf16_t*)(ws + WS_WC), M, D, DC}; pg8::StaticOrder S; S.init(M, D, G, bx);
          Epi3 E{(bf16_t*)(ws + WS_MIX), (const bf16_t*)(ws + WS_GATE), 0};
          pg8::gemm_phase<Epi3, pg8::StaticOrder, true, true>(lds, g, S, E); }
        { pg8::Gemm g{(const bf16_t*)(ws + WS_YA), (const bf16_t*)(ws + WS_WA), M, D, 256}; pg8::StaticOrder S; S.init(M, D, G, bx);
          Epi3 E{(bf16_t*)(ws + WS_MIX), (const bf16_t*)(ws + WS_GATE), 1};
          pg8::gemm_phase<Epi3, pg8::StaticOrder, true, true>(lds, g, S, E); }
        }
        SYNC();
    }
    if (IN(5)) {
        REP(5) {
        pg8::Gemm g{(const bf16_t*)(ws + WS_MIX), (const bf16_t*)(ws + WS_WO), M, D, D}; pg8::StaticOrder S; S.init(M, D, G, bx);
        EpiRes E{p.in[0], p.in[1] - (size_t)MP * D, (float*)(ws + WS_PRE)};
        pg8::gemm_phase<EpiRes, pg8::StaticOrder, true, true>(lds, g, S, E);
        }
        SYNC();
    }
    if (IN(6)) { REP(6) phase_ln<false>(p, p.in[12], p.in[13]); SYNC(); }
    if (IN(7)) {
        REP(7) {
        pg8::Gemm g{(const bf16_t*)(ws + WS_X1B), (const bf16_t*)(ws + WS_WUP), M, FF, D}; pg8::StaticOrder S; S.init(M, FF, G, bx);
        EpiHid E{(bf16_t*)(ws + WS_HID)};
        pg8::gemm_phase<EpiHid, pg8::StaticOrder, true, true>(lds, g, S, E);
        }
        SYNC();
    }
    if (IN(8)) {
        REP(8) {
        pg8::Gemm g{(const bf16_t*)(ws + WS_HID), (const bf16_t*)(ws + WS_WDN), M, D, FF}; pg8::StaticOrder S; S.init(M, D, G, bx);
        EpiRes E{(const float*)(ws + WS_X1F), (const float*)(ws + WS_X1F), (float*)(ws + WS_PRE)};
        pg8::gemm_phase<EpiRes, pg8::StaticOrder, true, true>(lds, g, S, E);
        }
        SYNC();
    }
    if (IN(9)) { REP(9) phase_ln<true>(p, p.in[16], p.in[17]); }
#ifdef DUMP
    if (IN(20)) { const size_t gt = (size_t)blockIdx.x * NT + threadIdx.x, GT = (size_t)gridDim.x * NT;
        for (size_t i = gt; i < (size_t)M * 1024; i += GT) { const size_t row = i >> 10, c = i & 1023; float v;
            if (DUMP == 1) { v = bf1(((const bf16_t*)(ws + WS_GATE))[row * 2048 + c]) + bf1(((const bf16_t*)(ws + WS_GATE))[row * 2048 + 1024 + c]) + bf1(((const bf16_t*)(ws + WS_ZC))[row * 1536 + c]) + bf1(((const bf16_t*)(ws + WS_ZC))[row * 1536 + 512 + c]);
                for (int sl = 0; sl < 9; ++sl) v += (float)(sl + 1) * bf1(((const bf16_t*)(ws + WS_QKV))[((size_t)sl * M + row) * 256 + (c & 255)]); }
            else if (DUMP == 2) { v = bf1(((const bf16_t*)(ws + WS_YC))[row * 512 + (c & 511)]);
                for (int sl = 0; sl < 3; ++sl) v += (float)(sl + 1) * bf1(((const bf16_t*)(ws + WS_OG))[((size_t)sl * M + row) * 256 + (c & 255)]) + ((const float*)(ws + WS_LSE))[((size_t)sl * M + row) * 4 + (c & 3)]; }
            else if (DUMP == 3) v = bf1(((const bf16_t*)(ws + WS_YA))[row * 256 + (c & 255)]);
            else if (DUMP == 4) v = bf1(((const bf16_t*)(ws + WS_MIX))[i]);
            else if (DUMP == 5 || DUMP == 8) v = ((const float*)(ws + WS_PRE))[i];
            else if (DUMP == 6) v = ((const float*)(ws + WS_X1F))[i];
            else { const bf16_t* hp = (const bf16_t*)(ws + WS_HID) + row * 4096 + c; v = bf1(hp[0]) + bf1(hp[1024]) + bf1(hp[2048]) + bf1(hp[3072]); }
            p.out[i] = v; } }
#endif
#undef IN
#undef SYNC
}

extern "C" void kernel_launch(void* const* d_in, const int* in_sizes, int n_in, void* d_out, int out_size, void* d_ws, size_t ws_size, hipStream_t stream) {
    static int grid = 0;
    if (grid == 0) {
        if (n_in != 18 || (size_t)out_size != O_END || ws_size < WS_END) { fprintf(stderr, "kernel_launch: unexpected shapes (n_in %d out %d ws %zu need %zu)\n", n_in, out_size, ws_size, (size_t)WS_END); grid = -1; return; }
        int dev = 0, cus = 0, per_cu = 0;
        (void)hipGetDevice(&dev); (void)hipDeviceGetAttribute(&cus, hipDeviceAttributeMultiprocessorCount, dev);
        if (hipFuncSetAttribute((const void*)fwd_kernel, hipFuncAttributeMaxDynamicSharedMemorySize, LDS_BYTES) != hipSuccess) { fprintf(stderr, "kernel_launch: hipFuncSetAttribute failed\n"); grid = -1; return; }
        if (hipOccupancyMaxActiveBlocksPerMultiprocessor(&per_cu, (const void*)fwd_kernel, NT, LDS_BYTES) != hipSuccess || per_cu < 1) { fprintf(stderr, "kernel_launch: occupancy query says %d\n", per_cu); per_cu = 1; }
        (void)hipGetLastError();
        grid = cus * 1;
    }
    if (grid < 0) return;
    Params p{};
    for (int i = 0; i < 18; ++i) p.in[i] = (const float*)d_in[i];
    p.out = (float*)d_out; p.ws = (unsigned char*)d_ws;
#if MK_MULTI
#ifdef DUMP
    for (int k = 0; k <= DUMP; ++k) { p.ph_lo = k; p.ph_hi = k + 1; hipLaunchKernelGGL(fwd_kernel, dim3(grid), dim3(NT), LDS_BYTES, stream, p); }
    p.ph_lo = 20; p.ph_hi = 21; hipLaunchKernelGGL(fwd_kernel, dim3(grid), dim3(NT), LDS_BYTES, stream, p);
#else
    for (int k = 0; k < N_PHASES; ++k) { p.ph_lo = k; p.ph_hi = k + 1; hipLaunchKernelGGL(fwd_kernel, dim3(grid), dim3(NT), LDS_BYTES, stream, p); }
#endif
#else
    p.ph_lo = 0; p.ph_hi = N_PHASES;
    if (hipMemsetAsync((char*)d_ws + WS_BAR, 0, 16384, stream) != hipSuccess) { fprintf(stderr, "kernel_launch: memset of the barrier words failed\n"); return; }
    void* args[] = {&p};
    hipError_t e = hipLaunchCooperativeKernel((const void*)fwd_kernel, dim3(grid), dim3(NT), args, LDS_BYTES, stream);
    if (e != hipSuccess) fprintf(stderr, "cooperative launch failed: %s (grid %d)\n", hipGetErrorString(e), grid);
#endif
}
```

```cpp
#include <hip/hip_runtime.h>
#include <hip/hip_cooperative_groups.h>
#include <cstdio>
#include <cstdint>
namespace cg = cooperative_groups;

#ifndef MK_MULTI
#define MK_MULTI 0
#define DUP -1
#endif

__device__ __forceinline__ int fresh_tid() { return threadIdx.x; }
namespace pg8 {
#define PG8_LAS __attribute__((address_space(3)))
typedef unsigned short bf16_t;
typedef short bf16x8 __attribute__((ext_vector_type(8)));
typedef float f32x4 __attribute__((ext_vector_type(4)));
typedef unsigned u32x4 __attribute__((ext_vector_type(4)));
typedef unsigned u32x2 __attribute__((ext_vector_type(2)));
constexpr int BM = 256, BK = 64, HALF = 128, HTB = HALF * BK * 2, STAGE_BYTES = 8 * HTB, NXCD = 8, WGM = 8;

__host__ __device__ __forceinline__ int lds_byte(int r, int c) { const int st = (r >> 4) * 2 + (c >> 5), rr = r & 15, cc = c & 31, ob = rr * 64 + cc * 2; return st * 1024 + (ob ^ (((ob >> 9) & 1) << 5)); }
__host__ __device__ __forceinline__ void stage_rc(int b, int& R, int& C) { const int st = b / 1024, sb = b % 1024, swz = sb ^ (((sb >> 9) & 1) << 5); R = (st >> 1) * 16 + swz / 64; C = (st & 1) * 32 + (swz % 64) / 2; }
__host__ __device__ __forceinline__ int perm32(int rho) { const int n = rho >> 4, i = rho & 15; return 8 * (i >> 2) + 4 * n + (i & 3); }
__host__ __device__ __forceinline__ int swap45(int v) { return (v & 15) | ((v & 16) << 1) | ((v & 32) >> 1); }

struct Unit { int pm, pn, kt0, nt; };
struct Gemm { const bf16_t* A; const bf16_t* Bt; int M, N, K; };

struct StaticOrder {
    int nM, nN, nwg, G, c, ntk;
    __host__ __device__ void init(int M, int N, int G_, int c_, int K_) { nM = M / BM; nN = N / BM; nwg = nM * nN; G = G_; c = c_; ntk = K_ / BK; }
    __host__ __device__ bool next(int i, Unit& u) const {
        u.kt0 = 0; u.nt = ntk;
        const long L = (long)i * G + c; if (L >= nwg) return false;
        int wgid = (int)L; { const int q = nwg / NXCD, r = nwg % NXCD, xcd = wgid % NXCD, off = wgid / NXCD; wgid = (xcd < r ? xcd * (q + 1) : r * (q + 1) + (xcd - r) * q) + off; }
        const int nig = WGM * nN, gid = wgid / nig, fm = gid * WGM, gsz = (nM - fm) < WGM ? (nM - fm) : WGM;
        u.pm = fm + ((wgid % nig) % gsz); u.pn = (wgid % nig) / gsz; return true;
    }
    __device__ __forceinline__ void a_ready(const Unit&) const {}
    __device__ __forceinline__ void done(const Unit&) const {}
};

typedef float cvt_f32x2 __attribute__((ext_vector_type(2)));
typedef __bf16 cvt_bf16x2 __attribute__((ext_vector_type(2)));
__device__ __forceinline__ unsigned cvt_pk_bf16(float lo, float hi) { const cvt_f32x2 v = {lo, hi}; const cvt_bf16x2 b = __builtin_convertvector(v, cvt_bf16x2); return __builtin_bit_cast(unsigned, b); }

template <class Epi, class Sched, bool ALIGN_EPI = false, bool SP2 = false>
__device__ __forceinline__ void gemm_phase(PG8_LAS unsigned char* lds, const Gemm g, const Sched& S, const Epi& E) {
    const int tid = fresh_tid(), wid = __builtin_amdgcn_readfirstlane(tid >> 6), lane = tid & 63, wr = wid >> 2, wc = wid & 3, fr = lane & 15, fq = lane >> 4;
    const int K = g.K;
    unsigned voffA[2], voffB[2];
#pragma unroll
    for (int i = 0; i < 2; ++i) { int R, C; stage_rc(tid * 16 + i * 8192, R, C);
        const int Rb = Epi::PERM == 1 ? ((R & ~31) + perm32(R & 31)) : (Epi::PERM == 2 ? ((R & ~63) + swap45(R & 63)) : R);
        voffA[i] = (unsigned)(R * K + C) * 2u; voffB[i] = (unsigned)(Rb * K + C) * 2u; }
    const size_t kstep = (size_t)(BK * 2);
    const size_t hstep = (size_t)HALF * K * 2;
    const size_t tstep = 2 * hstep;
    const unsigned ldsw = (unsigned)wid * 1024u;
    const int aoff = lds_byte(wr * 64 + fr, fq * 8), boff = lds_byte(wc * 32 + fr, fq * 8);
#define PG8_SA(b, h) (((b) * 2 + (h)) * HTB)
#define PG8_SB(b, h) ((4 + (b) * 2 + (h)) * HTB)
#define PG8_STAGE(bufoff, gbase, voff) do { _Pragma("unroll") for (int _i = 0; _i < 2; ++_i) \
        __builtin_amdgcn_global_load_lds((const unsigned*)((const char*)(gbase) + (voff)[_i]), (PG8_LAS unsigned*)(lds + (bufoff) + ldsw + _i * 8192), 16, 0, 0); } while (0)
#define PG8_LDA(dst, b, h) do { _Pragma("unroll") for (int m = 0; m < 4; ++m) _Pragma("unroll") for (int k = 0; k < 2; ++k) dst[m][k] = *(const PG8_LAS bf16x8*)(lds + PG8_SA(b, h) + aoff + m * 2048 + k * 1024); } while (0)
#define PG8_LDB(dst, b, h) do { _Pragma("unroll") for (int n = 0; n < 2; ++n) _Pragma("unroll") for (int k = 0; k < 2; ++k) dst[n][k] = *(const PG8_LAS bf16x8*)(lds + PG8_SB(b, h) + boff + n * 2048 + k * 1024); } while (0)
#define PG8_MMA(ai, bj, At, Bt) do { __builtin_amdgcn_s_setprio(1); _Pragma("unroll") for (int m = 0; m < 4; ++m) _Pragma("unroll") for (int n = 0; n < 2; ++n) _Pragma("unroll") for (int k = 0; k < 2; ++k) \
        acc[ai][bj][m][n] = __builtin_amdgcn_mfma_f32_16x16x32_bf16(Bt[n][k], At[m][k], acc[ai][bj][m][n], 0, 0, 0); __builtin_amdgcn_s_setprio(0); } while (0)
#define PG8_WAIT_V(n) asm volatile("s_waitcnt vmcnt(" #n ")" ::: "memory")
#define PG8_WAIT_L(n) asm volatile("s_waitcnt lgkmcnt(" #n ")" ::: "memory")
#define PG8_BAR __builtin_amdgcn_s_barrier()
#define PG8_SCHED __builtin_amdgcn_sched_barrier(0)
    Unit cur, nxt; int ui = 0;
    if (!S.next(0, cur)) return;
    f32x4 acc[2][2][4][2];
#pragma unroll
    for (int a = 0; a < 2; ++a)
#pragma unroll
        for (int b = 0; b < 2; ++b)
#pragma unroll
            for (int m = 0; m < 4; ++m)
#pragma unroll
                for (int n = 0; n < 2; ++n) acc[a][b][m][n] = (f32x4){0.f, 0.f, 0.f, 0.f};
    bf16x8 At[4][2], B0[2][2], B1[2][2];
    const char* cA = (const char*)g.A + (size_t)cur.pm * tstep + (size_t)cur.kt0 * kstep; const char* cB = (const char*)g.Bt + (size_t)cur.pn * tstep + (size_t)cur.kt0 * kstep;
    S.a_ready(cur);
    if constexpr (SP2) {
        PG8_STAGE(PG8_SB(0, 0), cB, voffB); PG8_STAGE(PG8_SB(0, 1), cB + hstep, voffB); PG8_STAGE(PG8_SA(0, 0), cA, voffA); PG8_STAGE(PG8_SA(0, 1), cA + hstep, voffA);
        if (wr == 1) PG8_BAR;
        PG8_WAIT_V(2); PG8_BAR;
        PG8_STAGE(PG8_SB(1, 0), cB + kstep, voffB); PG8_STAGE(PG8_SA(1, 0), cA + kstep, voffA); PG8_STAGE(PG8_SB(1, 1), cB + hstep + kstep, voffB);
        PG8_WAIT_V(6); PG8_BAR;
    } else {
        PG8_STAGE(PG8_SB(0, 0), cB, voffB); PG8_STAGE(PG8_SA(0, 0), cA, voffA); PG8_STAGE(PG8_SB(0, 1), cB + hstep, voffB); PG8_STAGE(PG8_SA(0, 1), cA + hstep, voffA);
        if (wr == 1) PG8_BAR;
        PG8_WAIT_V(4); PG8_BAR;
        PG8_STAGE(PG8_SB(1, 0), cB + kstep, voffB); PG8_STAGE(PG8_SA(1, 0), cA + kstep, voffA); PG8_STAGE(PG8_SB(1, 1), cB + hstep + kstep, voffB);
        PG8_WAIT_V(6); PG8_BAR;
    }
    for (;;) {
        const bool has_next = S.next(ui + 1, nxt);
        const char* nA = has_next ? (const char*)g.A + (size_t)nxt.pm * tstep + (size_t)nxt.kt0 * kstep : cA; const char* nB = has_next ? (const char*)g.Bt + (size_t)nxt.pn * tstep + (size_t)nxt.kt0 * kstep : cB;
        const int nt = cur.nt;
        for (int t = 0; t < nt; t += 2) {
            const bool last = (t == nt - 2);
            const char* a1 = cA + (size_t)(t + 1) * kstep;
            const char* a2 = last ? nA : cA + (size_t)(t + 2) * kstep; const char* b2 = last ? nB : cB + (size_t)(t + 2) * kstep;
            const char* a3 = a2 + kstep; const char* b3 = b2 + kstep;
            if (last && has_next) S.a_ready(nxt);
            if constexpr (SP2) {
            PG8_LDB(B0, 0, 0); PG8_LDB(B1, 0, 1); PG8_SCHED; PG8_LDA(At, 0, 0); PG8_STAGE(PG8_SA(1, 1), a1 + hstep, voffA);
            PG8_WAIT_V(8); PG8_WAIT_L(0); PG8_BAR; PG8_MMA(0, 0, At, B0); PG8_MMA(0, 1, At, B1); PG8_BAR; PG8_SCHED;
            PG8_LDA(At, 0, 1); PG8_STAGE(PG8_SB(0, 0), b2, voffB); PG8_STAGE(PG8_SB(0, 1), b2 + hstep, voffB); PG8_STAGE(PG8_SA(0, 0), a2, voffA);
            PG8_WAIT_V(8); PG8_WAIT_L(0); PG8_BAR; PG8_MMA(1, 0, At, B0); PG8_MMA(1, 1, At, B1); PG8_BAR; PG8_SCHED;
            PG8_LDB(B0, 1, 0); PG8_LDB(B1, 1, 1); PG8_SCHED; PG8_LDA(At, 1, 0); PG8_STAGE(PG8_SA(0, 1), a2 + hstep, voffA);
            PG8_WAIT_V(8); PG8_WAIT_L(0); PG8_BAR; PG8_MMA(0, 0, At, B0); PG8_MMA(0, 1, At, B1); PG8_BAR; PG8_SCHED;
            PG8_LDA(At, 1, 1); PG8_STAGE(PG8_SB(1, 0), b3, voffB); PG8_STAGE(PG8_SB(1, 1), b3 + hstep, voffB); PG8_STAGE(PG8_SA(1, 0), a3, voffA);
            PG8_WAIT_V(8); PG8_WAIT_L(0); PG8_BAR; PG8_MMA(1, 0, At, B0); PG8_MMA(1, 1, At, B1); PG8_BAR; PG8_SCHED;
            } else {
            PG8_LDB(B0, 0, 0); PG8_SCHED; PG8_LDA(At, 0, 0); PG8_STAGE(PG8_SA(1, 1), a1 + hstep, voffA);
            PG8_WAIT_L(8); PG8_BAR; PG8_WAIT_L(0); PG8_MMA(0, 0, At, B0); PG8_BAR; PG8_SCHED;
            PG8_LDB(B1, 0, 1); PG8_STAGE(PG8_SB(0, 0), b2, voffB);
            PG8_BAR; PG8_WAIT_L(0); PG8_MMA(0, 1, At, B1); PG8_BAR;
            PG8_LDA(At, 0, 1); PG8_STAGE(PG8_SA(0, 0), a2, voffA);
            PG8_BAR; PG8_WAIT_L(0); PG8_MMA(1, 0, At, B0); PG8_BAR; PG8_SCHED;
            PG8_STAGE(PG8_SB(0, 1), b2 + hstep, voffB);
            PG8_WAIT_V(6); PG8_BAR; PG8_MMA(1, 1, At, B1); PG8_BAR;
            PG8_LDB(B0, 1, 0); PG8_SCHED; PG8_LDA(At, 1, 0); PG8_STAGE(PG8_SA(0, 1), a2 + hstep, voffA);
            PG8_WAIT_L(8); PG8_BAR; PG8_WAIT_L(0); PG8_MMA(0, 0, At, B0); PG8_BAR; PG8_SCHED;
            PG8_LDB(B1, 1, 1); PG8_STAGE(PG8_SB(1, 0), b3, voffB);
            PG8_BAR; PG8_WAIT_L(0); PG8_MMA(0, 1, At, B1); PG8_BAR;
            PG8_LDA(At, 1, 1); PG8_STAGE(PG8_SA(1, 0), a3, voffA);
            PG8_BAR; PG8_WAIT_L(0); PG8_MMA(1, 0, At, B0); PG8_BAR; PG8_SCHED;
            PG8_STAGE(PG8_SB(1, 1), b3 + hstep, voffB);
            PG8_WAIT_V(6); PG8_BAR; PG8_MMA(1, 1, At, B1); PG8_BAR;
            }
        }
        if constexpr (ALIGN_EPI) { if (wr == 0) PG8_BAR; }
        E(acc, cur, wr, wc, fr, fq);
        if (!has_next) break;
#pragma unroll
        for (int a = 0; a < 2; ++a)
#pragma unroll
            for (int b = 0; b < 2; ++b)
#pragma unroll
                for (int m = 0; m < 4; ++m)
#pragma unroll
                    for (int n = 0; n < 2; ++n) acc[a][b][m][n] = (f32x4){0.f, 0.f, 0.f, 0.f};
        cur = nxt; cA = nA; cB = nB; ++ui;
        if constexpr (ALIGN_EPI) { if (wr == 1) PG8_BAR; }
    }
    PG8_WAIT_V(0);
    if constexpr (!ALIGN_EPI) { if (wr == 0) PG8_BAR; }
    PG8_BAR;
#undef PG8_SA
#undef PG8_SB
#undef PG8_STAGE
#undef PG8_LDA
#undef PG8_LDB
#undef PG8_MMA
#undef PG8_WAIT_V
#undef PG8_WAIT_L
#undef PG8_BAR
#undef PG8_SCHED
}
}

using pg8::bf16_t; using pg8::f32x4; using pg8::u32x4; using pg8::u32x2; using pg8::bf16x8; using pg8::cvt_pk_bf16;
#define LAS __attribute__((address_space(3)))
typedef short bf16x4 __attribute__((ext_vector_type(4)));
typedef float f32x2 __attribute__((ext_vector_type(2)));
constexpr int D = 1024, SEQ = 4096, MP = 16384, MS = 1024, M = MP + MS, NIN = 5888, DC = 512, FF = 4096;
constexpr int NT = 512;
constexpr float ALPHA = 1.189207115002721f;
constexpr float LN_EPS = 1e-5f;
constexpr int LDS_BYTES = pg8::STAGE_BYTES + 16;

constexpr size_t WS_XB = 0;
constexpr size_t WS_WIN = WS_XB + (size_t)M * D * 2;
constexpr size_t WS_WC = WS_WIN + (size_t)NIN * D * 2;
constexpr size_t WS_WA = WS_WC + (size_t)1024 * 512 * 2;
constexpr size_t WS_WO = WS_WA + (size_t)1024 * 256 * 2;
constexpr size_t WS_WUP = WS_WO + (size_t)1024 * 1024 * 2;
constexpr size_t WS_WDN = WS_WUP + (size_t)4096 * 1024 * 2;
constexpr size_t WS_ROPE = WS_WDN + (size_t)4096 * 1024 * 2;
constexpr size_t WS_ZC = WS_ROPE + (size_t)4096 * 32 * 8;
constexpr size_t WS_QKV = WS_ZC + (size_t)M * 1536 * 2;
constexpr size_t WS_GATE = WS_QKV + (size_t)9 * M * 256 * 2;
constexpr size_t WS_OG = WS_GATE + (size_t)M * 2048 * 2;
constexpr size_t WS_LSE = WS_OG + (size_t)3 * M * 256 * 2;
constexpr size_t WS_YC = WS_LSE + (size_t)3 * M * 4 * 4;
constexpr size_t WS_YA = WS_YC + (size_t)M * 512 * 2;
constexpr size_t WS_MIX = WS_YA + (size_t)M * 256 * 2;
constexpr size_t WS_PRE = WS_MIX + (size_t)M * 1024 * 2;
constexpr size_t WS_X1F = WS_PRE + (size_t)M * 1024 * 4;
constexpr size_t WS_PART = WS_X1F;
constexpr size_t WS_X1B = WS_X1F + (size_t)M * 1024 * 4;
constexpr size_t WS_HID = WS_X1B + (size_t)M * 1024 * 2;
constexpr size_t WS_BAR = WS_HID + (size_t)M * 4096 * 2;
constexpr size_t WS_OGS = WS_BAR + 16384;
constexpr size_t WS_LSES = WS_OGS + (size_t)6 * MS * 256 * 2;
constexpr size_t WS_END = WS_LSES + (size_t)6 * MS * 4 * 4;

constexpr size_t O_YP = 0;
constexpr size_t O_YS = O_YP + (size_t)MP * D;
constexpr size_t O_CP = O_YS + (size_t)MS * D;
constexpr size_t O_KVP0 = O_CP + 4 * 2 * 512;
constexpr size_t O_KVP1 = O_KVP0 + (size_t)4 * 128 * 512;
constexpr size_t O_KVP2 = O_KVP1 + (size_t)4 * 512 * 512;
constexpr size_t O_CS = O_KVP2 + (size_t)4 * 2048 * 512;
constexpr size_t O_KVS0 = O_CS + (size_t)128 * 2 * 512;
constexpr size_t O_KVS1 = O_KVS0 + (size_t)128 * 128 * 512;
constexpr size_t O_KVS2 = O_KVS1 + (size_t)128 * 512 * 512;
constexpr size_t O_END = O_KVS2 + (size_t)128 * 2048 * 512;

struct Params { const float* in[18]; float* out; unsigned char* ws; int ph_lo, ph_hi; };

__device__ __forceinline__ float bflo(unsigned w) { return __builtin_bit_cast(float, w << 16); }
__device__ __forceinline__ float bfhi(unsigned w) { return __builtin_bit_cast(float, w & 0xffff0000u); }
__device__ __forceinline__ float bf1(bf16_t h) { return __builtin_bit_cast(float, (unsigned)h << 16); }
__device__ __forceinline__ float wave_sum(float v) {
#pragma unroll
    for (int o = 1; o < 64; o <<= 1) v += __shfl_xor(v, o);
    return v;
}
__device__ __forceinline__ float wave_max(float v) {
#pragma unroll
    for (int o = 1; o < 64; o <<= 1) v = fmaxf(v, __shfl_xor(v, o));
    return v;
}

using pg8::Unit;
struct Epi1 {
    static constexpr int PERM = 2;
    bf16_t* zc; bf16_t* qkv; bf16_t* gates; const float* bgate; const float* rope; float* out;
    __device__ __forceinline__ void operator()(const f32x4 (&acc)[2][2][4][2], const Unit& u, int wr, int wc, int fr, int fq) const {
        const int row0 = u.pm * 256 + wr * 64 + fr;
        const int cw0 = 64 * (wc >> 1) + 16 * (wc & 1) + 4 * fq;
        if (u.pn < 6) {
#pragma unroll
            for (int ai = 0; ai < 2; ++ai)
#pragma unroll
                for (int m = 0; m < 4; ++m) { bf16_t* rp = zc + (size_t)(row0 + ai * 128 + m * 16) * 1536 + u.pn * 256 + cw0;
#pragma unroll
                    for (int bj = 0; bj < 2; ++bj)
#pragma unroll
                        for (int n = 0; n < 2; ++n) { const f32x4 v = acc[ai][bj][m][n]; u32x2 w; w.x = cvt_pk_bf16(v[0], v[1]); w.y = cvt_pk_bf16(v[2], v[3]); *(u32x2*)(rp + bj * 128 + n * 32) = w; } }
        } else if (u.pn < 15) {
            const int t = u.pn - 6, gi = t / 3, kind = t - 3 * gi;
            bf16_t* dst = qkv + (size_t)(gi * 3 + kind) * M * 256;
            const int Wk = 128 << (2 * gi);
            float* okp = out + (gi == 0 ? O_KVP0 : (gi == 1 ? O_KVP1 : O_KVP2));
            float* oks = out + (gi == 0 ? O_KVS0 : (gi == 1 ? O_KVS1 : O_KVS2));
            const int e0 = 16 * (wc & 1) + 4 * fq;
#pragma unroll
            for (int ai = 0; ai < 2; ++ai)
#pragma unroll
                for (int m = 0; m < 4; ++m) {
                    const int row = row0 + ai * 128 + m * 16;
                    int pos; float* kvb = nullptr;
                    if (row < MP) { const int nb = row >> 12, p = row & 4095; pos = p; const int pk = p - (SEQ - Wk); if (pk >= 0) kvb = okp + ((size_t)(nb * Wk + pk) * 2) * 256; }
                    else { const int rs = row - MP, nb = rs >> 3, tt = rs & 7; pos = 2048 + tt; kvb = oks + ((size_t)(nb * Wk + Wk - 8 + tt) * 2) * 256; }
                    f32x4 cs0 = {1.f, 0.f, 1.f, 0.f}, cs1 = {1.f, 0.f, 1.f, 0.f};
                    if (kind < 2) { const f32x4* rp = (const f32x4*)(rope + ((size_t)pos * 32 + e0) * 2); cs0 = rp[0]; cs1 = rp[1]; }
#pragma unroll
                    for (int bj = 0; bj < 2; ++bj) {
                        f32x4 x1 = acc[ai][bj][m][0], x2 = acc[ai][bj][m][1];
                        if (kind < 2) {
                            const f32x4 c = {cs0[0], cs0[2], cs1[0], cs1[2]}, s = {cs0[1], cs0[3], cs1[1], cs1[3]};
                            const f32x4 o1 = x1 * c - x2 * s, o2 = x2 * c + x1 * s; x1 = o1; x2 = o2;
                            if (kind == 0) { x1 = x1 * 0.125f; x2 = x2 * 0.125f; }
                        }
                        const int hc = (2 * bj + (wc >> 1)) * 64 + e0;
                        u32x2 w1, w2; w1.x = cvt_pk_bf16(x1[0], x1[1]); w1.y = cvt_pk_bf16(x1[2], x1[3]); w2.x = cvt_pk_bf16(x2[0], x2[1]); w2.y = cvt_pk_bf16(x2[2], x2[3]);
                        *(u32x2*)(dst + (size_t)row * 256 + hc) = w1; *(u32x2*)(dst + (size_t)row * 256 + hc + 32) = w2;
                        if (kind >= 1 && kvb) { float* kp = kvb + (kind - 1) * 256 + hc; *(f32x4*)kp = x1; *(f32x4*)(kp + 32) = x2; }
                    }
                    asm volatile("" ::: "memory");
                }
        } else {
            const int cg0 = (u.pn - 15) * 256 + cw0;
#pragma unroll
            for (int bj = 0; bj < 2; ++bj)
#pragma unroll
                for (int n = 0; n < 2; ++n) { const f32x4 bv = *(const f32x4*)(bgate + cg0 + bj * 128 + n * 32);
#pragma unroll
                    for (int ai = 0; ai < 2; ++ai)
#pragma unroll
                        for (int m = 0; m < 4; ++m) { const f32x4 v = acc[ai][bj][m][n] + bv; f32x4 s;
#pragma unroll
                            for (int j = 0; j < 4; ++j) s[j] = __builtin_amdgcn_rcpf(1.0f + __expf(-v[j]));
                            u32x2 w; w.x = cvt_pk_bf16(s[0], s[1]); w.y = cvt_pk_bf16(s[2], s[3]);
                            *(u32x2*)(gates + (size_t)(row0 + ai * 128 + m * 16) * 2048 + cg0 + bj * 128 + n * 32) = w; } }
        }
    }
};
struct Epi3 {
    static constexpr int PERM = 1;
    bf16_t* mix; const bf16_t* gates; int second;
    __device__ __forceinline__ void operator()(const f32x4 (&acc)[2][2][4][2], const Unit& u, int wr, int wc, int fr, int fq) const {
        const int row0 = u.pm * 256 + wr * 64 + fr, col0 = u.pn * 256 + wc * 32 + 8 * fq;
#pragma unroll
        for (int ai = 0; ai < 2; ++ai)
#pragma unroll
            for (int m = 0; m < 4; ++m) { const int row = row0 + ai * 128 + m * 16;
#pragma unroll
                for (int bj = 0; bj < 2; ++bj) { const int c = col0 + bj * 128;
                    const u32x4 g = *(const u32x4*)(gates + (size_t)row * 2048 + second * 1024 + c);
                    f32x4 v0 = acc[ai][bj][m][0], v1 = acc[ai][bj][m][1];
                    v0 = v0 * (f32x4){bflo(g.x), bfhi(g.x), bflo(g.y), bfhi(g.y)}; v1 = v1 * (f32x4){bflo(g.z), bfhi(g.z), bflo(g.w), bfhi(g.w)};
                    bf16_t* mp = mix + (size_t)row * 1024 + c;
                    if (second) { const u32x4 o = *(const u32x4*)mp; v0 = v0 + (f32x4){bflo(o.x), bfhi(o.x), bflo(o.y), bfhi(o.y)}; v1 = v1 + (f32x4){bflo(o.z), bfhi(o.z), bflo(o.w), bfhi(o.w)}; }
                    u32x4 w; w.x = cvt_pk_bf16(v0[0], v0[1]); w.y = cvt_pk_bf16(v0[2], v0[3]); w.z = cvt_pk_bf16(v1[0], v1[1]); w.w = cvt_pk_bf16(v1[2], v1[3]);
                    *(u32x4*)mp = w; }
                asm volatile("" ::: "memory"); }
    }
};
template <bool BF16RES>
struct EpiRes {
    static constexpr int PERM = 0;
    const void* res; float* pre; float* part;
    __device__ __forceinline__ void operator()(const f32x4 (&acc)[2][2][4][2], const Unit& u, int wr, int wc, int fr, int fq) const {
        const int row0 = u.pm * 256 + wr * 64 + fr, col0 = u.pn * 256 + wc * 32 + 4 * fq;
        if (u.pm >= 64) {
            float* pb = part + ((size_t)(u.kt0 / u.nt) * MS + (row0 - MP)) * 1024 + col0;
#pragma unroll
            for (int ai = 0; ai < 2; ++ai)
#pragma unroll
                for (int m = 0; m < 4; ++m)
#pragma unroll
                    for (int bj = 0; bj < 2; ++bj)
#pragma unroll
                        for (int n = 0; n < 2; ++n) *(f32x4*)(pb + (size_t)(ai * 128 + m * 16) * 1024 + bj * 128 + n * 16) = acc[ai][bj][m][n];
            return;
        }
#pragma unroll
        for (int ai = 0; ai < 2; ++ai)
#pragma unroll
            for (int m = 0; m < 4; ++m) { const size_t off = (size_t)(row0 + ai * 128 + m * 16) * 1024 + col0;
#pragma unroll
                for (int bj = 0; bj < 2; ++bj)
#pragma unroll
                    for (int n = 0; n < 2; ++n) { f32x4 r;
                        if (BF16RES) { const u32x2 rr = *(const u32x2*)((const bf16_t*)res + off + bj * 128 + n * 16); r = (f32x4){bflo(rr.x), bfhi(rr.x), bflo(rr.y), bfhi(rr.y)}; }
                        else r = *(const f32x4*)((const float*)res + off + bj * 128 + n * 16);
                        *(f32x4*)(pre + off + bj * 128 + n * 16) = r * ALPHA + acc[ai][bj][m][n]; }
                asm volatile("" ::: "memory"); }
    }
};
struct EpiHid {
    static constexpr int PERM = 1;
    bf16_t* hid;
    __device__ __forceinline__ void operator()(const f32x4 (&acc)[2][2][4][2], const Unit& u, int wr, int wc, int fr, int fq) const {
        const int row0 = u.pm * 256 + wr * 64 + fr, col0 = u.pn * 256 + wc * 32 + 8 * fq;
#pragma unroll
        for (int ai = 0; ai < 2; ++ai)
#pragma unroll
            for (int m = 0; m < 4; ++m) { bf16_t* rp = hid + (size_t)(row0 + ai * 128 + m * 16) * FF + col0;
#pragma unroll
                for (int bj = 0; bj < 2; ++bj) { f32x4 v0 = acc[ai][bj][m][0], v1 = acc[ai][bj][m][1];
#pragma unroll
                    for (int j = 0; j < 4; ++j) { const float a = fmaxf(v0[j], 0.f), b = fmaxf(v1[j], 0.f); v0[j] = a * a; v1[j] = b * b; }
                    u32x4 w; w.x = cvt_pk_bf16(v0[0], v0[1]); w.y = cvt_pk_bf16(v0[2], v0[3]); w.z = cvt_pk_bf16(v1[0], v1[1]); w.w = cvt_pk_bf16(v1[2], v1[3]);
                    *(u32x4*)(rp + bj * 128) = w; } }
    }
};


struct P1Order {
    int base, stride, limit, c;
    __device__ bool next(int i, pg8::Unit& u) const {
        u.kt0 = 0; u.nt = D / pg8::BK;
        if (c >= stride) return false;
        const int L = base + i * stride + c; if (L >= limit) return false;
        if (L < 92) { u.pm = 64 + L / 23; u.pn = L % 23; return true; }
        constexpr int nM = 64, nN = 23, nwg = nM * nN;
        int wgid = L - 92; { const int q = nwg / pg8::NXCD, r = nwg % pg8::NXCD, xcd = wgid % pg8::NXCD, off = wgid / pg8::NXCD; wgid = (xcd < r ? xcd * (q + 1) : r * (q + 1) + (xcd - r) * q) + off; }
        const int nig = pg8::WGM * nN, gid = wgid / nig, fm = gid * pg8::WGM, gsz = (nM - fm) < pg8::WGM ? (nM - fm) : pg8::WGM;
        u.pm = fm + ((wgid % nig) % gsz); u.pn = (wgid % nig) / gsz; return true;
    }
    __device__ __forceinline__ void a_ready(const pg8::Unit&) const {}
    __device__ __forceinline__ void done(const pg8::Unit&) const {}
};

struct SplitOrder {
    int NSL, ntk, G, c;
    __device__ __forceinline__ bool next(int i, pg8::Unit& u) const {
        const int nsub = 16 * NSL, L = i * G + c; const bool ok = (i <= 1) && (L < nsub + 256);
        const int idx = L / NSL, kz = L - idx * NSL, snt = ntk / NSL;
        constexpr int nM = 64, nN = 4, nwg = nM * nN;
        int wgid = L - nsub; wgid = wgid < 0 ? 0 : wgid;
        { const int q = nwg / pg8::NXCD, xcd = wgid % pg8::NXCD, off = wgid / pg8::NXCD; wgid = xcd * q + off; }
        const int nig = pg8::WGM * nN, gid = wgid / nig, fm = gid * pg8::WGM;
        const int ppm = fm + ((wgid % nig) % pg8::WGM), ppn = (wgid % nig) / pg8::WGM;
        const bool sub = L < nsub;
        pg8::Unit r; r.pm = sub ? 64 + (idx >> 2) : ppm; r.pn = sub ? (idx & 3) : ppn; r.kt0 = sub ? kz * snt : 0; r.nt = sub ? snt : ntk;
        u = r; return ok;
    }
    __device__ __forceinline__ void a_ready(const pg8::Unit&) const {}
    __device__ __forceinline__ void done(const pg8::Unit&) const {}
};
__device__ __forceinline__ void transpose_item(const float* W, int K, int N, bf16_t* WT, LAS float* scr, int item, int lane) {
    const int nblk = N / 32, kb = item / nblk, nb = item % nblk, k0 = 64 * kb, n0 = 32 * nb;
#pragma unroll 8
    for (int i = 0; i < 32; ++i) { const int kk = 2 * i + (lane >> 5); scr[kk * 33 + (lane & 31)] = W[(size_t)(k0 + kk) * N + n0 + (lane & 31)]; }
    asm volatile("s_waitcnt lgkmcnt(0)" ::: "memory");
    const int c = lane & 7;
#pragma unroll
    for (int j = 0; j < 4; ++j) { const int n = (lane >> 3) + 8 * j; const LAS float* s = scr + (8 * c) * 33 + n;
        u32x4 o; o.x = cvt_pk_bf16(s[0 * 33], s[1 * 33]); o.y = cvt_pk_bf16(s[2 * 33], s[3 * 33]); o.z = cvt_pk_bf16(s[4 * 33], s[5 * 33]); o.w = cvt_pk_bf16(s[6 * 33], s[7 * 33]);
        *(u32x4*)(WT + (size_t)(n0 + n) * K + k0 + 8 * c) = o; }
    asm volatile("s_waitcnt lgkmcnt(0)" ::: "memory");
}

__device__ __forceinline__ void phase_prep(const Params& p, LAS unsigned char* lds) {
    const int tid = fresh_tid(), lane = tid & 63, wave = tid >> 6;
    const size_t gt = (size_t)blockIdx.x * NT + tid, GT = (size_t)gridDim.x * NT;
    unsigned char* ws = p.ws;
    { bf16_t* xb = (bf16_t*)(ws + WS_XB); constexpr size_t NCH = (size_t)M * D / 8, NP = (size_t)MP * D / 8;
      for (size_t i0 = gt; i0 < NCH; i0 += 4 * GT) {
          f32x4 a[4], b[4];
#pragma unroll
          for (int k = 0; k < 4; ++k) { const size_t i = i0 + k * GT; if (i < NCH) { const float* src = (i < NP) ? p.in[0] + i * 8 : p.in[1] + (i - NP) * 8; a[k] = ((const f32x4*)src)[0]; b[k] = ((const f32x4*)src)[1]; } }
#pragma unroll
          for (int k = 0; k < 4; ++k) { const size_t i = i0 + k * GT; if (i < NCH) { u32x4 o; o.x = cvt_pk_bf16(a[k][0], a[k][1]); o.y = cvt_pk_bf16(a[k][2], a[k][3]); o.z = cvt_pk_bf16(b[k][0], b[k][1]); o.w = cvt_pk_bf16(b[k][2], b[k][3]);
              *(u32x4*)(xb + i * 8) = o; } } } }
    { float* rt = (float*)(ws + WS_ROPE);
      for (size_t i = gt; i < (size_t)4096 * 32; i += GT) { const int pos = (int)(i >> 5), f = (int)(i & 31);
          const float inv = 1.0f / exp2f((float)f * (13.287712379549449f / 32.0f));
          const float ang = (float)pos * inv;
          const double rev = (double)ang * 0.15915494309189535; const float fr = (float)(rev - floor(rev));
          rt[2 * i] = __builtin_amdgcn_cosf(fr); rt[2 * i + 1] = __builtin_amdgcn_sinf(fr); } }
    { LAS float* scr = (LAS float*)(lds + wave * 16384);
      const int gw = blockIdx.x * 8 + wave, NGW = gridDim.x * 8;
      constexpr int I_IN = (D / 64) * (NIN / 32), I_C = (DC / 64) * (D / 32), I_A = (256 / 64) * (D / 32), I_O = (D / 64) * (D / 32), I_UP = (D / 64) * (FF / 32), I_DN = (FF / 64) * (D / 32);
      constexpr int NITEMS = I_IN + I_C + I_A + I_O + I_UP + I_DN;
      for (int it = gw; it < NITEMS; it += NGW) { int r = it;
          if (r < I_IN) { transpose_item(p.in[6], D, NIN, (bf16_t*)(ws + WS_WIN), scr, r, lane); continue; } r -= I_IN;
          if (r < I_C) { transpose_item(p.in[9], DC, D, (bf16_t*)(ws + WS_WC), scr, r, lane); continue; } r -= I_C;
          if (r < I_A) { transpose_item(p.in[10], 256, D, (bf16_t*)(ws + WS_WA), scr, r, lane); continue; } r -= I_A;
          if (r < I_O) { transpose_item(p.in[11], D, D, (bf16_t*)(ws + WS_WO), scr, r, lane); continue; } r -= I_O;
          if (r < I_UP) { transpose_item(p.in[14], D, FF, (bf16_t*)(ws + WS_WUP), scr, r, lane); continue; } r -= I_UP;
          transpose_item(p.in[15], FF, D, (bf16_t*)(ws + WS_WDN), scr, r, lane); } }
}

constexpr int KS_STRIDE = 144;
constexpr int VT_STRIDE = 528;
constexpr int KS_OFF = 0, VT_OFF = 256 * KS_STRIDE;
__device__ __forceinline__ void attn_prompt_item(const Params& p, LAS unsigned char* lds, int item) {
    const int tid = fresh_tid(), lane = tid & 63, w = tid >> 6, fr = lane & 15, s = lane >> 4;
    const int g = item >> 9, rem = item & 511, nb = rem >> 7, rem2 = rem & 127, h = rem2 >> 5, rb = rem2 & 31;
    const int dsh = 2 * g, d = 1 << dsh, nbk = 32 >> dsh, r = rb / nbk, b = rb - r * nbk;
    const bf16_t* qb = (const bf16_t*)(p.ws + WS_QKV) + (size_t)(3 * g) * M * 256;
    const bf16_t* kb = qb + (size_t)M * 256; const bf16_t* vb = kb + (size_t)M * 256;
    const size_t rowbase = (size_t)nb * SEQ + r;
    const int i0 = 128 * (b - 1);
#pragma unroll
    for (int ii = 0; ii < 4; ++ii) { const int c = tid + NT * ii, kl = c >> 3, ch = c & 7; int ik = i0 + kl; ik = ik < 0 ? 0 : ik;
        const u32x4 v = *(const u32x4*)(kb + (rowbase + (size_t)ik * d) * 256 + h * 64 + ch * 8);
        *(LAS u32x4*)(lds + KS_OFF + kl * KS_STRIDE + ch * 16) = v; }
#pragma unroll
    for (int ii = 0; ii < 4; ++ii) { const int c = tid + NT * ii, kl = c & 255, ch = c >> 8; int ik = i0 + kl; ik = ik < 0 ? 0 : ik;
        const u32x4 v = *(const u32x4*)(vb + (rowbase + (size_t)ik * d) * 256 + h * 64 + ch * 8);
        LAS bf16_t* vt = (LAS bf16_t*)(lds + VT_OFF + (ch * 8) * VT_STRIDE) + kl;
        vt[0 * (VT_STRIDE / 2)] = (bf16_t)(v.x & 0xffff); vt[1 * (VT_STRIDE / 2)] = (bf16_t)(v.x >> 16);
        vt[2 * (VT_STRIDE / 2)] = (bf16_t)(v.y & 0xffff); vt[3 * (VT_STRIDE / 2)] = (bf16_t)(v.y >> 16);
        vt[4 * (VT_STRIDE / 2)] = (bf16_t)(v.z & 0xffff); vt[5 * (VT_STRIDE / 2)] = (bf16_t)(v.z >> 16);
        vt[6 * (VT_STRIDE / 2)] = (bf16_t)(v.w & 0xffff); vt[7 * (VT_STRIDE / 2)] = (bf16_t)(v.w >> 16); }
    const int iq = 128 * b + 16 * w + fr; const size_t qrow = rowbase + (size_t)iq * d;
    const bf16x8 q0 = *(const bf16x8*)(qb + qrow * 256 + h * 64 + 8 * s), q1 = *(const bf16x8*)(qb + qrow * 256 + h * 64 + 32 + 8 * s);
    __syncthreads();
    f32x4 sc[9];
#pragma unroll
    for (int j = 0; j < 9; ++j) {
        const LAS unsigned char* kp = lds + KS_OFF + (16 * (w + j) + fr) * KS_STRIDE + s * 16;
        const bf16x8 k0 = *(const LAS bf16x8*)kp, k1 = *(const LAS bf16x8*)(kp + 64);
        f32x4 a = {0.f, 0.f, 0.f, 0.f};
        a = __builtin_amdgcn_mfma_f32_16x16x32_bf16(k0, q0, a, 0, 0, 0);
        a = __builtin_amdgcn_mfma_f32_16x16x32_bf16(k1, q1, a, 0, 0, 0);
        sc[j] = a;
    }
    float mx = -INFINITY;
#pragma unroll
    for (int j = 0; j < 9; ++j)
#pragma unroll
        for (int i = 0; i < 4; ++i) { const int dist = 128 - 16 * j + fr - 4 * s - i; const int kl = 16 * (w + j) + 4 * s + i;
            const bool ok = (dist >= 0) && (dist <= 128) && (b > 0 || kl >= 128);
            sc[j][i] = ok ? sc[j][i] : -INFINITY; mx = fmaxf(mx, sc[j][i]); }
    mx = fmaxf(mx, __shfl_xor(mx, 16)); mx = fmaxf(mx, __shfl_xor(mx, 32));
    float sum = 0.f;
#pragma unroll
    for (int j = 0; j < 9; ++j)
#pragma unroll
        for (int i = 0; i < 4; ++i) { const float e = __expf(sc[j][i] - mx); sc[j][i] = e; sum += e; }
    sum += __shfl_xor(sum, 16); sum += __shfl_xor(sum, 32);
    f32x4 o[4];
#pragma unroll
    for (int dt = 0; dt < 4; ++dt) o[dt] = (f32x4){0.f, 0.f, 0.f, 0.f};
#pragma unroll
    for (int j = 0; j < 9; ++j) {
        u32x2 pw; pw.x = cvt_pk_bf16(sc[j][0], sc[j][1]); pw.y = cvt_pk_bf16(sc[j][2], sc[j][3]);
        const bf16x4 pf = __builtin_bit_cast(bf16x4, pw);
#pragma unroll
        for (int dt = 0; dt < 4; ++dt) {
            const bf16x4 vf = *(const LAS bf16x4*)(lds + VT_OFF + (16 * dt + fr) * VT_STRIDE + (16 * (w + j) + 4 * s) * 2);
            o[dt] = __builtin_amdgcn_mfma_f32_16x16x16bf16_1k(vf, pf, o[dt], 0, 0, 0);
        }
    }
    const float inv = 1.0f / sum;
    bf16_t* og = (bf16_t*)(p.ws + WS_OG) + (size_t)g * M * 256 + qrow * 256 + h * 64;
#pragma unroll
    for (int dt = 0; dt < 4; ++dt) { u32x2 ww; ww.x = cvt_pk_bf16(o[dt][0] * inv, o[dt][1] * inv); ww.y = cvt_pk_bf16(o[dt][2] * inv, o[dt][3] * inv); *(u32x2*)(og + 16 * dt + 4 * s) = ww; }
    if (s == 0) ((float*)(p.ws + WS_LSE))[((size_t)g * M + qrow) * 4 + h] = mx + __logf(sum);
    __syncthreads();
}

__device__ __forceinline__ void attn_sample_unit(const Params& p, LAS unsigned char* lds, int unit) {
    const int tid = fresh_tid(), lane = tid & 63, w = tid >> 6, ks = lane >> 4, dq = lane & 15;
    LAS float* ps = (LAS float*)(lds + w * 1024);
    const int it_ = unit >> 3, h = w & 3, t = 2 * (it_ & 3) + (w >> 2), g = (it_ >> 2) % 3, n = it_ / 12;
    const int dsh = 2 * g, d = 1 << dsh, W = 128 << dsh;
    const int nnew = (t >> dsh) + 1, ncache = 129 - nnew, idx0 = W + t - nnew * d;
    const size_t row = (size_t)MP + n * 8 + t;
    const bf16_t* qb = (const bf16_t*)(p.ws + WS_QKV) + (size_t)(3 * g) * M * 256 + h * 64 + 4 * dq;
    const bf16_t* kb = qb + (size_t)M * 256; const bf16_t* vb = kb + (size_t)M * 256;
    const float* cache = p.in[3 + g] + (size_t)n * W * 512 + h * 64 + 4 * dq;
    const u32x2 qq = *(const u32x2*)(qb + row * 256);
    const f32x4 qv = {bflo(qq.x), bfhi(qq.x), bflo(qq.y), bfhi(qq.y)};
    const size_t step = (size_t)4 * d * 512;
    { const float* kp = cache + (size_t)(idx0 - ks * d) * 512;
#pragma unroll 8
      for (int jj = 0; jj < 32; ++jj) {
          const f32x4 k = *(const f32x4*)kp; kp -= step;
          float a = (k[0] * qv[0] + k[1] * qv[1]) + (k[2] * qv[2] + k[3] * qv[3]);
          a += __shfl_xor(a, 1); a += __shfl_xor(a, 2); a += __shfl_xor(a, 4); a += __shfl_xor(a, 8);
          if (dq == 0) ps[4 * jj + ks] = (4 * jj + ks < ncache) ? a : -INFINITY;
      } }
#pragma unroll
    for (int i = 0; i < 2; ++i) { const int l = ks + 4 * i, lc = l < nnew ? l : 0;
        const u32x2 kk = *(const u32x2*)(kb + ((size_t)MP + n * 8 + (t - lc * d)) * 256);
        float a = (bflo(kk.x) * qv[0] + bfhi(kk.x) * qv[1]) + (bflo(kk.y) * qv[2] + bfhi(kk.y) * qv[3]);
        a += __shfl_xor(a, 1); a += __shfl_xor(a, 2); a += __shfl_xor(a, 4); a += __shfl_xor(a, 8);
        if (dq == 0) ps[128 + l] = (l < nnew) ? a : -INFINITY; }
    asm volatile("s_waitcnt lgkmcnt(0)" ::: "memory");
    const float s0 = ps[lane], s1 = ps[lane + 64], s2 = lane < 8 ? ps[128 + lane] : -INFINITY;
    const float mx = wave_max(fmaxf(fmaxf(s0, s1), s2));
    const float e0 = __expf(s0 - mx), e1 = __expf(s1 - mx), e2 = __expf(s2 - mx);
    asm volatile("s_waitcnt lgkmcnt(0)" ::: "memory");
    ps[lane] = e0; ps[lane + 64] = e1; if (lane < 8) ps[128 + lane] = e2;
    const float sum = wave_sum(e0 + e1 + e2);
    asm volatile("s_waitcnt lgkmcnt(0)" ::: "memory");
    f32x4 o = {0.f, 0.f, 0.f, 0.f};
    { const float* vp = cache + 256 + (size_t)(idx0 - ks * d) * 512;
#pragma unroll 8
      for (int jj = 0; jj < 32; ++jj) { const f32x4 v = *(const f32x4*)vp; vp -= step; o = o + v * ps[4 * jj + ks]; } }
#pragma unroll
    for (int i = 0; i < 2; ++i) { const int l = ks + 4 * i, lc = l < nnew ? l : 0;
        const u32x2 vv = *(const u32x2*)(vb + ((size_t)MP + n * 8 + (t - lc * d)) * 256);
        o = o + (f32x4){bflo(vv.x), bfhi(vv.x), bflo(vv.y), bfhi(vv.y)} * ps[128 + l]; }
#pragma unroll
    for (int i = 0; i < 4; ++i) { o[i] += __shfl_xor(o[i], 16); o[i] += __shfl_xor(o[i], 32); }
    const float inv = 1.0f / sum;
    if (ks == 0) { u32x2 ww; ww.x = cvt_pk_bf16(o[0] * inv, o[1] * inv); ww.y = cvt_pk_bf16(o[2] * inv, o[3] * inv);
        *(u32x2*)((bf16_t*)(p.ws + WS_OG) + (size_t)g * M * 256 + row * 256 + h * 64 + 4 * dq) = ww; }
    if (lane == 0) ((float*)(p.ws + WS_LSE))[((size_t)g * M + row) * 4 + h] = mx + __logf(sum);
    asm volatile("s_waitcnt lgkmcnt(0)" ::: "memory");
}

__device__ __forceinline__ float dpp_add16(float a) {
    a += __builtin_bit_cast(float, __builtin_amdgcn_update_dpp(0, __builtin_bit_cast(int, a), 0xB1, 0xF, 0xF, false));
    a += __builtin_bit_cast(float, __builtin_amdgcn_update_dpp(0, __builtin_bit_cast(int, a), 0x4E, 0xF, 0xF, false));
    a += __builtin_bit_cast(float, __builtin_amdgcn_update_dpp(0, __builtin_bit_cast(int, a), 0x141, 0xF, 0xF, false));
    a += __builtin_bit_cast(float, __builtin_amdgcn_update_dpp(0, __builtin_bit_cast(int, a), 0x140, 0xF, 0xF, false));
    return a;
}
struct SoftAcc { float m, l; f32x4 o; };
#ifndef SAC_NS
#define SAC_NS 2
#endif
template <int R>
__device__ __forceinline__ void soft_update(SoftAcc& A, const float (&sc)[R], const f32x4 (&v)[R]) {
    float mn = A.m;
#pragma unroll
    for (int i = 0; i < R; ++i) mn = fmaxf(mn, sc[i]);
    const float corr = __expf(A.m - mn);
    float ps = 0.f; f32x4 po = {0.f, 0.f, 0.f, 0.f};
#pragma unroll
    for (int i = 0; i < R; ++i) { const float pi = __expf(sc[i] - mn); ps += pi; po = po + v[i] * pi; }
    A.l = A.l * corr + ps; A.o = A.o * corr + po; A.m = mn;
}
template <int GI>
__device__ __forceinline__ void sac_unit(const Params& p, int n, int kh) {
    constexpr int dsh = 2 * GI, d = 1 << dsh, W = 128 << dsh;
    const int tid = threadIdx.x, lane = tid & 63, w = tid >> 6, dq = lane & 15, h = lane >> 4;
    const int t = w, nnew = (t >> dsh) + 1, ncache = 129 - nnew, idx0 = W - d + (t & (d - 1));
    const size_t srow = (size_t)n * 8 + t, row = (size_t)MP + srow;
    const bf16_t* qb = (const bf16_t*)(p.ws + WS_QKV) + (size_t)(3 * GI) * M * 256 + lane * 4;
    const bf16_t* kb = qb + (size_t)M * 256; const bf16_t* vb = kb + (size_t)M * 256;
    const u32x2 qq = *(const u32x2*)(qb + row * 256);
    const f32x4 qv = {bflo(qq.x), bfhi(qq.x), bflo(qq.y), bfhi(qq.y)};
    const float* cbase = p.in[3 + GI] + (size_t)n * W * 512 + lane * 4;
    float* obase = p.out + (GI == 0 ? O_KVS0 : (GI == 1 ? O_KVS1 : O_KVS2)) + (size_t)n * W * 512 + lane * 4;
    SoftAcc A; A.m = -INFINITY; A.l = 0.f; A.o = (f32x4){0.f, 0.f, 0.f, 0.f};
    const int c0 = kh ? 0 : 64;
    constexpr int R = (GI == 2) ? 2 : 4;
    struct Rows { f32x4 k[R], v[R], k2[R], v2[R]; };
    auto load_rows = [&](Rows& X, int cc) {
#pragma unroll
        for (int i = 0; i < R; ++i) { const float* rp = cbase + (size_t)(idx0 - (c0 + cc + i) * d) * 512;
            if (GI == 2) { X.k[i] = __builtin_nontemporal_load((const f32x4*)rp); X.v[i] = __builtin_nontemporal_load((const f32x4*)(rp + 256)); X.k2[i] = __builtin_nontemporal_load((const f32x4*)(rp + 8 * 512)); X.v2[i] = __builtin_nontemporal_load((const f32x4*)(rp + 8 * 512 + 256)); }
            else { X.k[i] = *(const f32x4*)rp; X.v[i] = *(const f32x4*)(rp + 256); } }
    };
    auto process_rows = [&](Rows& X, int cc) {
        float sc[R];
#pragma unroll
        for (int i = 0; i < R; ++i) { const float a = dpp_add16((X.k[i][0] * qv[0] + X.k[i][1] * qv[1]) + (X.k[i][2] * qv[2] + X.k[i][3] * qv[3])); sc[i] = (c0 + cc + i < ncache) ? a : -INFINITY; }
        soft_update<R>(A, sc, X.v);
#pragma unroll
        for (int i = 0; i < R; ++i) { const int idx = idx0 - (c0 + cc + i) * d;
            const bool mine = (GI == 2) ? true : (GI == 1 ? (w < 4) : ((idx & 7) == w));
            if (mine && idx >= 8) { float* op = obase + (size_t)(idx - 8) * 512; __builtin_nontemporal_store(X.k[i], (f32x4*)op); __builtin_nontemporal_store(X.v[i], (f32x4*)(op + 256)); }
            if (GI == 2) { float* op = obase + (size_t)idx * 512; __builtin_nontemporal_store(X.k2[i], (f32x4*)op); __builtin_nontemporal_store(X.v2[i], (f32x4*)(op + 256)); } }
    };
    { constexpr int NS = SAC_NS; Rows X[NS];
#pragma unroll
      for (int st = 0; st < NS - 1; ++st) load_rows(X[st], st * R);
#pragma unroll 1
      for (int cc = 0; cc < 64; cc += NS * R) {
#pragma unroll
          for (int st = 0; st < NS; ++st) { const int nxt = cc + (st + NS - 1) * R; if (nxt < 64) load_rows(X[(st + NS - 1) % NS], nxt); process_rows(X[st], cc + st * R); }
      } }
    if (kh) {
#pragma unroll
        for (int gq = 0; gq < 2; ++gq) {
            float sc[4]; f32x4 v[4];
#pragma unroll
            for (int i = 0; i < 4; ++i) { const int l = 4 * gq + i, lc = l < nnew ? l : 0; const size_t kr = ((size_t)MP + n * 8 + (t - lc * d)) * 256;
                const u32x2 kk = *(const u32x2*)(kb + kr), vv = *(const u32x2*)(vb + kr);
                const float a = dpp_add16((bflo(kk.x) * qv[0] + bfhi(kk.x) * qv[1]) + (bflo(kk.y) * qv[2] + bfhi(kk.y) * qv[3]));
                sc[i] = (l < nnew) ? a : -INFINITY; v[i] = (f32x4){bflo(vv.x), bfhi(vv.x), bflo(vv.y), bfhi(vv.y)}; }
            soft_update<4>(A, sc, v);
        }
    }
    const float inv = 1.0f / A.l; const int pg = 2 * GI + kh;
    u32x2 ww; ww.x = cvt_pk_bf16(A.o[0] * inv, A.o[1] * inv); ww.y = cvt_pk_bf16(A.o[2] * inv, A.o[3] * inv);
    *(u32x2*)((bf16_t*)(p.ws + WS_OGS) + ((size_t)pg * MS + srow) * 256 + lane * 4) = ww;
    if (dq == 0) ((float*)(p.ws + WS_LSES))[((size_t)pg * MS + srow) * 4 + h] = A.m + __logf(A.l);
}
__device__ __forceinline__ void phase_sample_attn_copy(const Params& p) {
    for (int u = blockIdx.x; u < 256; u += gridDim.x) { const int n = u >> 1, kh = u & 1; sac_unit<2>(p, n, kh); sac_unit<1>(p, n, kh); sac_unit<0>(p, n, kh); }
}

__device__ __forceinline__ void load_u8(const bf16_t* zc, size_t row, int c, float (&u)[8]) {
    const u32x4 a = *(const u32x4*)(zc + row * 1536 + 512 + c), b = *(const u32x4*)(zc + row * 1536 + 1024 + c);
    u[0] = bflo(a.x) * bflo(b.x); u[1] = bfhi(a.x) * bfhi(b.x); u[2] = bflo(a.y) * bflo(b.y); u[3] = bfhi(a.y) * bfhi(b.y);
    u[4] = bflo(a.z) * bflo(b.z); u[5] = bfhi(a.z) * bfhi(b.z); u[6] = bflo(a.w) * bflo(b.w); u[7] = bfhi(a.w) * bfhi(b.w);
}
__device__ __forceinline__ void phase_conv(const Params& p) {
    const bf16_t* zc = (const bf16_t*)(p.ws + WS_ZC); bf16_t* yc = (bf16_t*)(p.ws + WS_YC);
    const float* cw = p.in[8]; const float* st = p.in[2];
    const size_t gt = (size_t)blockIdx.x * NT + fresh_tid(), GT = (size_t)gridDim.x * NT;
    for (size_t i = gt; i < (size_t)M * 64; i += GT) {
        const size_t row = i >> 6; const int c = (int)(i & 63) * 8;
        float u0[8], u1[8], u2[8];
        load_u8(zc, row, c, u2);
        int tpos; int nb = 0; const bool prm = row < MP;
        if (prm) tpos = (int)(row & 4095); else { const int rs = (int)(row - MP); nb = rs >> 3; tpos = rs & 7; }
        if (tpos >= 1) load_u8(zc, row - 1, c, u1);
        else if (prm) {
#pragma unroll
            for (int e = 0; e < 8; ++e) u1[e] = 0.f; }
        else { const f32x4 a = *(const f32x4*)(st + ((size_t)nb * 2 + 1) * 512 + c), b = *(const f32x4*)(st + ((size_t)nb * 2 + 1) * 512 + c + 4);
            u1[0] = a[0]; u1[1] = a[1]; u1[2] = a[2]; u1[3] = a[3]; u1[4] = b[0]; u1[5] = b[1]; u1[6] = b[2]; u1[7] = b[3]; }
        if (tpos >= 2) load_u8(zc, row - 2, c, u0);
        else if (prm) {
#pragma unroll
            for (int e = 0; e < 8; ++e) u0[e] = 0.f; }
        else { const int si = tpos;
            const f32x4 a = *(const f32x4*)(st + ((size_t)nb * 2 + si) * 512 + c), b = *(const f32x4*)(st + ((size_t)nb * 2 + si) * 512 + c + 4);
            u0[0] = a[0]; u0[1] = a[1]; u0[2] = a[2]; u0[3] = a[3]; u0[4] = b[0]; u0[5] = b[1]; u0[6] = b[2]; u0[7] = b[3]; }
        const u32x4 bb = *(const u32x4*)(zc + row * 1536 + c);
        const float Bv[8] = {bflo(bb.x), bfhi(bb.x), bflo(bb.y), bfhi(bb.y), bflo(bb.z), bfhi(bb.z), bflo(bb.w), bfhi(bb.w)};
        float y[8];
#pragma unroll
        for (int e = 0; e < 8; ++e) y[e] = Bv[e] * (cw[c + e] * u0[e] + cw[512 + c + e] * u1[e] + cw[1024 + c + e] * u2[e]);
        u32x4 o; o.x = cvt_pk_bf16(y[0], y[1]); o.y = cvt_pk_bf16(y[2], y[3]); o.z = cvt_pk_bf16(y[4], y[5]); o.w = cvt_pk_bf16(y[6], y[7]);
        *(u32x4*)(yc + row * 512 + c) = o;
        float* so = nullptr;
        if (prm) { if (tpos >= SEQ - 2) so = p.out + O_CP + ((size_t)(row >> 12) * 2 + (tpos - (SEQ - 2))) * 512 + c; }
        else if (tpos >= 6) so = p.out + O_CS + ((size_t)nb * 2 + (tpos - 6)) * 512 + c;
        if (so) { *(f32x4*)so = (f32x4){u2[0], u2[1], u2[2], u2[3]}; *(f32x4*)(so + 4) = (f32x4){u2[4], u2[5], u2[6], u2[7]}; }
    }
}

constexpr int CP_PIECE = 8192;
constexpr int CP_UNITS_N = 2 + 8 + 32;
constexpr int CP_UNITS = 128 * CP_UNITS_N;
__device__ __forceinline__ void copy_unit(const Params& p, int unit) {
    const int n = unit / CP_UNITS_N, q = unit - n * CP_UNITS_N;
    const int g = q < 2 ? 0 : (q < 10 ? 1 : 2), piece = q - (g == 0 ? 0 : (g == 1 ? 2 : 10));
    const int W = 128 << (2 * g);
    const size_t per = (size_t)(W - 8) * 128, full = (size_t)W * 128;
    const f32x4* src = (const f32x4*)p.in[3 + g] + n * full + 1024 + (size_t)piece * CP_PIECE;
    f32x4* dst = (f32x4*)(p.out + (g == 0 ? O_KVS0 : (g == 1 ? O_KVS1 : O_KVS2))) + n * full + (size_t)piece * CP_PIECE;
    const int cnt = (int)((per - (size_t)piece * CP_PIECE) < (size_t)CP_PIECE ? (per - (size_t)piece * CP_PIECE) : (size_t)CP_PIECE);
    const int tid = fresh_tid();
#pragma unroll
    for (int u = 0; u < 2; ++u) {
        f32x4 v[8];
#pragma unroll
        for (int k = 0; k < 8; ++k) { const int idx = tid + (u * 8 + k) * NT; if (idx < cnt) v[k] = __builtin_nontemporal_load(src + idx); }
#pragma unroll
        for (int k = 0; k < 8; ++k) { const int idx = tid + (u * 8 + k) * NT; if (idx < cnt) __builtin_nontemporal_store(v[k], dst + idx); }
    }
}
__device__ __forceinline__ void phase_copy(const Params& p) {
    for (int u = blockIdx.x; u < CP_UNITS; u += gridDim.x) copy_unit(p, u);
}

template <int NG>
__device__ __forceinline__ void merge_rows(const bf16_t* og, const float* lse, size_t gstride_rows, size_t row, int c, bf16_t* dst) {
    const int h = c >> 6; float l[NG], mx = -INFINITY;
#pragma unroll
    for (int g = 0; g < NG; ++g) { l[g] = lse[((size_t)g * gstride_rows + row) * 4 + h]; mx = fmaxf(mx, l[g]); }
    float ws = 0.f;
#pragma unroll
    for (int g = 0; g < NG; ++g) { l[g] = __expf(l[g] - mx); ws += l[g]; }
    const float inv = 1.0f / ws; float acc[8];
#pragma unroll
    for (int e = 0; e < 8; ++e) acc[e] = 0.f;
#pragma unroll
    for (int g = 0; g < NG; ++g) { const u32x4 a = *(const u32x4*)(og + ((size_t)g * gstride_rows + row) * 256 + c); const float wg = l[g] * inv;
        acc[0] += wg * bflo(a.x); acc[1] += wg * bfhi(a.x); acc[2] += wg * bflo(a.y); acc[3] += wg * bfhi(a.y); acc[4] += wg * bflo(a.z); acc[5] += wg * bfhi(a.z); acc[6] += wg * bflo(a.w); acc[7] += wg * bfhi(a.w); }
    u32x4 o; o.x = cvt_pk_bf16(acc[0], acc[1]); o.y = cvt_pk_bf16(acc[2], acc[3]); o.z = cvt_pk_bf16(acc[4], acc[5]); o.w = cvt_pk_bf16(acc[6], acc[7]);
    *(u32x4*)dst = o;
}
__device__ __forceinline__ void phase_merge(const Params& p) {
    bf16_t* ya = (bf16_t*)(p.ws + WS_YA);
    const size_t gt = (size_t)blockIdx.x * NT + threadIdx.x, GT = (size_t)gridDim.x * NT;
    for (size_t i = gt; i < (size_t)M * 32; i += GT) {
        const size_t row = i >> 5; const int c = (int)(i & 31) * 8;
        if (row < MP) merge_rows<3>((const bf16_t*)(p.ws + WS_OG), (const float*)(p.ws + WS_LSE), M, row, c, ya + row * 256 + c);
        else merge_rows<6>((const bf16_t*)(p.ws + WS_OGS), (const float*)(p.ws + WS_LSES), MS, row - MP, c, ya + row * 256 + c);
    }
}

template <bool FINAL>
__device__ __forceinline__ void phase_ln(const Params& p, const float* gam, const float* bet) {
    constexpr int NSL = FINAL ? 8 : 4;
    const int lane = threadIdx.x & 63, w = threadIdx.x >> 6;
    const float* pre = (const float*)(p.ws + WS_PRE); const float* part = (const float*)(p.ws + WS_PART);
    f32x4 gv[4], bv[4];
#pragma unroll
    for (int j = 0; j < 4; ++j) { gv[j] = ((const f32x4*)gam)[lane + 64 * j]; bv[j] = ((const f32x4*)bet)[lane + 64 * j]; }
    for (int row = blockIdx.x * 8 + w; row < M; row += gridDim.x * 8) {
        f32x4 v[4];
        if (row < MP) { const f32x4* xr = (const f32x4*)(pre + (size_t)row * 1024) + lane;
#pragma unroll
            for (int j = 0; j < 4; ++j) v[j] = xr[64 * j]; }
        else { const int rs = row - MP;
#pragma unroll
            for (int j = 0; j < 4; ++j) {
                if (FINAL) { const u32x2 rr = ((const u32x2*)(p.ws + WS_X1B + (size_t)row * 2048))[lane + 64 * j]; v[j] = (f32x4){bflo(rr.x), bfhi(rr.x), bflo(rr.y), bfhi(rr.y)} * ALPHA; }
                else v[j] = ((const f32x4*)(p.in[1] + (size_t)rs * 1024))[lane + 64 * j] * ALPHA; }
#pragma unroll 2
            for (int z = 0; z < NSL; ++z) { const f32x4* pr = (const f32x4*)(part + ((size_t)z * MS + rs) * 1024) + lane;
#pragma unroll
                for (int j = 0; j < 4; ++j) v[j] = v[j] + pr[64 * j]; } }
        float s = 0.f;
#pragma unroll
        for (int j = 0; j < 4; ++j) s += (v[j][0] + v[j][1]) + (v[j][2] + v[j][3]);
        const float mean = wave_sum(s) * (1.f / 1024.f); float s2 = 0.f;
#pragma unroll
        for (int j = 0; j < 4; ++j) { v[j] = v[j] - mean; s2 += (v[j][0] * v[j][0] + v[j][1] * v[j][1]) + (v[j][2] * v[j][2] + v[j][3] * v[j][3]); }
        const float rstd = 1.f / sqrtf(wave_sum(s2) * (1.f / 1024.f) + LN_EPS);
#pragma unroll
        for (int j = 0; j < 4; ++j) { const f32x4 y = v[j] * rstd * gv[j] + bv[j];
            if (FINAL) { ((f32x4*)(p.out + (size_t)row * 1024))[lane + 64 * j] = y; }
            else { u32x2 ww; ww.x = cvt_pk_bf16(y[0], y[1]); ww.y = cvt_pk_bf16(y[2], y[3]); ((u32x2*)(p.ws + WS_X1B + (size_t)row * 2048))[lane + 64 * j] = ww; } }
    }
}

#define XB_TMO      128
#define XB_XCNT(j)  (256  + 64 * (j))
#define XB_XSUB(j)  (1280 + 64 * (j))
#define XB_XGEN(j)  (2304 + 64 * (j))
#define XB_TOP      3328
#define XB_TOPGEN   3392
#define XCD_BAR_WORDS 3456
#define XB_SPIN_CAP (1u << 18)
__device__ __forceinline__ unsigned xb_ld(unsigned* p)              { return __hip_atomic_load(p, __ATOMIC_RELAXED, __HIP_MEMORY_SCOPE_AGENT); }
__device__ __forceinline__ unsigned xb_add(unsigned* p, unsigned v) { return __hip_atomic_fetch_add(p, v, __ATOMIC_RELAXED, __HIP_MEMORY_SCOPE_AGENT); }
__device__ __forceinline__ unsigned xb_xcc_id() { return (unsigned)__builtin_amdgcn_s_getreg((3 << 11) | 20) & 0xFu; }
#define XB_SPIN(cond, bar) do { unsigned _sp = 0; while (cond) { __builtin_amdgcn_s_sleep(1); \
    if ((++_sp & 255u) == 0u) { if (xb_ld(&(bar)[XB_TMO])) break; if (_sp > XB_SPIN_CAP) { atomicAdd(&(bar)[XB_TMO], 1u); break; } } } } while (0)
struct XcdBarrier { unsigned* bar; unsigned x; volatile LAS unsigned* st; };
__device__ __forceinline__ XcdBarrier xcd_barrier_post(unsigned* bar, volatile LAS unsigned* st) {
    XcdBarrier b; b.bar = bar; b.x = xb_xcc_id(); b.st = st;
    if (threadIdx.x == 0) (void)xb_add(&bar[XB_XCNT(b.x)], 1u);
    return b;
}
__device__ __forceinline__ void xcd_barrier_complete(unsigned* bar, unsigned x, unsigned& nloc, unsigned& nx) {
    const unsigned G = gridDim.x * gridDim.y * gridDim.z;
    unsigned sum, cnt, mine, sp = 0u;
    for (;;) {
        sum = 0u; cnt = 0u; mine = 0u;
#pragma unroll
        for (unsigned j = 0; j < 16; ++j) { const unsigned c = xb_ld(&bar[XB_XCNT(j)]); sum += c; cnt += (c > 0u) ? 1u : 0u; mine = (j == x) ? c : mine; }
        if (sum == G) break;
        __builtin_amdgcn_s_sleep(1);
        if ((++sp & 255u) == 0u) { if (xb_ld(&bar[XB_TMO])) break; if (sp > XB_SPIN_CAP) { atomicAdd(&bar[XB_TMO], 1u); break; } }
    }
    nloc = mine > 0u ? mine : 1u; nx = cnt > 0u ? cnt : 1u;
}
__device__ __forceinline__ void xcd_barrier(const XcdBarrier& b) {
    asm volatile("s_waitcnt vmcnt(0)" ::: "memory");
    __syncthreads();
    if (threadIdx.x == 0) {
        unsigned* bar = b.bar;
        __builtin_amdgcn_s_waitcnt(0);
        unsigned nloc = b.st[0], nx = b.st[1];
        if (nloc == 0u) { xcd_barrier_complete(bar, b.x, nloc, nx); b.st[0] = nloc; b.st[1] = nx; }
        const unsigned old = xb_add(&bar[XB_XSUB(b.x)], 1u);
        const unsigned gen = old / nloc;
        if (old + 1u == (gen + 1u) * nloc) {
            __builtin_amdgcn_fence(__ATOMIC_RELEASE, "agent");
            asm volatile("s_waitcnt vmcnt(0)" ::: "memory");
            const unsigned og = xb_add(&bar[XB_TOP], 1u);
            const unsigned tg = og / nx;
            if (og + 1u == (tg + 1u) * nx) xb_add(&bar[XB_TOPGEN], 1u);
            else XB_SPIN(xb_ld(&bar[XB_TOPGEN]) == tg, bar);
            __builtin_amdgcn_fence(__ATOMIC_ACQUIRE, "agent");
            xb_add(&bar[XB_XGEN(b.x)], 1u);
            asm volatile("s_waitcnt vmcnt(0)" ::: "memory");
        } else {
            XB_SPIN(xb_ld(&bar[XB_XGEN(b.x)]) == gen, bar);
            __builtin_amdgcn_fence(__ATOMIC_ACQUIRE, "agent");
            asm volatile("s_waitcnt vmcnt(0)" ::: "memory");
        }
    }
    __syncthreads();
}

constexpr int N_PHASES = 10;
__global__ void __launch_bounds__(NT, 2) fwd_kernel(Params p) {
    extern __shared__ __attribute__((aligned(16))) unsigned char smem[];
    LAS unsigned char* lds = (LAS unsigned char*)smem;
    unsigned char* ws = p.ws;
    const int G = gridDim.x, bx = blockIdx.x;
#if MK_MULTI
#define SYNC() do {} while (0)
#else
    cg::grid_group grid = cg::this_grid();
    if (p.ph_lo < 0) grid.sync();
    volatile LAS unsigned* xst = (volatile LAS unsigned*)(lds + pg8::STAGE_BYTES);
    if (threadIdx.x < 4) xst[threadIdx.x] = 0u;
    __syncthreads();
    const XcdBarrier xbar = xcd_barrier_post((unsigned*)(ws + WS_BAR), xst);
#define SYNC1() xcd_barrier(xbar)
#define SYNC() do { SYNC1(); if (DUP == 30) SYNC1(); } while (0)
#endif
#ifndef DUP
#define DUP -1
#endif
#define IN(k) (p.ph_lo <= (k) && (k) < p.ph_hi)
#define REP(k) for (int rep_ = 0; rep_ < ((DUP) == (k) ? 2 : 1); ++rep_)
    if (IN(0)) { REP(0) { phase_prep(p, lds); __syncthreads(); } SYNC(); }
    if (IN(1)) {
        constexpr int GEMM_WGS = 192;
        pg8::Gemm g{(const bf16_t*)(ws + WS_XB), (const bf16_t*)(ws + WS_WIN), M, NIN, D};
        Epi1 E{(bf16_t*)(ws + WS_ZC), (bf16_t*)(ws + WS_QKV), (bf16_t*)(ws + WS_GATE), p.in[7], (const float*)(ws + WS_ROPE), p.out};
        { P1Order S{0, G, (G < 1564 ? G : 1564), bx}; pg8::gemm_phase<Epi1, P1Order, true, true>(lds, g, S, E); }
        SYNC();
        { const int gw = G > 64 ? (G * 3) / 4 : G;
          if (gw != GEMM_WGS && bx == 0 && threadIdx.x == 0) {   }
          P1Order S{G < 1564 ? G : 1564, gw, 1564, bx}; pg8::gemm_phase<Epi1, P1Order, true, true>(lds, g, S, E); }
        { unsigned* qctr = (unsigned*)(ws + WS_BAR) + 3520;
          for (;;) {
              __syncthreads();
              if (threadIdx.x == 0) xst[2] = __hip_atomic_fetch_add(qctr, 1u, __ATOMIC_RELAXED, __HIP_MEMORY_SCOPE_AGENT);
              __syncthreads();
              const int u = (int)xst[2]; if (u >= 256) break;
              const int n = u >> 1, kh = u & 1; sac_unit<2>(p, n, kh); sac_unit<1>(p, n, kh); sac_unit<0>(p, n, kh);
          } }
        SYNC();
    }
    if (IN(2)) {
        REP(21) for (int it = bx; it < 1536; it += G) attn_prompt_item(p, lds, it);
        REP(23) phase_conv(p);
        __syncthreads();
        SYNC();
    }
    if (IN(3)) { REP(3) phase_merge(p); SYNC(); }
    if (IN(4)) {
        REP(4) {
        { pg8::Gemm g{(const bf16_t*)(ws + WS_YC), (const bf16_t*)(ws + WS_WC), M, D, DC}; pg8::StaticOrder S; S.init(M, D, G, bx, DC);
          Epi3 E{(bf16_t*)(ws + WS_MIX), (const bf16_t*)(ws + WS_GATE), 0};
          pg8::gemm_phase<Epi3, pg8::StaticOrder, true, true>(lds, g, S, E); }
        { pg8::Gemm g{(const bf16_t*)(ws + WS_YA), (const bf16_t*)(ws + WS_WA), M, D, 256}; pg8::StaticOrder S; S.init(M, D, G, bx, 256);
          Epi3 E{(bf16_t*)(ws + WS_MIX), (const bf16_t*)(ws + WS_GATE), 1};
          pg8::gemm_phase<Epi3, pg8::StaticOrder, true, true>(lds, g, S, E); }
        }
        SYNC();
    }
    if (IN(5)) {
        REP(5) {
        pg8::Gemm g{(const bf16_t*)(ws + WS_MIX), (const bf16_t*)(ws + WS_WO), M, D, D}; SplitOrder S{4, D / 64, G, bx};
        EpiRes<false> E{p.in[0], (float*)(ws + WS_PRE), (float*)(ws + WS_PART)};
        pg8::gemm_phase<EpiRes<false>, SplitOrder, true, true>(lds, g, S, E);
        }
        SYNC();
    }
    if (IN(6)) { REP(6) phase_ln<false>(p, p.in[12], p.in[13]); SYNC(); }
    if (IN(7)) {
        REP(7) {
        pg8::Gemm g{(const bf16_t*)(ws + WS_X1B), (const bf16_t*)(ws + WS_WUP), M, FF, D}; pg8::StaticOrder S; S.init(M, FF, G, bx, D);
        EpiHid E{(bf16_t*)(ws + WS_HID)};
        pg8::gemm_phase<EpiHid, pg8::StaticOrder, true, true>(lds, g, S, E);
        }
        SYNC();
    }
    if (IN(8)) {
        REP(8) {
        pg8::Gemm g{(const bf16_t*)(ws + WS_HID), (const bf16_t*)(ws + WS_WDN), M, D, FF}; SplitOrder S{8, FF / 64, G, bx};
        EpiRes<true> E{(const void*)(ws + WS_X1B), (float*)(ws + WS_PRE), (float*)(ws + WS_PART)};
        pg8::gemm_phase<EpiRes<true>, SplitOrder, true, true>(lds, g, S, E);
        }
        SYNC();
    }
    if (IN(9)) { REP(9) phase_ln<true>(p, p.in[16], p.in[17]); }
#ifdef DUMP
    if (IN(20)) { const size_t gt = (size_t)blockIdx.x * NT + threadIdx.x, GT = (size_t)gridDim.x * NT;
        for (size_t i = gt; i < (size_t)M * 1024; i += GT) { const size_t row = i >> 10, c = i & 1023; float v;
            if (DUMP == 1) { v = bf1(((const bf16_t*)(ws + WS_GATE))[row * 2048 + c]) + bf1(((const bf16_t*)(ws + WS_GATE))[row * 2048 + 1024 + c]) + bf1(((const bf16_t*)(ws + WS_ZC))[row * 1536 + c]) + bf1(((const bf16_t*)(ws + WS_ZC))[row * 1536 + 512 + c]);
                for (int sl = 0; sl < 9; ++sl) v += (float)(sl + 1) * bf1(((const bf16_t*)(ws + WS_QKV))[((size_t)sl * M + row) * 256 + (c & 255)]); }
            else if (DUMP == 2) { v = bf1(((const bf16_t*)(ws + WS_YC))[row * 512 + (c & 511)]);
                for (int sl = 0; sl < 3; ++sl) v += (float)(sl + 1) * bf1(((const bf16_t*)(ws + WS_OG))[((size_t)sl * M + row) * 256 + (c & 255)]) + ((const float*)(ws + WS_LSE))[((size_t)sl * M + row) * 4 + (c & 3)]; }
            else if (DUMP == 3) v = bf1(((const bf16_t*)(ws + WS_YA))[row * 256 + (c & 255)]);
            else if (DUMP == 4) v = bf1(((const bf16_t*)(ws + WS_MIX))[i]);
            else if (DUMP == 5 || DUMP == 8) v = ((const float*)(ws + WS_PRE))[i];
            else if (DUMP == 6) v = ((const float*)(ws + WS_X1F))[i];
            else { const bf16_t* hp = (const bf16_t*)(ws + WS_HID) + row * 4096 + c; v = bf1(hp[0]) + bf1(hp[1024]) + bf1(hp[2048]) + bf1(hp[3072]); }
            p.out[i] = v; } }
#endif
#undef IN
#undef SYNC
}

extern "C" void kernel_launch(void* const* d_in, const int* in_sizes, int n_in, void* d_out, int out_size, void* d_ws, size_t ws_size, hipStream_t stream) {
    static int grid = 0;
    if (grid == 0) {
        if (n_in != 18 || (size_t)out_size != O_END || ws_size < WS_END) { fprintf(stderr, "kernel_launch: unexpected shapes (n_in %d out %d ws %zu need %zu)\n", n_in, out_size, ws_size, (size_t)WS_END); grid = -1; return; }
        int dev = 0, cus = 0, per_cu = 0;
        (void)hipGetDevice(&dev); (void)hipDeviceGetAttribute(&cus, hipDeviceAttributeMultiprocessorCount, dev);
        if (hipFuncSetAttribute((const void*)fwd_kernel, hipFuncAttributeMaxDynamicSharedMemorySize, LDS_BYTES) != hipSuccess) { fprintf(stderr, "kernel_launch: hipFuncSetAttribute failed\n"); grid = -1; return; }
        if (hipOccupancyMaxActiveBlocksPerMultiprocessor(&per_cu, (const void*)fwd_kernel, NT, LDS_BYTES) != hipSuccess || per_cu < 1) { fprintf(stderr, "kernel_launch: occupancy query says %d\n", per_cu); per_cu = 1; }
        (void)hipGetLastError();
        grid = cus * 1;
    }
    if (grid < 0) return;
    Params p{};
    for (int i = 0; i < 18; ++i) p.in[i] = (const float*)d_in[i];
    p.out = (float*)d_out; p.ws = (unsigned char*)d_ws;
#if MK_MULTI
#ifdef DUMP
    for (int k = 0; k <= DUMP; ++k) { p.ph_lo = k; p.ph_hi = k + 1; hipLaunchKernelGGL(fwd_kernel, dim3(grid), dim3(NT), LDS_BYTES, stream, p); }
    p.ph_lo = 20; p.ph_hi = 21; hipLaunchKernelGGL(fwd_kernel, dim3(grid), dim3(NT), LDS_BYTES, stream, p);
#else
    for (int k = 0; k < N_PHASES; ++k) { p.ph_lo = k; p.ph_hi = k + 1; hipLaunchKernelGGL(fwd_kernel, dim3(grid), dim3(NT), LDS_BYTES, stream, p); }
#endif
#else
    p.ph_lo = 0; p.ph_hi = N_PHASES;
    if (hipMemsetAsync((char*)d_ws + WS_BAR, 0, 16384, stream) != hipSuccess) { fprintf(stderr, "kernel_launch: memset of the barrier words failed\n"); return; }
    void* args[] = {&p};
    hipError_t e = hipLaunchCooperativeKernel((const void*)fwd_kernel, dim3(grid), dim3(NT), args, LDS_BYTES, stream);
    if (e != hipSuccess) fprintf(stderr, "cooperative launch failed: %s (grid %d)\n", hipGetErrorString(e), grid);
#endif
}
```

```cpp
#include <hip/hip_runtime.h>
#include <hip/hip_cooperative_groups.h>
#include <cstdio>
#include <cstdint>
namespace cg = cooperative_groups;

#ifndef MK_MULTI
#define MK_MULTI 0
#define DUP -1
#endif

__device__ __forceinline__ int fresh_tid() { return threadIdx.x; }
namespace pg8 {
#define PG8_LAS __attribute__((address_space(3)))
typedef unsigned short bf16_t;
typedef short bf16x8 __attribute__((ext_vector_type(8)));
typedef float f32x4 __attribute__((ext_vector_type(4)));
typedef unsigned u32x4 __attribute__((ext_vector_type(4)));
typedef unsigned u32x2 __attribute__((ext_vector_type(2)));
constexpr int BM = 256, BK = 64, HALF = 128, HTB = HALF * BK * 2, STAGE_BYTES = 8 * HTB, NXCD = 8, WGM = 8;

__host__ __device__ __forceinline__ int lds_byte(int r, int c) { const int st = (r >> 4) * 2 + (c >> 5), rr = r & 15, cc = c & 31, ob = rr * 64 + cc * 2; return st * 1024 + (ob ^ (((ob >> 9) & 1) << 5)); }
__host__ __device__ __forceinline__ void stage_rc(int b, int& R, int& C) { const int st = b / 1024, sb = b % 1024, swz = sb ^ (((sb >> 9) & 1) << 5); R = (st >> 1) * 16 + swz / 64; C = (st & 1) * 32 + (swz % 64) / 2; }
__host__ __device__ __forceinline__ int perm32(int rho) { const int n = rho >> 4, i = rho & 15; return 8 * (i >> 2) + 4 * n + (i & 3); }
__host__ __device__ __forceinline__ int swap45(int v) { return (v & 15) | ((v & 16) << 1) | ((v & 32) >> 1); }

struct Unit { int pm, pn, kt0, nt; };
struct Gemm { const bf16_t* A; const bf16_t* Bt; int M, N, K; };

struct StaticOrder {
    int nM, nN, nwg, G, c, ntk;
    __host__ __device__ void init(int M, int N, int G_, int c_, int K_) { nM = M / BM; nN = N / BM; nwg = nM * nN; G = G_; c = c_; ntk = K_ / BK; }
    __host__ __device__ bool next(int i, Unit& u) const {
        u.kt0 = 0; u.nt = ntk;
        const long L = (long)i * G + c; if (L >= nwg) return false;
        int wgid = (int)L; { const int q = nwg / NXCD, r = nwg % NXCD, xcd = wgid % NXCD, off = wgid / NXCD; wgid = (xcd < r ? xcd * (q + 1) : r * (q + 1) + (xcd - r) * q) + off; }
        const int nig = WGM * nN, gid = wgid / nig, fm = gid * WGM, gsz = (nM - fm) < WGM ? (nM - fm) : WGM;
        u.pm = fm + ((wgid % nig) % gsz); u.pn = (wgid % nig) / gsz; return true;
    }
    __device__ __forceinline__ void a_ready(const Unit&) const {}
    __device__ __forceinline__ void done(const Unit&) const {}
};

typedef float cvt_f32x2 __attribute__((ext_vector_type(2)));
typedef __bf16 cvt_bf16x2 __attribute__((ext_vector_type(2)));
__device__ __forceinline__ unsigned cvt_pk_bf16(float lo, float hi) { const cvt_f32x2 v = {lo, hi}; const cvt_bf16x2 b = __builtin_convertvector(v, cvt_bf16x2); return __builtin_bit_cast(unsigned, b); }

struct NoCopy { static constexpr bool ON = false; __device__ __forceinline__ void step(int) {} };
template <class Epi, class Sched, bool ALIGN_EPI = false, bool SP2 = false, class CS = NoCopy>
__device__ __forceinline__ void gemm_phase(PG8_LAS unsigned char* lds, const Gemm g, const Sched& S, const Epi& E, CS& cs) {
    static_assert(SP2 || !CS::ON, "the copy stream is wired into the SP2 loop only");
    const int tid = fresh_tid(), wid = __builtin_amdgcn_readfirstlane(tid >> 6), lane = tid & 63, wr = wid >> 2, wc = wid & 3, fr = lane & 15, fq = lane >> 4;
    const int K = g.K;
    unsigned voffA[2], voffB[2];
#pragma unroll
    for (int i = 0; i < 2; ++i) { int R, C; stage_rc(tid * 16 + i * 8192, R, C);
        const int Rb = Epi::PERM == 1 ? ((R & ~31) + perm32(R & 31)) : (Epi::PERM == 2 ? ((R & ~63) + swap45(R & 63)) : R);
        voffA[i] = (unsigned)(R * K + C) * 2u; voffB[i] = (unsigned)(Rb * K + C) * 2u; }
    const size_t kstep = (size_t)(BK * 2);
    const size_t hstep = (size_t)HALF * K * 2;
    const size_t tstep = 2 * hstep;
    const unsigned ldsw = (unsigned)wid * 1024u;
    const int aoff = lds_byte(wr * 64 + fr, fq * 8), boff = lds_byte(wc * 32 + fr, fq * 8);
#define PG8_SA(b, h) (((b) * 2 + (h)) * HTB)
#define PG8_SB(b, h) ((4 + (b) * 2 + (h)) * HTB)
#define PG8_STAGE(bufoff, gbase, voff) do { _Pragma("unroll") for (int _i = 0; _i < 2; ++_i) \
        __builtin_amdgcn_global_load_lds((const unsigned*)((const char*)(gbase) + (voff)[_i]), (PG8_LAS unsigned*)(lds + (bufoff) + ldsw + _i * 8192), 16, 0, 0); } while (0)
#define PG8_LDA(dst, b, h) do { _Pragma("unroll") for (int m = 0; m < 4; ++m) _Pragma("unroll") for (int k = 0; k < 2; ++k) dst[m][k] = *(const PG8_LAS bf16x8*)(lds + PG8_SA(b, h) + aoff + m * 2048 + k * 1024); } while (0)
#define PG8_LDB(dst, b, h) do { _Pragma("unroll") for (int n = 0; n < 2; ++n) _Pragma("unroll") for (int k = 0; k < 2; ++k) dst[n][k] = *(const PG8_LAS bf16x8*)(lds + PG8_SB(b, h) + boff + n * 2048 + k * 1024); } while (0)
#define PG8_MMA(ai, bj, At, Bt) do { __builtin_amdgcn_s_setprio(1); _Pragma("unroll") for (int m = 0; m < 4; ++m) _Pragma("unroll") for (int n = 0; n < 2; ++n) _Pragma("unroll") for (int k = 0; k < 2; ++k) \
        acc[ai][bj][m][n] = __builtin_amdgcn_mfma_f32_16x16x32_bf16(Bt[n][k], At[m][k], acc[ai][bj][m][n], 0, 0, 0); __builtin_amdgcn_s_setprio(0); } while (0)
#define PG8_WAIT_V(n) asm volatile("s_waitcnt vmcnt(" #n ")" ::: "memory")
#define PG8_WAIT_L(n) asm volatile("s_waitcnt lgkmcnt(" #n ")" ::: "memory")
#define PG8_WAIT_VC(a) do { if constexpr (!CS::ON) PG8_WAIT_V(8); else if constexpr ((a) == 12) PG8_WAIT_V(12); else if constexpr ((a) == 10) PG8_WAIT_V(10); else PG8_WAIT_V(8); } while (0)
#define PG8_BAR __builtin_amdgcn_s_barrier()
#define PG8_SCHED __builtin_amdgcn_sched_barrier(0)
    Unit cur, nxt; int ui = 0;
    if (!S.next(0, cur)) return;
    f32x4 acc[2][2][4][2];
#pragma unroll
    for (int a = 0; a < 2; ++a)
#pragma unroll
        for (int b = 0; b < 2; ++b)
#pragma unroll
            for (int m = 0; m < 4; ++m)
#pragma unroll
                for (int n = 0; n < 2; ++n) acc[a][b][m][n] = (f32x4){0.f, 0.f, 0.f, 0.f};
    bf16x8 At[4][2], B0[2][2], B1[2][2];
    const char* cA = (const char*)g.A + (size_t)cur.pm * tstep + (size_t)cur.kt0 * kstep; const char* cB = (const char*)g.Bt + (size_t)cur.pn * tstep + (size_t)cur.kt0 * kstep;
    S.a_ready(cur);
    if constexpr (SP2) {
        PG8_STAGE(PG8_SB(0, 0), cB, voffB); PG8_STAGE(PG8_SB(0, 1), cB + hstep, voffB); PG8_STAGE(PG8_SA(0, 0), cA, voffA); PG8_STAGE(PG8_SA(0, 1), cA + hstep, voffA);
        if (wr == 1) PG8_BAR;
        PG8_WAIT_V(2); PG8_BAR;
        PG8_STAGE(PG8_SB(1, 0), cB + kstep, voffB); PG8_STAGE(PG8_SA(1, 0), cA + kstep, voffA); PG8_STAGE(PG8_SB(1, 1), cB + hstep + kstep, voffB);
        PG8_WAIT_V(6); PG8_BAR;
    } else {
        PG8_STAGE(PG8_SB(0, 0), cB, voffB); PG8_STAGE(PG8_SA(0, 0), cA, voffA); PG8_STAGE(PG8_SB(0, 1), cB + hstep, voffB); PG8_STAGE(PG8_SA(0, 1), cA + hstep, voffA);
        if (wr == 1) PG8_BAR;
        PG8_WAIT_V(4); PG8_BAR;
        PG8_STAGE(PG8_SB(1, 0), cB + kstep, voffB); PG8_STAGE(PG8_SA(1, 0), cA + kstep, voffA); PG8_STAGE(PG8_SB(1, 1), cB + hstep + kstep, voffB);
        PG8_WAIT_V(6); PG8_BAR;
    }
    for (;;) {
        const bool has_next = S.next(ui + 1, nxt);
        const char* nA = has_next ? (const char*)g.A + (size_t)nxt.pm * tstep + (size_t)nxt.kt0 * kstep : cA; const char* nB = has_next ? (const char*)g.Bt + (size_t)nxt.pn * tstep + (size_t)nxt.kt0 * kstep : cB;
        const int nt = cur.nt;
        for (int t = 0; t < nt; t += 2) {
            const bool last = (t == nt - 2);
            const char* a1 = cA + (size_t)(t + 1) * kstep;
            const char* a2 = last ? nA : cA + (size_t)(t + 2) * kstep; const char* b2 = last ? nB : cB + (size_t)(t + 2) * kstep;
            const char* a3 = a2 + kstep; const char* b3 = b2 + kstep;
            if (last && has_next) S.a_ready(nxt);
            if constexpr (SP2) {
            cs.step(0); PG8_LDB(B0, 0, 0); PG8_LDB(B1, 0, 1); PG8_SCHED; PG8_LDA(At, 0, 0); PG8_STAGE(PG8_SA(1, 1), a1 + hstep, voffA);
            PG8_WAIT_VC(12); PG8_WAIT_L(0); PG8_BAR; PG8_MMA(0, 0, At, B0); PG8_MMA(0, 1, At, B1); PG8_BAR; PG8_SCHED;
            PG8_LDA(At, 0, 1); PG8_STAGE(PG8_SB(0, 0), b2, voffB); PG8_STAGE(PG8_SB(0, 1), b2 + hstep, voffB); PG8_STAGE(PG8_SA(0, 0), a2, voffA);
            PG8_WAIT_VC(10); PG8_WAIT_L(0); PG8_BAR; PG8_MMA(1, 0, At, B0); PG8_MMA(1, 1, At, B1); PG8_BAR; PG8_SCHED;
            PG8_LDB(B0, 1, 0); PG8_LDB(B1, 1, 1); PG8_SCHED; PG8_LDA(At, 1, 0); PG8_STAGE(PG8_SA(0, 1), a2 + hstep, voffA);
            PG8_WAIT_VC(8); PG8_WAIT_L(0); PG8_BAR; PG8_MMA(0, 0, At, B0); PG8_MMA(0, 1, At, B1); PG8_BAR; PG8_SCHED;
            cs.step(3); PG8_LDA(At, 1, 1); PG8_STAGE(PG8_SB(1, 0), b3, voffB); PG8_STAGE(PG8_SB(1, 1), b3 + hstep, voffB); PG8_STAGE(PG8_SA(1, 0), a3, voffA);
            PG8_WAIT_VC(10); PG8_WAIT_L(0); PG8_BAR; PG8_MMA(1, 0, At, B0); PG8_MMA(1, 1, At, B1); PG8_BAR; PG8_SCHED;
            } else {
            PG8_LDB(B0, 0, 0); PG8_SCHED; PG8_LDA(At, 0, 0); PG8_STAGE(PG8_SA(1, 1), a1 + hstep, voffA);
            PG8_WAIT_L(8); PG8_BAR; PG8_WAIT_L(0); PG8_MMA(0, 0, At, B0); PG8_BAR; PG8_SCHED;
            PG8_LDB(B1, 0, 1); PG8_STAGE(PG8_SB(0, 0), b2, voffB);
            PG8_BAR; PG8_WAIT_L(0); PG8_MMA(0, 1, At, B1); PG8_BAR;
            PG8_LDA(At, 0, 1); PG8_STAGE(PG8_SA(0, 0), a2, voffA);
            PG8_BAR; PG8_WAIT_L(0); PG8_MMA(1, 0, At, B0); PG8_BAR; PG8_SCHED;
            PG8_STAGE(PG8_SB(0, 1), b2 + hstep, voffB);
            PG8_WAIT_V(6); PG8_BAR; PG8_MMA(1, 1, At, B1); PG8_BAR;
            PG8_LDB(B0, 1, 0); PG8_SCHED; PG8_LDA(At, 1, 0); PG8_STAGE(PG8_SA(0, 1), a2 + hstep, voffA);
            PG8_WAIT_L(8); PG8_BAR; PG8_WAIT_L(0); PG8_MMA(0, 0, At, B0); PG8_BAR; PG8_SCHED;
            PG8_LDB(B1, 1, 1); PG8_STAGE(PG8_SB(1, 0), b3, voffB);
            PG8_BAR; PG8_WAIT_L(0); PG8_MMA(0, 1, At, B1); PG8_BAR;
            PG8_LDA(At, 1, 1); PG8_STAGE(PG8_SA(1, 0), a3, voffA);
            PG8_BAR; PG8_WAIT_L(0); PG8_MMA(1, 0, At, B0); PG8_BAR; PG8_SCHED;
            PG8_STAGE(PG8_SB(1, 1), b3 + hstep, voffB);
            PG8_WAIT_V(6); PG8_BAR; PG8_MMA(1, 1, At, B1); PG8_BAR;
            }
        }
        if constexpr (ALIGN_EPI) { if (wr == 0) PG8_BAR; }
        E(acc, cur, wr, wc, fr, fq);
        if (!has_next) break;
#pragma unroll
        for (int a = 0; a < 2; ++a)
#pragma unroll
            for (int b = 0; b < 2; ++b)
#pragma unroll
                for (int m = 0; m < 4; ++m)
#pragma unroll
                    for (int n = 0; n < 2; ++n) acc[a][b][m][n] = (f32x4){0.f, 0.f, 0.f, 0.f};
        cur = nxt; cA = nA; cB = nB; ++ui;
        if constexpr (ALIGN_EPI) { if (wr == 1) PG8_BAR; }
    }
    PG8_WAIT_V(0);
    if constexpr (!ALIGN_EPI) { if (wr == 0) PG8_BAR; }
    PG8_BAR;
#undef PG8_SA
#undef PG8_SB
#undef PG8_STAGE
#undef PG8_LDA
#undef PG8_LDB
#undef PG8_MMA
#undef PG8_WAIT_V
#undef PG8_WAIT_L
#undef PG8_WAIT_VC
#undef PG8_BAR
#undef PG8_SCHED
}
template <class Epi, class Sched, bool ALIGN_EPI = false, bool SP2 = false>
__device__ __forceinline__ void gemm_phase(PG8_LAS unsigned char* lds, const Gemm g, const Sched& S, const Epi& E) { NoCopy nc; gemm_phase<Epi, Sched, ALIGN_EPI, SP2, NoCopy>(lds, g, S, E, nc); }
}

using pg8::bf16_t; using pg8::f32x4; using pg8::u32x4; using pg8::u32x2; using pg8::bf16x8; using pg8::cvt_pk_bf16;
#define LAS __attribute__((address_space(3)))
typedef short bf16x4 __attribute__((ext_vector_type(4)));
typedef float f32x2 __attribute__((ext_vector_type(2)));
constexpr int D = 1024, SEQ = 4096, MP = 16384, MS = 1024, M = MP + MS, NIN = 5888, DC = 512, FF = 4096;
constexpr int NT = 512;
constexpr float ALPHA = 1.189207115002721f;
constexpr float LN_EPS = 1e-5f;
constexpr int LDS_BYTES = pg8::STAGE_BYTES + 16;

constexpr size_t WS_XB = 0;
constexpr size_t WS_WIN = WS_XB + (size_t)M * D * 2;
constexpr size_t WS_WC = WS_WIN + (size_t)NIN * D * 2;
constexpr size_t WS_WA = WS_WC + (size_t)1024 * 512 * 2;
constexpr size_t WS_WO = WS_WA + (size_t)1024 * 256 * 2;
constexpr size_t WS_WUP = WS_WO + (size_t)1024 * 1024 * 2;
constexpr size_t WS_WDN = WS_WUP + (size_t)4096 * 1024 * 2;
constexpr size_t WS_ROPE = WS_WDN + (size_t)4096 * 1024 * 2;
constexpr size_t WS_ZC = WS_ROPE + (size_t)4096 * 32 * 8;
constexpr size_t WS_QKV = WS_ZC + (size_t)M * 1536 * 2;
constexpr size_t WS_GATE = WS_QKV + (size_t)9 * M * 256 * 2;
constexpr size_t WS_OG = WS_GATE + (size_t)M * 2048 * 2;
constexpr size_t WS_LSE = WS_OG + (size_t)3 * M * 256 * 2;
constexpr size_t WS_YC = WS_LSE + (size_t)3 * M * 4 * 4;
constexpr size_t WS_YA = WS_YC + (size_t)M * 512 * 2;
constexpr size_t WS_MIX = WS_YA + (size_t)M * 256 * 2;
constexpr size_t WS_PRE = WS_MIX + (size_t)M * 1024 * 2;
constexpr size_t WS_X1F = WS_PRE + (size_t)M * 1024 * 4;
constexpr size_t WS_PART = WS_X1F;
constexpr size_t WS_X1B = WS_X1F + (size_t)M * 1024 * 4;
constexpr size_t WS_HID = WS_X1B + (size_t)M * 1024 * 2;
constexpr size_t WS_BAR = WS_HID + (size_t)M * 4096 * 2;
constexpr size_t WS_OGS = WS_BAR + 16384;
constexpr size_t WS_LSES = WS_OGS + (size_t)6 * MS * 256 * 2;
constexpr size_t WS_DUMP = WS_LSES + (size_t)6 * MS * 4 * 4;
constexpr size_t WS_END = WS_DUMP + (size_t)1024 * 8192;

constexpr size_t O_YP = 0;
constexpr size_t O_YS = O_YP + (size_t)MP * D;
constexpr size_t O_CP = O_YS + (size_t)MS * D;
constexpr size_t O_KVP0 = O_CP + 4 * 2 * 512;
constexpr size_t O_KVP1 = O_KVP0 + (size_t)4 * 128 * 512;
constexpr size_t O_KVP2 = O_KVP1 + (size_t)4 * 512 * 512;
constexpr size_t O_CS = O_KVP2 + (size_t)4 * 2048 * 512;
constexpr size_t O_KVS0 = O_CS + (size_t)128 * 2 * 512;
constexpr size_t O_KVS1 = O_KVS0 + (size_t)128 * 128 * 512;
constexpr size_t O_KVS2 = O_KVS1 + (size_t)128 * 512 * 512;
constexpr size_t O_END = O_KVS2 + (size_t)128 * 2048 * 512;

struct Params { const float* in[18]; float* out; unsigned char* ws; int ph_lo, ph_hi; };

__device__ __forceinline__ float bflo(unsigned w) { return __builtin_bit_cast(float, w << 16); }
__device__ __forceinline__ float bfhi(unsigned w) { return __builtin_bit_cast(float, w & 0xffff0000u); }
__device__ __forceinline__ float bf1(bf16_t h) { return __builtin_bit_cast(float, (unsigned)h << 16); }
__device__ __forceinline__ float wave_sum(float v) {
#pragma unroll
    for (int o = 1; o < 64; o <<= 1) v += __shfl_xor(v, o);
    return v;
}
__device__ __forceinline__ float wave_max(float v) {
#pragma unroll
    for (int o = 1; o < 64; o <<= 1) v = fmaxf(v, __shfl_xor(v, o));
    return v;
}

using pg8::Unit;
struct Epi1 {
    static constexpr int PERM = 2;
    bf16_t* zc; bf16_t* qkv; bf16_t* gates; const float* bgate; const float* rope; float* out;
    __device__ __forceinline__ void operator()(const f32x4 (&acc)[2][2][4][2], const Unit& u, int wr, int wc, int fr, int fq) const {
        const int row0 = u.pm * 256 + wr * 64 + fr;
        const int cw0 = 64 * (wc >> 1) + 16 * (wc & 1) + 4 * fq;
        if (u.pn < 6) {
#pragma unroll
            for (int ai = 0; ai < 2; ++ai)
#pragma unroll
                for (int m = 0; m < 4; ++m) { bf16_t* rp = zc + (size_t)(row0 + ai * 128 + m * 16) * 1536 + u.pn * 256 + cw0;
#pragma unroll
                    for (int bj = 0; bj < 2; ++bj)
#pragma unroll
                        for (int n = 0; n < 2; ++n) { const f32x4 v = acc[ai][bj][m][n]; u32x2 w; w.x = cvt_pk_bf16(v[0], v[1]); w.y = cvt_pk_bf16(v[2], v[3]); *(u32x2*)(rp + bj * 128 + n * 32) = w; } }
        } else if (u.pn < 15) {
            const int t = u.pn - 6, gi = t / 3, kind = t - 3 * gi;
            bf16_t* dst = qkv + (size_t)(gi * 3 + kind) * M * 256;
            const int Wk = 128 << (2 * gi);
            float* okp = out + (gi == 0 ? O_KVP0 : (gi == 1 ? O_KVP1 : O_KVP2));
            float* oks = out + (gi == 0 ? O_KVS0 : (gi == 1 ? O_KVS1 : O_KVS2));
            const int e0 = 16 * (wc & 1) + 4 * fq;
#pragma unroll
            for (int ai = 0; ai < 2; ++ai)
#pragma unroll
                for (int m = 0; m < 4; ++m) {
                    const int row = row0 + ai * 128 + m * 16;
                    int pos; float* kvb = nullptr;
                    if (row < MP) { const int nb = row >> 12, p = row & 4095; pos = p; const int pk = p - (SEQ - Wk); if (pk >= 0) kvb = okp + ((size_t)(nb * Wk + pk) * 2) * 256; }
                    else { const int rs = row - MP, nb = rs >> 3, tt = rs & 7; pos = 2048 + tt; kvb = oks + ((size_t)(nb * Wk + Wk - 8 + tt) * 2) * 256; }
                    f32x4 cs0 = {1.f, 0.f, 1.f, 0.f}, cs1 = {1.f, 0.f, 1.f, 0.f};
                    if (kind < 2) { const f32x4* rp = (const f32x4*)(rope + ((size_t)pos * 32 + e0) * 2); cs0 = rp[0]; cs1 = rp[1]; }
#pragma unroll
                    for (int bj = 0; bj < 2; ++bj) {
                        f32x4 x1 = acc[ai][bj][m][0], x2 = acc[ai][bj][m][1];
                        if (kind < 2) {
                            const f32x4 c = {cs0[0], cs0[2], cs1[0], cs1[2]}, s = {cs0[1], cs0[3], cs1[1], cs1[3]};
                            const f32x4 o1 = x1 * c - x2 * s, o2 = x2 * c + x1 * s; x1 = o1; x2 = o2;
                            if (kind == 0) { x1 = x1 * 0.125f; x2 = x2 * 0.125f; }
                        }
                        const int hc = (2 * bj + (wc >> 1)) * 64 + e0;
                        u32x2 w1, w2; w1.x = cvt_pk_bf16(x1[0], x1[1]); w1.y = cvt_pk_bf16(x1[2], x1[3]); w2.x = cvt_pk_bf16(x2[0], x2[1]); w2.y = cvt_pk_bf16(x2[2], x2[3]);
                        *(u32x2*)(dst + (size_t)row * 256 + hc) = w1; *(u32x2*)(dst + (size_t)row * 256 + hc + 32) = w2;
                        if (kind >= 1 && kvb) { float* kp = kvb + (kind - 1) * 256 + hc; *(f32x4*)kp = x1; *(f32x4*)(kp + 32) = x2; }
                    }
                    asm volatile("" ::: "memory");
                }
        } else {
            const int cg0 = (u.pn - 15) * 256 + cw0;
#pragma unroll
            for (int bj = 0; bj < 2; ++bj)
#pragma unroll
                for (int n = 0; n < 2; ++n) { const f32x4 bv = *(const f32x4*)(bgate + cg0 + bj * 128 + n * 32);
#pragma unroll
                    for (int ai = 0; ai < 2; ++ai)
#pragma unroll
                        for (int m = 0; m < 4; ++m) { const f32x4 v = acc[ai][bj][m][n] + bv; f32x4 s;
#pragma unroll
                            for (int j = 0; j < 4; ++j) s[j] = __builtin_amdgcn_rcpf(1.0f + __expf(-v[j]));
                            u32x2 w; w.x = cvt_pk_bf16(s[0], s[1]); w.y = cvt_pk_bf16(s[2], s[3]);
                            *(u32x2*)(gates + (size_t)(row0 + ai * 128 + m * 16) * 2048 + cg0 + bj * 128 + n * 32) = w; } }
        }
    }
};
struct Epi3 {
    static constexpr int PERM = 1;
    bf16_t* mix; const bf16_t* gates; int second;
    __device__ __forceinline__ void operator()(const f32x4 (&acc)[2][2][4][2], const Unit& u, int wr, int wc, int fr, int fq) const {
        const int row0 = u.pm * 256 + wr * 64 + fr, col0 = u.pn * 256 + wc * 32 + 8 * fq;
#pragma unroll
        for (int ai = 0; ai < 2; ++ai)
#pragma unroll
            for (int m = 0; m < 4; ++m) { const int row = row0 + ai * 128 + m * 16;
#pragma unroll
                for (int bj = 0; bj < 2; ++bj) { const int c = col0 + bj * 128;
                    const u32x4 g = *(const u32x4*)(gates + (size_t)row * 2048 + second * 1024 + c);
                    f32x4 v0 = acc[ai][bj][m][0], v1 = acc[ai][bj][m][1];
                    v0 = v0 * (f32x4){bflo(g.x), bfhi(g.x), bflo(g.y), bfhi(g.y)}; v1 = v1 * (f32x4){bflo(g.z), bfhi(g.z), bflo(g.w), bfhi(g.w)};
                    bf16_t* mp = mix + (size_t)row * 1024 + c;
                    if (second) { const u32x4 o = *(const u32x4*)mp; v0 = v0 + (f32x4){bflo(o.x), bfhi(o.x), bflo(o.y), bfhi(o.y)}; v1 = v1 + (f32x4){bflo(o.z), bfhi(o.z), bflo(o.w), bfhi(o.w)}; }
                    u32x4 w; w.x = cvt_pk_bf16(v0[0], v0[1]); w.y = cvt_pk_bf16(v0[2], v0[3]); w.z = cvt_pk_bf16(v1[0], v1[1]); w.w = cvt_pk_bf16(v1[2], v1[3]);
                    *(u32x4*)mp = w; }
                asm volatile("" ::: "memory"); }
    }
};
template <bool BF16RES>
struct EpiRes {
    static constexpr int PERM = 0;
    const void* res; float* pre; float* part;
    __device__ __forceinline__ void operator()(const f32x4 (&acc)[2][2][4][2], const Unit& u, int wr, int wc, int fr, int fq) const {
        const int row0 = u.pm * 256 + wr * 64 + fr, col0 = u.pn * 256 + wc * 32 + 4 * fq;
        if (u.pm >= 64) {
            float* pb = part + ((size_t)(u.kt0 / u.nt) * MS + (row0 - MP)) * 1024 + col0;
#pragma unroll
            for (int ai = 0; ai < 2; ++ai)
#pragma unroll
                for (int m = 0; m < 4; ++m)
#pragma unroll
                    for (int bj = 0; bj < 2; ++bj)
#pragma unroll
                        for (int n = 0; n < 2; ++n) *(f32x4*)(pb + (size_t)(ai * 128 + m * 16) * 1024 + bj * 128 + n * 16) = acc[ai][bj][m][n];
            return;
        }
#pragma unroll
        for (int ai = 0; ai < 2; ++ai)
#pragma unroll
            for (int m = 0; m < 4; ++m) { const size_t off = (size_t)(row0 + ai * 128 + m * 16) * 1024 + col0;
#pragma unroll
                for (int bj = 0; bj < 2; ++bj)
#pragma unroll
                    for (int n = 0; n < 2; ++n) { f32x4 r;
                        if (BF16RES) { const u32x2 rr = *(const u32x2*)((const bf16_t*)res + off + bj * 128 + n * 16); r = (f32x4){bflo(rr.x), bfhi(rr.x), bflo(rr.y), bfhi(rr.y)}; }
                        else r = *(const f32x4*)((const float*)res + off + bj * 128 + n * 16);
                        *(f32x4*)(pre + off + bj * 128 + n * 16) = r * ALPHA + acc[ai][bj][m][n]; }
                asm volatile("" ::: "memory"); }
    }
};
struct EpiHid {
    static constexpr int PERM = 1;
    bf16_t* hid;
    __device__ __forceinline__ void operator()(const f32x4 (&acc)[2][2][4][2], const Unit& u, int wr, int wc, int fr, int fq) const {
        const int row0 = u.pm * 256 + wr * 64 + fr, col0 = u.pn * 256 + wc * 32 + 8 * fq;
#pragma unroll
        for (int ai = 0; ai < 2; ++ai)
#pragma unroll
            for (int m = 0; m < 4; ++m) { bf16_t* rp = hid + (size_t)(row0 + ai * 128 + m * 16) * FF + col0;
#pragma unroll
                for (int bj = 0; bj < 2; ++bj) { f32x4 v0 = acc[ai][bj][m][0], v1 = acc[ai][bj][m][1];
#pragma unroll
                    for (int j = 0; j < 4; ++j) { const float a = fmaxf(v0[j], 0.f), b = fmaxf(v1[j], 0.f); v0[j] = a * a; v1[j] = b * b; }
                    u32x4 w; w.x = cvt_pk_bf16(v0[0], v0[1]); w.y = cvt_pk_bf16(v0[2], v0[3]); w.z = cvt_pk_bf16(v1[0], v1[1]); w.w = cvt_pk_bf16(v1[2], v1[3]);
                    *(u32x4*)(rp + bj * 128) = w; } }
    }
};


struct P1Order {
    int base, stride, limit, c;
    __device__ bool next(int i, pg8::Unit& u) const {
        u.kt0 = 0; u.nt = D / pg8::BK;
        if (c >= stride) return false;
        const int L = base + i * stride + c; if (L >= limit) return false;
        if (L < 92) { u.pm = 64 + L / 23; u.pn = L % 23; return true; }
        constexpr int nM = 64, nN = 23, nwg = nM * nN;
        int wgid = L - 92; { const int q = nwg / pg8::NXCD, r = nwg % pg8::NXCD, xcd = wgid % pg8::NXCD, off = wgid / pg8::NXCD; wgid = (xcd < r ? xcd * (q + 1) : r * (q + 1) + (xcd - r) * q) + off; }
        const int nig = pg8::WGM * nN, gid = wgid / nig, fm = gid * pg8::WGM, gsz = (nM - fm) < pg8::WGM ? (nM - fm) : pg8::WGM;
        u.pm = fm + ((wgid % nig) % gsz); u.pn = (wgid % nig) / gsz; return true;
    }
    __device__ __forceinline__ void a_ready(const pg8::Unit&) const {}
    __device__ __forceinline__ void done(const pg8::Unit&) const {}
};

struct SplitOrder {
    int NSL, ntk, G, c;
    __device__ __forceinline__ bool next(int i, pg8::Unit& u) const {
        const int nsub = 16 * NSL, L = i * G + c; const bool ok = (i <= 1) && (L < nsub + 256);
        const int idx = L / NSL, kz = L - idx * NSL, snt = ntk / NSL;
        constexpr int nM = 64, nN = 4, nwg = nM * nN;
        int wgid = L - nsub; wgid = wgid < 0 ? 0 : wgid;
        { const int q = nwg / pg8::NXCD, xcd = wgid % pg8::NXCD, off = wgid / pg8::NXCD; wgid = xcd * q + off; }
        const int nig = pg8::WGM * nN, gid = wgid / nig, fm = gid * pg8::WGM;
        const int ppm = fm + ((wgid % nig) % pg8::WGM), ppn = (wgid % nig) / pg8::WGM;
        const bool sub = L < nsub;
        pg8::Unit r; r.pm = sub ? 64 + (idx >> 2) : ppm; r.pn = sub ? (idx & 3) : ppn; r.kt0 = sub ? kz * snt : 0; r.nt = sub ? snt : ntk;
        u = r; return ok;
    }
    __device__ __forceinline__ void a_ready(const pg8::Unit&) const {}
    __device__ __forceinline__ void done(const pg8::Unit&) const {}
};
__device__ __forceinline__ void transpose_item(const float* W, int K, int N, bf16_t* WT, LAS float* scr, int item, int lane) {
    const int nblk = N / 32, kb = item / nblk, nb = item % nblk, k0 = 64 * kb, n0 = 32 * nb;
#pragma unroll 8
    for (int i = 0; i < 32; ++i) { const int kk = 2 * i + (lane >> 5); scr[kk * 33 + (lane & 31)] = W[(size_t)(k0 + kk) * N + n0 + (lane & 31)]; }
    asm volatile("s_waitcnt lgkmcnt(0)" ::: "memory");
    const int c = lane & 7;
#pragma unroll
    for (int j = 0; j < 4; ++j) { const int n = (lane >> 3) + 8 * j; const LAS float* s = scr + (8 * c) * 33 + n;
        u32x4 o; o.x = cvt_pk_bf16(s[0 * 33], s[1 * 33]); o.y = cvt_pk_bf16(s[2 * 33], s[3 * 33]); o.z = cvt_pk_bf16(s[4 * 33], s[5 * 33]); o.w = cvt_pk_bf16(s[6 * 33], s[7 * 33]);
        *(u32x4*)(WT + (size_t)(n0 + n) * K + k0 + 8 * c) = o; }
    asm volatile("s_waitcnt lgkmcnt(0)" ::: "memory");
}

__device__ __forceinline__ void phase_prep(const Params& p, LAS unsigned char* lds) {
    const int tid = fresh_tid(), lane = tid & 63, wave = tid >> 6;
    const size_t gt = (size_t)blockIdx.x * NT + tid, GT = (size_t)gridDim.x * NT;
    unsigned char* ws = p.ws;
    { bf16_t* xb = (bf16_t*)(ws + WS_XB); constexpr size_t NCH = (size_t)M * D / 8, NP = (size_t)MP * D / 8;
      for (size_t i0 = gt; i0 < NCH; i0 += 4 * GT) {
          f32x4 a[4], b[4];
#pragma unroll
          for (int k = 0; k < 4; ++k) { const size_t i = i0 + k * GT; if (i < NCH) { const float* src = (i < NP) ? p.in[0] + i * 8 : p.in[1] + (i - NP) * 8; a[k] = ((const f32x4*)src)[0]; b[k] = ((const f32x4*)src)[1]; } }
#pragma unroll
          for (int k = 0; k < 4; ++k) { const size_t i = i0 + k * GT; if (i < NCH) { u32x4 o; o.x = cvt_pk_bf16(a[k][0], a[k][1]); o.y = cvt_pk_bf16(a[k][2], a[k][3]); o.z = cvt_pk_bf16(b[k][0], b[k][1]); o.w = cvt_pk_bf16(b[k][2], b[k][3]);
              *(u32x4*)(xb + i * 8) = o; } } } }
    { float* rt = (float*)(ws + WS_ROPE);
      for (size_t i = gt; i < (size_t)4096 * 32; i += GT) { const int pos = (int)(i >> 5), f = (int)(i & 31);
          const float inv = 1.0f / exp2f((float)f * (13.287712379549449f / 32.0f));
          const float ang = (float)pos * inv;
          const double rev = (double)ang * 0.15915494309189535; const float fr = (float)(rev - floor(rev));
          rt[2 * i] = __builtin_amdgcn_cosf(fr); rt[2 * i + 1] = __builtin_amdgcn_sinf(fr); } }
    { LAS float* scr = (LAS float*)(lds + wave * 16384);
      const int gw = blockIdx.x * 8 + wave, NGW = gridDim.x * 8;
      constexpr int I_IN = (D / 64) * (NIN / 32), I_C = (DC / 64) * (D / 32), I_A = (256 / 64) * (D / 32), I_O = (D / 64) * (D / 32), I_UP = (D / 64) * (FF / 32), I_DN = (FF / 64) * (D / 32);
      constexpr int NITEMS = I_IN + I_C + I_A + I_O + I_UP + I_DN;
      for (int it = gw; it < NITEMS; it += NGW) { int r = it;
          if (r < I_IN) { transpose_item(p.in[6], D, NIN, (bf16_t*)(ws + WS_WIN), scr, r, lane); continue; } r -= I_IN;
          if (r < I_C) { transpose_item(p.in[9], DC, D, (bf16_t*)(ws + WS_WC), scr, r, lane); continue; } r -= I_C;
          if (r < I_A) { transpose_item(p.in[10], 256, D, (bf16_t*)(ws + WS_WA), scr, r, lane); continue; } r -= I_A;
          if (r < I_O) { transpose_item(p.in[11], D, D, (bf16_t*)(ws + WS_WO), scr, r, lane); continue; } r -= I_O;
          if (r < I_UP) { transpose_item(p.in[14], D, FF, (bf16_t*)(ws + WS_WUP), scr, r, lane); continue; } r -= I_UP;
          transpose_item(p.in[15], FF, D, (bf16_t*)(ws + WS_WDN), scr, r, lane); } }
}

constexpr int KS_STRIDE = 144;
constexpr int VT_STRIDE = 528;
constexpr int KS_OFF = 0, VT_OFF = 256 * KS_STRIDE;
__device__ __forceinline__ void attn_prompt_item(const Params& p, LAS unsigned char* lds, int item) {
    const int tid = fresh_tid(), lane = tid & 63, w = tid >> 6, fr = lane & 15, s = lane >> 4;
    const int g = item >> 9, rem = item & 511, nb = rem >> 7, rem2 = rem & 127, h = rem2 >> 5, rb = rem2 & 31;
    const int dsh = 2 * g, d = 1 << dsh, nbk = 32 >> dsh, r = rb / nbk, b = rb - r * nbk;
    const bf16_t* qb = (const bf16_t*)(p.ws + WS_QKV) + (size_t)(3 * g) * M * 256;
    const bf16_t* kb = qb + (size_t)M * 256; const bf16_t* vb = kb + (size_t)M * 256;
    const size_t rowbase = (size_t)nb * SEQ + r;
    const int i0 = 128 * (b - 1);
#pragma unroll
    for (int ii = 0; ii < 4; ++ii) { const int c = tid + NT * ii, kl = c >> 3, ch = c & 7; int ik = i0 + kl; ik = ik < 0 ? 0 : ik;
        const u32x4 v = *(const u32x4*)(kb + (rowbase + (size_t)ik * d) * 256 + h * 64 + ch * 8);
        *(LAS u32x4*)(lds + KS_OFF + kl * KS_STRIDE + ch * 16) = v; }
#pragma unroll
    for (int ii = 0; ii < 4; ++ii) { const int c = tid + NT * ii, kl = c & 255, ch = c >> 8; int ik = i0 + kl; ik = ik < 0 ? 0 : ik;
        const u32x4 v = *(const u32x4*)(vb + (rowbase + (size_t)ik * d) * 256 + h * 64 + ch * 8);
        LAS bf16_t* vt = (LAS bf16_t*)(lds + VT_OFF + (ch * 8) * VT_STRIDE) + kl;
        vt[0 * (VT_STRIDE / 2)] = (bf16_t)(v.x & 0xffff); vt[1 * (VT_STRIDE / 2)] = (bf16_t)(v.x >> 16);
        vt[2 * (VT_STRIDE / 2)] = (bf16_t)(v.y & 0xffff); vt[3 * (VT_STRIDE / 2)] = (bf16_t)(v.y >> 16);
        vt[4 * (VT_STRIDE / 2)] = (bf16_t)(v.z & 0xffff); vt[5 * (VT_STRIDE / 2)] = (bf16_t)(v.z >> 16);
        vt[6 * (VT_STRIDE / 2)] = (bf16_t)(v.w & 0xffff); vt[7 * (VT_STRIDE / 2)] = (bf16_t)(v.w >> 16); }
    const int iq = 128 * b + 16 * w + fr; const size_t qrow = rowbase + (size_t)iq * d;
    const bf16x8 q0 = *(const bf16x8*)(qb + qrow * 256 + h * 64 + 8 * s), q1 = *(const bf16x8*)(qb + qrow * 256 + h * 64 + 32 + 8 * s);
    __syncthreads();
    f32x4 sc[9];
#pragma unroll
    for (int j = 0; j < 9; ++j) {
        const LAS unsigned char* kp = lds + KS_OFF + (16 * (w + j) + fr) * KS_STRIDE + s * 16;
        const bf16x8 k0 = *(const LAS bf16x8*)kp, k1 = *(const LAS bf16x8*)(kp + 64);
        f32x4 a = {0.f, 0.f, 0.f, 0.f};
        a = __builtin_amdgcn_mfma_f32_16x16x32_bf16(k0, q0, a, 0, 0, 0);
        a = __builtin_amdgcn_mfma_f32_16x16x32_bf16(k1, q1, a, 0, 0, 0);
        sc[j] = a;
    }
    float mx = -INFINITY;
#pragma unroll
    for (int j = 0; j < 9; ++j)
#pragma unroll
        for (int i = 0; i < 4; ++i) { const int dist = 128 - 16 * j + fr - 4 * s - i; const int kl = 16 * (w + j) + 4 * s + i;
            const bool ok = (dist >= 0) && (dist <= 128) && (b > 0 || kl >= 128);
            sc[j][i] = ok ? sc[j][i] : -INFINITY; mx = fmaxf(mx, sc[j][i]); }
    mx = fmaxf(mx, __shfl_xor(mx, 16)); mx = fmaxf(mx, __shfl_xor(mx, 32));
    float sum = 0.f;
#pragma unroll
    for (int j = 0; j < 9; ++j)
#pragma unroll
        for (int i = 0; i < 4; ++i) { const float e = __expf(sc[j][i] - mx); sc[j][i] = e; sum += e; }
    sum += __shfl_xor(sum, 16); sum += __shfl_xor(sum, 32);
    f32x4 o[4];
#pragma unroll
    for (int dt = 0; dt < 4; ++dt) o[dt] = (f32x4){0.f, 0.f, 0.f, 0.f};
#pragma unroll
    for (int j = 0; j < 9; ++j) {
        u32x2 pw; pw.x = cvt_pk_bf16(sc[j][0], sc[j][1]); pw.y = cvt_pk_bf16(sc[j][2], sc[j][3]);
        const bf16x4 pf = __builtin_bit_cast(bf16x4, pw);
#pragma unroll
        for (int dt = 0; dt < 4; ++dt) {
            const bf16x4 vf = *(const LAS bf16x4*)(lds + VT_OFF + (16 * dt + fr) * VT_STRIDE + (16 * (w + j) + 4 * s) * 2);
            o[dt] = __builtin_amdgcn_mfma_f32_16x16x16bf16_1k(vf, pf, o[dt], 0, 0, 0);
        }
    }
    const float inv = 1.0f / sum;
    bf16_t* og = (bf16_t*)(p.ws + WS_OG) + (size_t)g * M * 256 + qrow * 256 + h * 64;
#pragma unroll
    for (int dt = 0; dt < 4; ++dt) { u32x2 ww; ww.x = cvt_pk_bf16(o[dt][0] * inv, o[dt][1] * inv); ww.y = cvt_pk_bf16(o[dt][2] * inv, o[dt][3] * inv); *(u32x2*)(og + 16 * dt + 4 * s) = ww; }
    if (s == 0) ((float*)(p.ws + WS_LSE))[((size_t)g * M + qrow) * 4 + h] = mx + __logf(sum);
    __syncthreads();
}

__device__ __forceinline__ void attn_sample_unit(const Params& p, LAS unsigned char* lds, int unit) {
    const int tid = fresh_tid(), lane = tid & 63, w = tid >> 6, ks = lane >> 4, dq = lane & 15;
    LAS float* ps = (LAS float*)(lds + w * 1024);
    const int it_ = unit >> 3, h = w & 3, t = 2 * (it_ & 3) + (w >> 2), g = (it_ >> 2) % 3, n = it_ / 12;
    const int dsh = 2 * g, d = 1 << dsh, W = 128 << dsh;
    const int nnew = (t >> dsh) + 1, ncache = 129 - nnew, idx0 = W + t - nnew * d;
    const size_t row = (size_t)MP + n * 8 + t;
    const bf16_t* qb = (const bf16_t*)(p.ws + WS_QKV) + (size_t)(3 * g) * M * 256 + h * 64 + 4 * dq;
    const bf16_t* kb = qb + (size_t)M * 256; const bf16_t* vb = kb + (size_t)M * 256;
    const float* cache = p.in[3 + g] + (size_t)n * W * 512 + h * 64 + 4 * dq;
    const u32x2 qq = *(const u32x2*)(qb + row * 256);
    const f32x4 qv = {bflo(qq.x), bfhi(qq.x), bflo(qq.y), bfhi(qq.y)};
    const size_t step = (size_t)4 * d * 512;
    { const float* kp = cache + (size_t)(idx0 - ks * d) * 512;
#pragma unroll 8
      for (int jj = 0; jj < 32; ++jj) {
          const f32x4 k = *(const f32x4*)kp; kp -= step;
          float a = (k[0] * qv[0] + k[1] * qv[1]) + (k[2] * qv[2] + k[3] * qv[3]);
          a += __shfl_xor(a, 1); a += __shfl_xor(a, 2); a += __shfl_xor(a, 4); a += __shfl_xor(a, 8);
          if (dq == 0) ps[4 * jj + ks] = (4 * jj + ks < ncache) ? a : -INFINITY;
      } }
#pragma unroll
    for (int i = 0; i < 2; ++i) { const int l = ks + 4 * i, lc = l < nnew ? l : 0;
        const u32x2 kk = *(const u32x2*)(kb + ((size_t)MP + n * 8 + (t - lc * d)) * 256);
        float a = (bflo(kk.x) * qv[0] + bfhi(kk.x) * qv[1]) + (bflo(kk.y) * qv[2] + bfhi(kk.y) * qv[3]);
        a += __shfl_xor(a, 1); a += __shfl_xor(a, 2); a += __shfl_xor(a, 4); a += __shfl_xor(a, 8);
        if (dq == 0) ps[128 + l] = (l < nnew) ? a : -INFINITY; }
    asm volatile("s_waitcnt lgkmcnt(0)" ::: "memory");
    const float s0 = ps[lane], s1 = ps[lane + 64], s2 = lane < 8 ? ps[128 + lane] : -INFINITY;
    const float mx = wave_max(fmaxf(fmaxf(s0, s1), s2));
    const float e0 = __expf(s0 - mx), e1 = __expf(s1 - mx), e2 = __expf(s2 - mx);
    asm volatile("s_waitcnt lgkmcnt(0)" ::: "memory");
    ps[lane] = e0; ps[lane + 64] = e1; if (lane < 8) ps[128 + lane] = e2;
    const float sum = wave_sum(e0 + e1 + e2);
    asm volatile("s_waitcnt lgkmcnt(0)" ::: "memory");
    f32x4 o = {0.f, 0.f, 0.f, 0.f};
    { const float* vp = cache + 256 + (size_t)(idx0 - ks * d) * 512;
#pragma unroll 8
      for (int jj = 0; jj < 32; ++jj) { const f32x4 v = *(const f32x4*)vp; vp -= step; o = o + v * ps[4 * jj + ks]; } }
#pragma unroll
    for (int i = 0; i < 2; ++i) { const int l = ks + 4 * i, lc = l < nnew ? l : 0;
        const u32x2 vv = *(const u32x2*)(vb + ((size_t)MP + n * 8 + (t - lc * d)) * 256);
        o = o + (f32x4){bflo(vv.x), bfhi(vv.x), bflo(vv.y), bfhi(vv.y)} * ps[128 + l]; }
#pragma unroll
    for (int i = 0; i < 4; ++i) { o[i] += __shfl_xor(o[i], 16); o[i] += __shfl_xor(o[i], 32); }
    const float inv = 1.0f / sum;
    if (ks == 0) { u32x2 ww; ww.x = cvt_pk_bf16(o[0] * inv, o[1] * inv); ww.y = cvt_pk_bf16(o[2] * inv, o[3] * inv);
        *(u32x2*)((bf16_t*)(p.ws + WS_OG) + (size_t)g * M * 256 + row * 256 + h * 64 + 4 * dq) = ww; }
    if (lane == 0) ((float*)(p.ws + WS_LSE))[((size_t)g * M + row) * 4 + h] = mx + __logf(sum);
    asm volatile("s_waitcnt lgkmcnt(0)" ::: "memory");
}

__device__ __forceinline__ float dpp_add16(float a) {
    a += __builtin_bit_cast(float, __builtin_amdgcn_update_dpp(0, __builtin_bit_cast(int, a), 0xB1, 0xF, 0xF, false));
    a += __builtin_bit_cast(float, __builtin_amdgcn_update_dpp(0, __builtin_bit_cast(int, a), 0x4E, 0xF, 0xF, false));
    a += __builtin_bit_cast(float, __builtin_amdgcn_update_dpp(0, __builtin_bit_cast(int, a), 0x141, 0xF, 0xF, false));
    a += __builtin_bit_cast(float, __builtin_amdgcn_update_dpp(0, __builtin_bit_cast(int, a), 0x140, 0xF, 0xF, false));
    return a;
}
struct SoftAcc { float m, l; f32x4 o; };
#ifndef SAC_COPY2
#define SAC_COPY2 0
#endif
#ifndef SAC_NS
#define SAC_NS 2
#endif
template <int R>
__device__ __forceinline__ void soft_update(SoftAcc& A, const float (&sc)[R], const f32x4 (&v)[R]) {
    float mn = A.m;
#pragma unroll
    for (int i = 0; i < R; ++i) mn = fmaxf(mn, sc[i]);
    const float corr = __expf(A.m - mn);
    float ps = 0.f; f32x4 po = {0.f, 0.f, 0.f, 0.f};
#pragma unroll
    for (int i = 0; i < R; ++i) { const float pi = __expf(sc[i] - mn); ps += pi; po = po + v[i] * pi; }
    A.l = A.l * corr + ps; A.o = A.o * corr + po; A.m = mn;
}
template <int GI>
__device__ __forceinline__ void sac_unit(const Params& p, int n, int kh) {
    constexpr int dsh = 2 * GI, d = 1 << dsh, W = 128 << dsh;
    const int tid = threadIdx.x, lane = tid & 63, w = tid >> 6, dq = lane & 15, h = lane >> 4;
    const int t = w, nnew = (t >> dsh) + 1, ncache = 129 - nnew, idx0 = W - d + (t & (d - 1));
    const size_t srow = (size_t)n * 8 + t, row = (size_t)MP + srow;
    const bf16_t* qb = (const bf16_t*)(p.ws + WS_QKV) + (size_t)(3 * GI) * M * 256 + lane * 4;
    const bf16_t* kb = qb + (size_t)M * 256; const bf16_t* vb = kb + (size_t)M * 256;
    const u32x2 qq = *(const u32x2*)(qb + row * 256);
    const f32x4 qv = {bflo(qq.x), bfhi(qq.x), bflo(qq.y), bfhi(qq.y)};
    const float* cbase = p.in[3 + GI] + (size_t)n * W * 512 + lane * 4;
    float* obase = p.out + (GI == 0 ? O_KVS0 : (GI == 1 ? O_KVS1 : O_KVS2)) + (size_t)n * W * 512 + lane * 4;
    SoftAcc A; A.m = -INFINITY; A.l = 0.f; A.o = (f32x4){0.f, 0.f, 0.f, 0.f};
    const int c0 = kh ? 0 : 64;
    constexpr int R = (GI == 2 && SAC_COPY2) ? 2 : 4;
    struct Rows { f32x4 k[R], v[R], k2[R], v2[R]; };
    auto load_rows = [&](Rows& X, int cc) {
#pragma unroll
        for (int i = 0; i < R; ++i) { const float* rp = cbase + (size_t)(idx0 - (c0 + cc + i) * d) * 512;
            if (GI == 2) { X.k[i] = __builtin_nontemporal_load((const f32x4*)rp); X.v[i] = __builtin_nontemporal_load((const f32x4*)(rp + 256));
                if (SAC_COPY2) { X.k2[i] = __builtin_nontemporal_load((const f32x4*)(rp + 8 * 512)); X.v2[i] = __builtin_nontemporal_load((const f32x4*)(rp + 8 * 512 + 256)); } }
            else { X.k[i] = *(const f32x4*)rp; X.v[i] = *(const f32x4*)(rp + 256); } }
    };
    auto process_rows = [&](Rows& X, int cc) {
        float sc[R];
#pragma unroll
        for (int i = 0; i < R; ++i) { const float a = dpp_add16((X.k[i][0] * qv[0] + X.k[i][1] * qv[1]) + (X.k[i][2] * qv[2] + X.k[i][3] * qv[3])); sc[i] = (c0 + cc + i < ncache) ? a : -INFINITY; }
        soft_update<R>(A, sc, X.v);
#pragma unroll
        for (int i = 0; i < R; ++i) { const int idx = idx0 - (c0 + cc + i) * d;
            const bool mine = (GI == 2) ? true : (GI == 1 ? (w < 4) : ((idx & 7) == w));
            if (mine && idx >= 8) { float* op = obase + (size_t)(idx - 8) * 512; __builtin_nontemporal_store(X.k[i], (f32x4*)op); __builtin_nontemporal_store(X.v[i], (f32x4*)(op + 256)); }
            if (GI == 2 && SAC_COPY2) { float* op = obase + (size_t)idx * 512; __builtin_nontemporal_store(X.k2[i], (f32x4*)op); __builtin_nontemporal_store(X.v2[i], (f32x4*)(op + 256)); } }
    };
    { constexpr int NS = SAC_NS; Rows X[NS];
#pragma unroll
      for (int st = 0; st < NS - 1; ++st) load_rows(X[st], st * R);
#pragma unroll 1
      for (int cc = 0; cc < 64; cc += NS * R) {
#pragma unroll
          for (int st = 0; st < NS; ++st) { const int nxt = cc + (st + NS - 1) * R; if (nxt < 64) load_rows(X[(st + NS - 1) % NS], nxt); process_rows(X[st], cc + st * R); }
      } }
    if (kh) {
#pragma unroll
        for (int gq = 0; gq < 2; ++gq) {
            float sc[4]; f32x4 v[4];
#pragma unroll
            for (int i = 0; i < 4; ++i) { const int l = 4 * gq + i, lc = l < nnew ? l : 0; const size_t kr = ((size_t)MP + n * 8 + (t - lc * d)) * 256;
                const u32x2 kk = *(const u32x2*)(kb + kr), vv = *(const u32x2*)(vb + kr);
                const float a = dpp_add16((bflo(kk.x) * qv[0] + bfhi(kk.x) * qv[1]) + (bflo(kk.y) * qv[2] + bfhi(kk.y) * qv[3]));
                sc[i] = (l < nnew) ? a : -INFINITY; v[i] = (f32x4){bflo(vv.x), bfhi(vv.x), bflo(vv.y), bfhi(vv.y)}; }
            soft_update<4>(A, sc, v);
        }
    }
    const float inv = 1.0f / A.l; const int pg = 2 * GI + kh;
    u32x2 ww; ww.x = cvt_pk_bf16(A.o[0] * inv, A.o[1] * inv); ww.y = cvt_pk_bf16(A.o[2] * inv, A.o[3] * inv);
    *(u32x2*)((bf16_t*)(p.ws + WS_OGS) + ((size_t)pg * MS + srow) * 256 + lane * 4) = ww;
    if (dq == 0) ((float*)(p.ws + WS_LSES))[((size_t)pg * MS + srow) * 4 + h] = A.m + __logf(A.l);
}
__device__ __forceinline__ void phase_sample_attn_copy(const Params& p) {
    for (int u = blockIdx.x; u < 256; u += gridDim.x) { const int n = u >> 1, kh = u & 1; sac_unit<2>(p, n, kh); sac_unit<1>(p, n, kh); sac_unit<0>(p, n, kh); }
}

__device__ __forceinline__ void load_u8(const bf16_t* zc, size_t row, int c, float (&u)[8]) {
    const u32x4 a = *(const u32x4*)(zc + row * 1536 + 512 + c), b = *(const u32x4*)(zc + row * 1536 + 1024 + c);
    u[0] = bflo(a.x) * bflo(b.x); u[1] = bfhi(a.x) * bfhi(b.x); u[2] = bflo(a.y) * bflo(b.y); u[3] = bfhi(a.y) * bfhi(b.y);
    u[4] = bflo(a.z) * bflo(b.z); u[5] = bfhi(a.z) * bfhi(b.z); u[6] = bflo(a.w) * bflo(b.w); u[7] = bfhi(a.w) * bfhi(b.w);
}
__device__ __forceinline__ void phase_conv(const Params& p) {
    const bf16_t* zc = (const bf16_t*)(p.ws + WS_ZC); bf16_t* yc = (bf16_t*)(p.ws + WS_YC);
    const float* cw = p.in[8]; const float* st = p.in[2];
    const size_t gt = (size_t)blockIdx.x * NT + fresh_tid(), GT = (size_t)gridDim.x * NT;
    for (size_t i = gt; i < (size_t)M * 64; i += GT) {
        const size_t row = i >> 6; const int c = (int)(i & 63) * 8;
        float u0[8], u1[8], u2[8];
        load_u8(zc, row, c, u2);
        int tpos; int nb = 0; const bool prm = row < MP;
        if (prm) tpos = (int)(row & 4095); else { const int rs = (int)(row - MP); nb = rs >> 3; tpos = rs & 7; }
        if (tpos >= 1) load_u8(zc, row - 1, c, u1);
        else if (prm) {
#pragma unroll
            for (int e = 0; e < 8; ++e) u1[e] = 0.f; }
        else { const f32x4 a = *(const f32x4*)(st + ((size_t)nb * 2 + 1) * 512 + c), b = *(const f32x4*)(st + ((size_t)nb * 2 + 1) * 512 + c + 4);
            u1[0] = a[0]; u1[1] = a[1]; u1[2] = a[2]; u1[3] = a[3]; u1[4] = b[0]; u1[5] = b[1]; u1[6] = b[2]; u1[7] = b[3]; }
        if (tpos >= 2) load_u8(zc, row - 2, c, u0);
        else if (prm) {
#pragma unroll
            for (int e = 0; e < 8; ++e) u0[e] = 0.f; }
        else { const int si = tpos;
            const f32x4 a = *(const f32x4*)(st + ((size_t)nb * 2 + si) * 512 + c), b = *(const f32x4*)(st + ((size_t)nb * 2 + si) * 512 + c + 4);
            u0[0] = a[0]; u0[1] = a[1]; u0[2] = a[2]; u0[3] = a[3]; u0[4] = b[0]; u0[5] = b[1]; u0[6] = b[2]; u0[7] = b[3]; }
        const u32x4 bb = *(const u32x4*)(zc + row * 1536 + c);
        const float Bv[8] = {bflo(bb.x), bfhi(bb.x), bflo(bb.y), bfhi(bb.y), bflo(bb.z), bfhi(bb.z), bflo(bb.w), bfhi(bb.w)};
        float y[8];
#pragma unroll
        for (int e = 0; e < 8; ++e) y[e] = Bv[e] * (cw[c + e] * u0[e] + cw[512 + c + e] * u1[e] + cw[1024 + c + e] * u2[e]);
        u32x4 o; o.x = cvt_pk_bf16(y[0], y[1]); o.y = cvt_pk_bf16(y[2], y[3]); o.z = cvt_pk_bf16(y[4], y[5]); o.w = cvt_pk_bf16(y[6], y[7]);
        *(u32x4*)(yc + row * 512 + c) = o;
        float* so = nullptr;
        if (prm) { if (tpos >= SEQ - 2) so = p.out + O_CP + ((size_t)(row >> 12) * 2 + (tpos - (SEQ - 2))) * 512 + c; }
        else if (tpos >= 6) so = p.out + O_CS + ((size_t)nb * 2 + (tpos - 6)) * 512 + c;
        if (so) { *(f32x4*)so = (f32x4){u2[0], u2[1], u2[2], u2[3]}; *(f32x4*)(so + 4) = (f32x4){u2[4], u2[5], u2[6], u2[7]}; }
    }
}

constexpr int CP_PIECE = 8192;
constexpr int CP_UNITS_N = 2 + 8 + 32;
constexpr int CP_UNITS = 128 * CP_UNITS_N;
__device__ __forceinline__ void copy_unit(const Params& p, int unit) {
    const int n = unit / CP_UNITS_N, q = unit - n * CP_UNITS_N;
    const int g = q < 2 ? 0 : (q < 10 ? 1 : 2), piece = q - (g == 0 ? 0 : (g == 1 ? 2 : 10));
    const int W = 128 << (2 * g);
    const size_t per = (size_t)(W - 8) * 128, full = (size_t)W * 128;
    const f32x4* src = (const f32x4*)p.in[3 + g] + n * full + 1024 + (size_t)piece * CP_PIECE;
    f32x4* dst = (f32x4*)(p.out + (g == 0 ? O_KVS0 : (g == 1 ? O_KVS1 : O_KVS2))) + n * full + (size_t)piece * CP_PIECE;
    const int cnt = (int)((per - (size_t)piece * CP_PIECE) < (size_t)CP_PIECE ? (per - (size_t)piece * CP_PIECE) : (size_t)CP_PIECE);
    const int tid = fresh_tid();
#pragma unroll
    for (int u = 0; u < 2; ++u) {
        f32x4 v[8];
#pragma unroll
        for (int k = 0; k < 8; ++k) { const int idx = tid + (u * 8 + k) * NT; if (idx < cnt) v[k] = __builtin_nontemporal_load(src + idx); }
#pragma unroll
        for (int k = 0; k < 8; ++k) { const int idx = tid + (u * 8 + k) * NT; if (idx < cnt) __builtin_nontemporal_store(v[k], dst + idx); }
    }
}
__device__ __forceinline__ void phase_copy(const Params& p) {
    for (int u = blockIdx.x; u < CP_UNITS; u += gridDim.x) copy_unit(p, u);
}

template <int NG>
__device__ __forceinline__ void merge_rows(const bf16_t* og, const float* lse, size_t gstride_rows, size_t row, int c, bf16_t* dst) {
    const int h = c >> 6; float l[NG], mx = -INFINITY;
#pragma unroll
    for (int g = 0; g < NG; ++g) { l[g] = lse[((size_t)g * gstride_rows + row) * 4 + h]; mx = fmaxf(mx, l[g]); }
    float ws = 0.f;
#pragma unroll
    for (int g = 0; g < NG; ++g) { l[g] = __expf(l[g] - mx); ws += l[g]; }
    const float inv = 1.0f / ws; float acc[8];
#pragma unroll
    for (int e = 0; e < 8; ++e) acc[e] = 0.f;
#pragma unroll
    for (int g = 0; g < NG; ++g) { const u32x4 a = *(const u32x4*)(og + ((size_t)g * gstride_rows + row) * 256 + c); const float wg = l[g] * inv;
        acc[0] += wg * bflo(a.x); acc[1] += wg * bfhi(a.x); acc[2] += wg * bflo(a.y); acc[3] += wg * bfhi(a.y); acc[4] += wg * bflo(a.z); acc[5] += wg * bfhi(a.z); acc[6] += wg * bflo(a.w); acc[7] += wg * bfhi(a.w); }
    u32x4 o; o.x = cvt_pk_bf16(acc[0], acc[1]); o.y = cvt_pk_bf16(acc[2], acc[3]); o.z = cvt_pk_bf16(acc[4], acc[5]); o.w = cvt_pk_bf16(acc[6], acc[7]);
    *(u32x4*)dst = o;
}
__device__ __forceinline__ void phase_merge(const Params& p) {
    bf16_t* ya = (bf16_t*)(p.ws + WS_YA);
    const size_t gt = (size_t)blockIdx.x * NT + threadIdx.x, GT = (size_t)gridDim.x * NT;
    for (size_t i = gt; i < (size_t)M * 32; i += GT) {
        const size_t row = i >> 5; const int c = (int)(i & 31) * 8;
        if (row < MP) merge_rows<3>((const bf16_t*)(p.ws + WS_OG), (const float*)(p.ws + WS_LSE), M, row, c, ya + row * 256 + c);
        else merge_rows<6>((const bf16_t*)(p.ws + WS_OGS), (const float*)(p.ws + WS_LSES), MS, row - MP, c, ya + row * 256 + c);
    }
}

template <bool FINAL>
__device__ __forceinline__ void phase_ln(const Params& p, const float* gam, const float* bet) {
    constexpr int NSL = FINAL ? 8 : 4;
    const int lane = threadIdx.x & 63, w = threadIdx.x >> 6;
    const float* pre = (const float*)(p.ws + WS_PRE); const float* part = (const float*)(p.ws + WS_PART);
    f32x4 gv[4], bv[4];
#pragma unroll
    for (int j = 0; j < 4; ++j) { gv[j] = ((const f32x4*)gam)[lane + 64 * j]; bv[j] = ((const f32x4*)bet)[lane + 64 * j]; }
    for (int row = blockIdx.x * 8 + w; row < M; row += gridDim.x * 8) {
        f32x4 v[4];
        if (row < MP) { const f32x4* xr = (const f32x4*)(pre + (size_t)row * 1024) + lane;
#pragma unroll
            for (int j = 0; j < 4; ++j) v[j] = xr[64 * j]; }
        else { const int rs = row - MP;
#pragma unroll
            for (int j = 0; j < 4; ++j) {
                if (FINAL) { const u32x2 rr = ((const u32x2*)(p.ws + WS_X1B + (size_t)row * 2048))[lane + 64 * j]; v[j] = (f32x4){bflo(rr.x), bfhi(rr.x), bflo(rr.y), bfhi(rr.y)} * ALPHA; }
                else v[j] = ((const f32x4*)(p.in[1] + (size_t)rs * 1024))[lane + 64 * j] * ALPHA; }
#pragma unroll 2
            for (int z = 0; z < NSL; ++z) { const f32x4* pr = (const f32x4*)(part + ((size_t)z * MS + rs) * 1024) + lane;
#pragma unroll
                for (int j = 0; j < 4; ++j) v[j] = v[j] + pr[64 * j]; } }
        float s = 0.f;
#pragma unroll
        for (int j = 0; j < 4; ++j) s += (v[j][0] + v[j][1]) + (v[j][2] + v[j][3]);
        const float mean = wave_sum(s) * (1.f / 1024.f); float s2 = 0.f;
#pragma unroll
        for (int j = 0; j < 4; ++j) { v[j] = v[j] - mean; s2 += (v[j][0] * v[j][0] + v[j][1] * v[j][1]) + (v[j][2] * v[j][2] + v[j][3] * v[j][3]); }
        const float rstd = 1.f / sqrtf(wave_sum(s2) * (1.f / 1024.f) + LN_EPS);
#pragma unroll
        for (int j = 0; j < 4; ++j) { const f32x4 y = v[j] * rstd * gv[j] + bv[j];
            if (FINAL) { ((f32x4*)(p.out + (size_t)row * 1024))[lane + 64 * j] = y; }
            else { u32x2 ww; ww.x = cvt_pk_bf16(y[0], y[1]); ww.y = cvt_pk_bf16(y[2], y[3]); ((u32x2*)(p.ws + WS_X1B + (size_t)row * 2048))[lane + 64 * j] = ww; } }
    }
}


struct CopyStream {
    static constexpr bool ON = true;
    static constexpr int NSTEPS = 128 * 256;
    f32x4 ra, rb; char* pa; char* pb;
    const char* src; char* dst; char* dump; unsigned lane_off; int cur, end;
    __device__ __forceinline__ void init(const Params& p) {
        const int spb = (NSTEPS + (int)gridDim.x - 1) / (int)gridDim.x;
        cur = (int)blockIdx.x * spb; end = cur + spb < NSTEPS ? cur + spb : NSTEPS; if (cur > end) cur = end;
        src = (const char*)p.in[5]; dst = (char*)(p.out + O_KVS2); dump = (char*)(p.ws + WS_DUMP) + (size_t)blockIdx.x * 8192; lane_off = threadIdx.x * 16u;
        pa = dump; pb = dump; ra = (f32x4){0.f, 0.f, 0.f, 0.f}; rb = ra;
    }
    __device__ __forceinline__ static size_t step_off(int s) { const int n = s >> 8, q = s & 255; return (((size_t)n << 20) + ((size_t)(q >> 1) << 13) + 4096 + ((size_t)(q & 1) << 11)) * 4; }
    __device__ __forceinline__ void load(f32x4& r, char*& d) {
        const bool live = cur < end; const size_t off = step_off(live ? cur : 0);
        const char* a = (live ? src + off : (const char*)dump) + lane_off; d = (live ? dst + off - 4096 * 4 : dump) + lane_off; cur += live ? 1 : 0;
        asm volatile("global_load_dwordx4 %0, %1, off nt" : "=&v"(r) : "v"(a) : "memory");
    }
    __device__ __forceinline__ void step(int k) {
        if (k == 0) { load(ra, pa); load(rb, pb); }
        else if (k == 3) { asm volatile("global_store_dwordx4 %0, %1, off nt" :: "v"(pa), "v"(ra) : "memory"); asm volatile("global_store_dwordx4 %0, %1, off nt" :: "v"(pb), "v"(rb) : "memory"); }
    }
    __device__ __forceinline__ void finish() {
        for (; cur < end; ++cur) { const size_t off = step_off(cur); const f32x4 v = __builtin_nontemporal_load((const f32x4*)(src + off + lane_off)); __builtin_nontemporal_store(v, (f32x4*)(dst + off - 4096 * 4 + lane_off)); }
    }
};

#define XB_TMO      128
#define XB_XCNT(j)  (256  + 64 * (j))
#define XB_XSUB(j)  (1280 + 64 * (j))
#define XB_XGEN(j)  (2304 + 64 * (j))
#define XB_TOP      3328
#define XB_TOPGEN   3392
#define XCD_BAR_WORDS 3456
#define XB_SPIN_CAP (1u << 18)
__device__ __forceinline__ unsigned xb_ld(unsigned* p)              { return __hip_atomic_load(p, __ATOMIC_RELAXED, __HIP_MEMORY_SCOPE_AGENT); }
__device__ __forceinline__ unsigned xb_add(unsigned* p, unsigned v) { return __hip_atomic_fetch_add(p, v, __ATOMIC_RELAXED, __HIP_MEMORY_SCOPE_AGENT); }
__device__ __forceinline__ unsigned xb_xcc_id() { return (unsigned)__builtin_amdgcn_s_getreg((3 << 11) | 20) & 0xFu; }
#define XB_SPIN(cond, bar) do { unsigned _sp = 0; while (cond) { __builtin_amdgcn_s_sleep(1); \
    if ((++_sp & 255u) == 0u) { if (xb_ld(&(bar)[XB_TMO])) break; if (_sp > XB_SPIN_CAP) { atomicAdd(&(bar)[XB_TMO], 1u); break; } } } } while (0)
struct XcdBarrier { unsigned* bar; unsigned x; volatile LAS unsigned* st; };
__device__ __forceinline__ XcdBarrier xcd_barrier_post(unsigned* bar, volatile LAS unsigned* st) {
    XcdBarrier b; b.bar = bar; b.x = xb_xcc_id(); b.st = st;
    if (threadIdx.x == 0) (void)xb_add(&bar[XB_XCNT(b.x)], 1u);
    return b;
}
__device__ __forceinline__ void xcd_barrier_complete(unsigned* bar, unsigned x, unsigned& nloc, unsigned& nx) {
    const unsigned G = gridDim.x * gridDim.y * gridDim.z;
    unsigned sum, cnt, mine, sp = 0u;
    for (;;) {
        sum = 0u; cnt = 0u; mine = 0u;
#pragma unroll
        for (unsigned j = 0; j < 16; ++j) { const unsigned c = xb_ld(&bar[XB_XCNT(j)]); sum += c; cnt += (c > 0u) ? 1u : 0u; mine = (j == x) ? c : mine; }
        if (sum == G) break;
        __builtin_amdgcn_s_sleep(1);
        if ((++sp & 255u) == 0u) { if (xb_ld(&bar[XB_TMO])) break; if (sp > XB_SPIN_CAP) { atomicAdd(&bar[XB_TMO], 1u); break; } }
    }
    nloc = mine > 0u ? mine : 1u; nx = cnt > 0u ? cnt : 1u;
}
__device__ __forceinline__ void xcd_barrier(const XcdBarrier& b) {
    asm volatile("s_waitcnt vmcnt(0)" ::: "memory");
    __syncthreads();
    if (threadIdx.x == 0) {
        unsigned* bar = b.bar;
        __builtin_amdgcn_s_waitcnt(0);
        unsigned nloc = b.st[0], nx = b.st[1];
        if (nloc == 0u) { xcd_barrier_complete(bar, b.x, nloc, nx); b.st[0] = nloc; b.st[1] = nx; }
        const unsigned old = xb_add(&bar[XB_XSUB(b.x)], 1u);
        const unsigned gen = old / nloc;
        if (old + 1u == (gen + 1u) * nloc) {
            __builtin_amdgcn_fence(__ATOMIC_RELEASE, "agent");
            asm volatile("s_waitcnt vmcnt(0)" ::: "memory");
            const unsigned og = xb_add(&bar[XB_TOP], 1u);
            const unsigned tg = og / nx;
            if (og + 1u == (tg + 1u) * nx) xb_add(&bar[XB_TOPGEN], 1u);
            else XB_SPIN(xb_ld(&bar[XB_TOPGEN]) == tg, bar);
            __builtin_amdgcn_fence(__ATOMIC_ACQUIRE, "agent");
            xb_add(&bar[XB_XGEN(b.x)], 1u);
            asm volatile("s_waitcnt vmcnt(0)" ::: "memory");
        } else {
            XB_SPIN(xb_ld(&bar[XB_XGEN(b.x)]) == gen, bar);
            __builtin_amdgcn_fence(__ATOMIC_ACQUIRE, "agent");
            asm volatile("s_waitcnt vmcnt(0)" ::: "memory");
        }
    }
    __syncthreads();
}

constexpr int N_PHASES = 10;
__global__ void __launch_bounds__(NT, 2) fwd_kernel(Params p) {
    extern __shared__ __attribute__((aligned(16))) unsigned char smem[];
    LAS unsigned char* lds = (LAS unsigned char*)smem;
    unsigned char* ws = p.ws;
    const int G = gridDim.x, bx = blockIdx.x;
#if MK_MULTI
#define SYNC() do {} while (0)
#else
    cg::grid_group grid = cg::this_grid();
    if (p.ph_lo < 0) grid.sync();
    volatile LAS unsigned* xst = (volatile LAS unsigned*)(lds + pg8::STAGE_BYTES);
    if (threadIdx.x < 4) xst[threadIdx.x] = 0u;
    __syncthreads();
    const XcdBarrier xbar = xcd_barrier_post((unsigned*)(ws + WS_BAR), xst);
#define SYNC1() xcd_barrier(xbar)
#define SYNC() do { SYNC1(); if (DUP == 30) SYNC1(); } while (0)
#endif
#ifndef DUP
#define DUP -1
#endif
#define IN(k) (p.ph_lo <= (k) && (k) < p.ph_hi)
#define REP(k) for (int rep_ = 0; rep_ < ((DUP) == (k) ? 2 : 1); ++rep_)
    if (IN(0)) { REP(0) { phase_prep(p, lds); __syncthreads(); } SYNC(); }
    if (IN(1)) {
        constexpr int GEMM_WGS = 192;
        pg8::Gemm g{(const bf16_t*)(ws + WS_XB), (const bf16_t*)(ws + WS_WIN), M, NIN, D};
        Epi1 E{(bf16_t*)(ws + WS_ZC), (bf16_t*)(ws + WS_QKV), (bf16_t*)(ws + WS_GATE), p.in[7], (const float*)(ws + WS_ROPE), p.out};
        { P1Order S{0, G, (G < 1564 ? G : 1564), bx}; pg8::gemm_phase<Epi1, P1Order, true, true>(lds, g, S, E); }
        SYNC();
        { const int gw = G > 64 ? (G * 3) / 4 : G;
          if (gw != GEMM_WGS && bx == 0 && threadIdx.x == 0) {   }
          P1Order S{G < 1564 ? G : 1564, gw, 1564, bx}; pg8::gemm_phase<Epi1, P1Order, true, true>(lds, g, S, E); }
        { unsigned* qctr = (unsigned*)(ws + WS_BAR) + 3520;
          for (;;) {
              __syncthreads();
              if (threadIdx.x == 0) xst[2] = __hip_atomic_fetch_add(qctr, 1u, __ATOMIC_RELAXED, __HIP_MEMORY_SCOPE_AGENT);
              __syncthreads();
              const int u = (int)xst[2]; if (u >= 256) break;
              const int n = u >> 1, kh = u & 1; sac_unit<2>(p, n, kh); sac_unit<1>(p, n, kh); sac_unit<0>(p, n, kh);
          } }
        SYNC();
    }
    if (IN(2)) {
        REP(21) for (int it = bx; it < 1536; it += G) attn_prompt_item(p, lds, it);
        REP(23) phase_conv(p);
        __syncthreads();
        SYNC();
    }
    if (IN(3)) { REP(3) phase_merge(p); SYNC(); }
    if (IN(4)) {
        REP(4) {
        { pg8::Gemm g{(const bf16_t*)(ws + WS_YC), (const bf16_t*)(ws + WS_WC), M, D, DC}; pg8::StaticOrder S; S.init(M, D, G, bx, DC);
          Epi3 E{(bf16_t*)(ws + WS_MIX), (const bf16_t*)(ws + WS_GATE), 0};
          pg8::gemm_phase<Epi3, pg8::StaticOrder, true, true>(lds, g, S, E); }
        { pg8::Gemm g{(const bf16_t*)(ws + WS_YA), (const bf16_t*)(ws + WS_WA), M, D, 256}; pg8::StaticOrder S; S.init(M, D, G, bx, 256);
          Epi3 E{(bf16_t*)(ws + WS_MIX), (const bf16_t*)(ws + WS_GATE), 1};
          pg8::gemm_phase<Epi3, pg8::StaticOrder, true, true>(lds, g, S, E); }
        }
        SYNC();
    }
    if (IN(5)) {
        REP(5) {
        pg8::Gemm g{(const bf16_t*)(ws + WS_MIX), (const bf16_t*)(ws + WS_WO), M, D, D}; SplitOrder S{4, D / 64, G, bx};
        EpiRes<false> E{p.in[0], (float*)(ws + WS_PRE), (float*)(ws + WS_PART)};
        pg8::gemm_phase<EpiRes<false>, SplitOrder, true, true>(lds, g, S, E);
        }
        SYNC();
    }
    if (IN(6)) { REP(6) phase_ln<false>(p, p.in[12], p.in[13]); SYNC(); }
#if !SAC_COPY2
    CopyStream cs; cs.init(p);
#endif
    if (IN(7)) {
        REP(7) {
        pg8::Gemm g{(const bf16_t*)(ws + WS_X1B), (const bf16_t*)(ws + WS_WUP), M, FF, D}; pg8::StaticOrder S; S.init(M, FF, G, bx, D);
        EpiHid E{(bf16_t*)(ws + WS_HID)};
#if SAC_COPY2
        pg8::gemm_phase<EpiHid, pg8::StaticOrder, true, true>(lds, g, S, E);
#else
        pg8::gemm_phase<EpiHid, pg8::StaticOrder, true, true, CopyStream>(lds, g, S, E, cs);
#endif
        }
        SYNC();
    }
    if (IN(8)) {
        REP(8) {
        pg8::Gemm g{(const bf16_t*)(ws + WS_HID), (const bf16_t*)(ws + WS_WDN), M, D, FF}; SplitOrder S{8, FF / 64, G, bx};
        EpiRes<true> E{(const void*)(ws + WS_X1B), (float*)(ws + WS_PRE), (float*)(ws + WS_PART)};
#if SAC_COPY2
        pg8::gemm_phase<EpiRes<true>, SplitOrder, true, true>(lds, g, S, E);
#else
        pg8::gemm_phase<EpiRes<true>, SplitOrder, true, true, CopyStream>(lds, g, S, E, cs);
        cs.finish();
#endif
        }
        SYNC();
    }
    if (IN(9)) { REP(9) phase_ln<true>(p, p.in[16], p.in[17]); }
#ifdef DUMP
    if (IN(20)) { const size_t gt = (size_t)blockIdx.x * NT + threadIdx.x, GT = (size_t)gridDim.x * NT;
        for (size_t i = gt; i < (size_t)M * 1024; i += GT) { const size_t row = i >> 10, c = i & 1023; float v;
            if (DUMP == 1) { v = bf1(((const bf16_t*)(ws + WS_GATE))[row * 2048 + c]) + bf1(((const bf16_t*)(ws + WS_GATE))[row * 2048 + 1024 + c]) + bf1(((const bf16_t*)(ws + WS_ZC))[row * 1536 + c]) + bf1(((const bf16_t*)(ws + WS_ZC))[row * 1536 + 512 + c]);
                for (int sl = 0; sl < 9; ++sl) v += (float)(sl + 1) * bf1(((const bf16_t*)(ws + WS_QKV))[((size_t)sl * M + row) * 256 + (c & 255)]); }
            else if (DUMP == 2) { v = bf1(((const bf16_t*)(ws + WS_YC))[row * 512 + (c & 511)]);
                for (int sl = 0; sl < 3; ++sl) v += (float)(sl + 1) * bf1(((const bf16_t*)(ws + WS_OG))[((size_t)sl * M + row) * 256 + (c & 255)]) + ((const float*)(ws + WS_LSE))[((size_t)sl * M + row) * 4 + (c & 3)]; }
            else if (DUMP == 3) v = bf1(((const bf16_t*)(ws + WS_YA))[row * 256 + (c & 255)]);
            else if (DUMP == 4) v = bf1(((const bf16_t*)(ws + WS_MIX))[i]);
            else if (DUMP == 5 || DUMP == 8) v = ((const float*)(ws + WS_PRE))[i];
            else if (DUMP == 6) v = ((const float*)(ws + WS_X1F))[i];
            else { const bf16_t* hp = (const bf16_t*)(ws + WS_HID) + row * 4096 + c; v = bf1(hp[0]) + bf1(hp[1024]) + bf1(hp[2048]) + bf1(hp[3072]); }
            p.out[i] = v; } }
#endif
#undef IN
#undef SYNC
}

extern "C" void kernel_launch(void* const* d_in, const int* in_sizes, int n_in, void* d_out, int out_size, void* d_ws, size_t ws_size, hipStream_t stream) {
    static int grid = 0;
    if (grid == 0) {
        if (n_in != 18 || (size_t)out_size != O_END || ws_size < WS_END) { fprintf(stderr, "kernel_launch: unexpected shapes (n_in %d out %d ws %zu need %zu)\n", n_in, out_size, ws_size, (size_t)WS_END); grid = -1; return; }
        int dev = 0, cus = 0, per_cu = 0;
        (void)hipGetDevice(&dev); (void)hipDeviceGetAttribute(&cus, hipDeviceAttributeMultiprocessorCount, dev);
        if (hipFuncSetAttribute((const void*)fwd_kernel, hipFuncAttributeMaxDynamicSharedMemorySize, LDS_BYTES) != hipSuccess) { fprintf(stderr, "kernel_launch: hipFuncSetAttribute failed\n"); grid = -1; return; }
        if (hipOccupancyMaxActiveBlocksPerMultiprocessor(&per_cu, (const void*)fwd_kernel, NT, LDS_BYTES) != hipSuccess || per_cu < 1) { fprintf(stderr, "kernel_launch: occupancy query says %d\n", per_cu); per_cu = 1; }
        (void)hipGetLastError();
        grid = cus * 1;
    }
    if (grid < 0) return;
    Params p{};
    for (int i = 0; i < 18; ++i) p.in[i] = (const float*)d_in[i];
    p.out = (float*)d_out; p.ws = (unsigned char*)d_ws;
#if MK_MULTI
#ifdef DUMP
    for (int k = 0; k <= DUMP; ++k) { p.ph_lo = k; p.ph_hi = k + 1; hipLaunchKernelGGL(fwd_kernel, dim3(grid), dim3(NT), LDS_BYTES, stream, p); }
    p.ph_lo = 20; p.ph_hi = 21; hipLaunchKernelGGL(fwd_kernel, dim3(grid), dim3(NT), LDS_BYTES, stream, p);
#else
    for (int k = 0; k < N_PHASES; ++k) { p.ph_lo = k; p.ph_hi = k + 1; hipLaunchKernelGGL(fwd_kernel, dim3(grid), dim3(NT), LDS_BYTES, stream, p); }
#endif
#else
    p.ph_lo = 0; p.ph_hi = N_PHASES;
    if (hipMemsetAsync((char*)d_ws + WS_BAR, 0, 16384, stream) != hipSuccess) { fprintf(stderr, "kernel_launch: memset of the barrier words failed\n"); return; }
    void* args[] = {&p};
    hipError_t e = hipLaunchCooperativeKernel((const void*)fwd_kernel, dim3(grid), dim3(NT), args, LDS_BYTES, stream);
    if (e != hipSuccess) fprintf(stderr, "cooperative launch failed: %s (grid %d)\n", hipGetErrorString(e), grid);
#endif
}
```

```cpp
#include <hip/hip_runtime.h>
#include <hip/hip_cooperative_groups.h>
#include <cstdio>
#include <cstdint>
namespace cg = cooperative_groups;

#ifndef MK_MULTI
#define MK_MULTI 0
#define DUP -1
#endif

__device__ __forceinline__ int fresh_tid() { return threadIdx.x; }
namespace pg8 {
#define PG8_LAS __attribute__((address_space(3)))
typedef unsigned short bf16_t;
typedef short bf16x8 __attribute__((ext_vector_type(8)));
typedef float f32x4 __attribute__((ext_vector_type(4)));
typedef unsigned u32x4 __attribute__((ext_vector_type(4)));
typedef unsigned u32x2 __attribute__((ext_vector_type(2)));
constexpr int BM = 256, BK = 64, HALF = 128, HTB = HALF * BK * 2, STAGE_BYTES = 8 * HTB, NXCD = 8, WGM = 8;

__host__ __device__ __forceinline__ int lds_byte(int r, int c) { const int st = (r >> 4) * 2 + (c >> 5), rr = r & 15, cc = c & 31, ob = rr * 64 + cc * 2; return st * 1024 + (ob ^ (((ob >> 9) & 1) << 5)); }
__host__ __device__ __forceinline__ void stage_rc(int b, int& R, int& C) { const int st = b / 1024, sb = b % 1024, swz = sb ^ (((sb >> 9) & 1) << 5); R = (st >> 1) * 16 + swz / 64; C = (st & 1) * 32 + (swz % 64) / 2; }
__host__ __device__ __forceinline__ int perm32(int rho) { const int n = rho >> 4, i = rho & 15; return 8 * (i >> 2) + 4 * n + (i & 3); }
__host__ __device__ __forceinline__ int swap45(int v) { return (v & 15) | ((v & 16) << 1) | ((v & 32) >> 1); }

struct Unit { int pm, pn, kt0, nt; };
struct Gemm { const bf16_t* A; const bf16_t* Bt; int M, N, K; };

struct StaticOrder {
    int nM, nN, nwg, G, c, ntk;
    __host__ __device__ void init(int M, int N, int G_, int c_, int K_) { nM = M / BM; nN = N / BM; nwg = nM * nN; G = G_; c = c_; ntk = K_ / BK; }
    __host__ __device__ bool next(int i, Unit& u) const {
        u.kt0 = 0; u.nt = ntk;
        const long L = (long)i * G + c; if (L >= nwg) return false;
        int wgid = (int)L; { const int q = nwg / NXCD, r = nwg % NXCD, xcd = wgid % NXCD, off = wgid / NXCD; wgid = (xcd < r ? xcd * (q + 1) : r * (q + 1) + (xcd - r) * q) + off; }
        const int nig = WGM * nN, gid = wgid / nig, fm = gid * WGM, gsz = (nM - fm) < WGM ? (nM - fm) : WGM;
        u.pm = fm + ((wgid % nig) % gsz); u.pn = (wgid % nig) / gsz; return true;
    }
    __device__ __forceinline__ void a_ready(const Unit&) const {}
    __device__ __forceinline__ void done(const Unit&) const {}
};

typedef float cvt_f32x2 __attribute__((ext_vector_type(2)));
typedef __bf16 cvt_bf16x2 __attribute__((ext_vector_type(2)));
__device__ __forceinline__ unsigned cvt_pk_bf16(float lo, float hi) { const cvt_f32x2 v = {lo, hi}; const cvt_bf16x2 b = __builtin_convertvector(v, cvt_bf16x2); return __builtin_bit_cast(unsigned, b); }

struct NoCopy { static constexpr bool ON = false; __device__ __forceinline__ void step(int) {} };
template <class Epi, class Sched, bool ALIGN_EPI = false, bool SP2 = false, class CS = NoCopy>
__device__ __forceinline__ void gemm_phase(PG8_LAS unsigned char* lds, const Gemm g, const Sched& S, const Epi& E, CS& cs) {
    static_assert(SP2 || !CS::ON, "the copy stream is wired into the SP2 loop only");
    const int tid = fresh_tid(), wid = __builtin_amdgcn_readfirstlane(tid >> 6), lane = tid & 63, wr = wid >> 2, wc = wid & 3, fr = lane & 15, fq = lane >> 4;
    const int K = g.K;
    unsigned voffA[2], voffB[2];
#pragma unroll
    for (int i = 0; i < 2; ++i) { int R, C; stage_rc(tid * 16 + i * 8192, R, C);
        const int Rb = Epi::PERM == 1 ? ((R & ~31) + perm32(R & 31)) : (Epi::PERM == 2 ? ((R & ~63) + swap45(R & 63)) : R);
        voffA[i] = (unsigned)(R * K + C) * 2u; voffB[i] = (unsigned)(Rb * K + C) * 2u; }
    const size_t kstep = (size_t)(BK * 2);
    const size_t hstep = (size_t)HALF * K * 2;
    const size_t tstep = 2 * hstep;
    const unsigned ldsw = (unsigned)wid * 1024u;
    const int aoff = lds_byte(wr * 64 + fr, fq * 8), boff = lds_byte(wc * 32 + fr, fq * 8);
#define PG8_SA(b, h) (((b) * 2 + (h)) * HTB)
#define PG8_SB(b, h) ((4 + (b) * 2 + (h)) * HTB)
#define PG8_STAGE(bufoff, gbase, voff) do { _Pragma("unroll") for (int _i = 0; _i < 2; ++_i) \
        __builtin_amdgcn_global_load_lds((const unsigned*)((const char*)(gbase) + (voff)[_i]), (PG8_LAS unsigned*)(lds + (bufoff) + ldsw + _i * 8192), 16, 0, 0); } while (0)
#define PG8_LDA(dst, b, h) do { _Pragma("unroll") for (int m = 0; m < 4; ++m) _Pragma("unroll") for (int k = 0; k < 2; ++k) dst[m][k] = *(const PG8_LAS bf16x8*)(lds + PG8_SA(b, h) + aoff + m * 2048 + k * 1024); } while (0)
#define PG8_LDB(dst, b, h) do { _Pragma("unroll") for (int n = 0; n < 2; ++n) _Pragma("unroll") for (int k = 0; k < 2; ++k) dst[n][k] = *(const PG8_LAS bf16x8*)(lds + PG8_SB(b, h) + boff + n * 2048 + k * 1024); } while (0)
#define PG8_MMA(ai, bj, At, Bt) do { __builtin_amdgcn_s_setprio(1); _Pragma("unroll") for (int m = 0; m < 4; ++m) _Pragma("unroll") for (int n = 0; n < 2; ++n) _Pragma("unroll") for (int k = 0; k < 2; ++k) \
        acc[ai][bj][m][n] = __builtin_amdgcn_mfma_f32_16x16x32_bf16(Bt[n][k], At[m][k], acc[ai][bj][m][n], 0, 0, 0); __builtin_amdgcn_s_setprio(0); } while (0)
#define PG8_WAIT_V(n) asm volatile("s_waitcnt vmcnt(" #n ")" ::: "memory")
#define PG8_WAIT_L(n) asm volatile("s_waitcnt lgkmcnt(" #n ")" ::: "memory")
#define PG8_WAIT_VC(a) do { if constexpr (!CS::ON) PG8_WAIT_V(8); else if constexpr ((a) == 12) PG8_WAIT_V(12); else if constexpr ((a) == 10) PG8_WAIT_V(10); else PG8_WAIT_V(8); } while (0)
#define PG8_BAR __builtin_amdgcn_s_barrier()
#define PG8_SCHED __builtin_amdgcn_sched_barrier(0)
    Unit cur, nxt; int ui = 0;
    if (!S.next(0, cur)) return;
    f32x4 acc[2][2][4][2];
#pragma unroll
    for (int a = 0; a < 2; ++a)
#pragma unroll
        for (int b = 0; b < 2; ++b)
#pragma unroll
            for (int m = 0; m < 4; ++m)
#pragma unroll
                for (int n = 0; n < 2; ++n) acc[a][b][m][n] = (f32x4){0.f, 0.f, 0.f, 0.f};
    bf16x8 At[4][2], B0[2][2], B1[2][2];
    const char* cA = (const char*)g.A + (size_t)cur.pm * tstep + (size_t)cur.kt0 * kstep; const char* cB = (const char*)g.Bt + (size_t)cur.pn * tstep + (size_t)cur.kt0 * kstep;
    S.a_ready(cur);
    if constexpr (SP2) {
        PG8_STAGE(PG8_SB(0, 0), cB, voffB); PG8_STAGE(PG8_SB(0, 1), cB + hstep, voffB); PG8_STAGE(PG8_SA(0, 0), cA, voffA); PG8_STAGE(PG8_SA(0, 1), cA + hstep, voffA);
        if (wr == 1) PG8_BAR;
        PG8_WAIT_V(2); PG8_BAR;
        PG8_STAGE(PG8_SB(1, 0), cB + kstep, voffB); PG8_STAGE(PG8_SA(1, 0), cA + kstep, voffA); PG8_STAGE(PG8_SB(1, 1), cB + hstep + kstep, voffB);
        PG8_WAIT_V(6); PG8_BAR;
    } else {
        PG8_STAGE(PG8_SB(0, 0), cB, voffB); PG8_STAGE(PG8_SA(0, 0), cA, voffA); PG8_STAGE(PG8_SB(0, 1), cB + hstep, voffB); PG8_STAGE(PG8_SA(0, 1), cA + hstep, voffA);
        if (wr == 1) PG8_BAR;
        PG8_WAIT_V(4); PG8_BAR;
        PG8_STAGE(PG8_SB(1, 0), cB + kstep, voffB); PG8_STAGE(PG8_SA(1, 0), cA + kstep, voffA); PG8_STAGE(PG8_SB(1, 1), cB + hstep + kstep, voffB);
        PG8_WAIT_V(6); PG8_BAR;
    }
    for (;;) {
        const bool has_next = S.next(ui + 1, nxt);
        const char* nA = has_next ? (const char*)g.A + (size_t)nxt.pm * tstep + (size_t)nxt.kt0 * kstep : cA; const char* nB = has_next ? (const char*)g.Bt + (size_t)nxt.pn * tstep + (size_t)nxt.kt0 * kstep : cB;
        const int nt = cur.nt;
        for (int t = 0; t < nt; t += 2) {
            const bool last = (t == nt - 2);
            const char* a1 = cA + (size_t)(t + 1) * kstep;
            const char* a2 = last ? nA : cA + (size_t)(t + 2) * kstep; const char* b2 = last ? nB : cB + (size_t)(t + 2) * kstep;
            const char* a3 = a2 + kstep; const char* b3 = b2 + kstep;
            if (last && has_next) S.a_ready(nxt);
            if constexpr (SP2) {
            PG8_LDB(B0, 0, 0); PG8_LDB(B1, 0, 1); PG8_SCHED; PG8_LDA(At, 0, 0); PG8_STAGE(PG8_SA(1, 1), a1 + hstep, voffA); cs.step(0);
            PG8_WAIT_VC(12); PG8_WAIT_L(0); PG8_BAR; PG8_MMA(0, 0, At, B0); PG8_MMA(0, 1, At, B1); PG8_BAR; PG8_SCHED;
            PG8_LDA(At, 0, 1); PG8_STAGE(PG8_SB(0, 0), b2, voffB); PG8_STAGE(PG8_SB(0, 1), b2 + hstep, voffB); PG8_STAGE(PG8_SA(0, 0), a2, voffA);
            PG8_WAIT_VC(12); PG8_WAIT_L(0); PG8_BAR; PG8_MMA(1, 0, At, B0); PG8_MMA(1, 1, At, B1); PG8_BAR; PG8_SCHED;
            PG8_LDB(B0, 1, 0); PG8_LDB(B1, 1, 1); PG8_SCHED; PG8_LDA(At, 1, 0); PG8_STAGE(PG8_SA(0, 1), a2 + hstep, voffA);
            PG8_WAIT_VC(10); PG8_WAIT_L(0); PG8_BAR; PG8_MMA(0, 0, At, B0); PG8_MMA(0, 1, At, B1); PG8_BAR; PG8_SCHED;
            PG8_LDA(At, 1, 1); PG8_STAGE(PG8_SB(1, 0), b3, voffB); PG8_STAGE(PG8_SB(1, 1), b3 + hstep, voffB); PG8_STAGE(PG8_SA(1, 0), a3, voffA);
            PG8_WAIT_VC(8); PG8_WAIT_L(0); PG8_BAR; cs.step(3); PG8_MMA(1, 0, At, B0); PG8_MMA(1, 1, At, B1); PG8_BAR; PG8_SCHED;
            } else {
            PG8_LDB(B0, 0, 0); PG8_SCHED; PG8_LDA(At, 0, 0); PG8_STAGE(PG8_SA(1, 1), a1 + hstep, voffA);
            PG8_WAIT_L(8); PG8_BAR; PG8_WAIT_L(0); PG8_MMA(0, 0, At, B0); PG8_BAR; PG8_SCHED;
            PG8_LDB(B1, 0, 1); PG8_STAGE(PG8_SB(0, 0), b2, voffB);
            PG8_BAR; PG8_WAIT_L(0); PG8_MMA(0, 1, At, B1); PG8_BAR;
            PG8_LDA(At, 0, 1); PG8_STAGE(PG8_SA(0, 0), a2, voffA);
            PG8_BAR; PG8_WAIT_L(0); PG8_MMA(1, 0, At, B0); PG8_BAR; PG8_SCHED;
            PG8_STAGE(PG8_SB(0, 1), b2 + hstep, voffB);
            PG8_WAIT_V(6); PG8_BAR; PG8_MMA(1, 1, At, B1); PG8_BAR;
            PG8_LDB(B0, 1, 0); PG8_SCHED; PG8_LDA(At, 1, 0); PG8_STAGE(PG8_SA(0, 1), a2 + hstep, voffA);
            PG8_WAIT_L(8); PG8_BAR; PG8_WAIT_L(0); PG8_MMA(0, 0, At, B0); PG8_BAR; PG8_SCHED;
            PG8_LDB(B1, 1, 1); PG8_STAGE(PG8_SB(1, 0), b3, voffB);
            PG8_BAR; PG8_WAIT_L(0); PG8_MMA(0, 1, At, B1); PG8_BAR;
            PG8_LDA(At, 1, 1); PG8_STAGE(PG8_SA(1, 0), a3, voffA);
            PG8_BAR; PG8_WAIT_L(0); PG8_MMA(1, 0, At, B0); PG8_BAR; PG8_SCHED;
            PG8_STAGE(PG8_SB(1, 1), b3 + hstep, voffB);
            PG8_WAIT_V(6); PG8_BAR; PG8_MMA(1, 1, At, B1); PG8_BAR;
            }
        }
        if constexpr (ALIGN_EPI) { if (wr == 0) PG8_BAR; }
        E(acc, cur, wr, wc, fr, fq);
        if (!has_next) break;
#pragma unroll
        for (int a = 0; a < 2; ++a)
#pragma unroll
            for (int b = 0; b < 2; ++b)
#pragma unroll
                for (int m = 0; m < 4; ++m)
#pragma unroll
                    for (int n = 0; n < 2; ++n) acc[a][b][m][n] = (f32x4){0.f, 0.f, 0.f, 0.f};
        cur = nxt; cA = nA; cB = nB; ++ui;
        if constexpr (ALIGN_EPI) { if (wr == 1) PG8_BAR; }
    }
    PG8_WAIT_V(0);
    if constexpr (!ALIGN_EPI) { if (wr == 0) PG8_BAR; }
    PG8_BAR;
#undef PG8_SA
#undef PG8_SB
#undef PG8_STAGE
#undef PG8_LDA
#undef PG8_LDB
#undef PG8_MMA
#undef PG8_WAIT_V
#undef PG8_WAIT_L
#undef PG8_WAIT_VC
#undef PG8_BAR
#undef PG8_SCHED
}
template <class Epi, class Sched, bool ALIGN_EPI = false, bool SP2 = false>
__device__ __forceinline__ void gemm_phase(PG8_LAS unsigned char* lds, const Gemm g, const Sched& S, const Epi& E) { NoCopy nc; gemm_phase<Epi, Sched, ALIGN_EPI, SP2, NoCopy>(lds, g, S, E, nc); }
}

using pg8::bf16_t; using pg8::f32x4; using pg8::u32x4; using pg8::u32x2; using pg8::bf16x8; using pg8::cvt_pk_bf16;
#define LAS __attribute__((address_space(3)))
typedef short bf16x4 __attribute__((ext_vector_type(4)));
typedef float f32x2 __attribute__((ext_vector_type(2)));
constexpr int D = 1024, SEQ = 4096, MP = 16384, MS = 1024, M = MP + MS, NIN = 5888, DC = 512, FF = 4096;
constexpr int NT = 512;
constexpr float ALPHA = 1.189207115002721f;
constexpr float LN_EPS = 1e-5f;
constexpr int LDS_BYTES = pg8::STAGE_BYTES + 16;

constexpr size_t WS_XB = 0;
constexpr size_t WS_WIN = WS_XB + (size_t)M * D * 2;
constexpr size_t WS_WC = WS_WIN + (size_t)NIN * D * 2;
constexpr size_t WS_WA = WS_WC + (size_t)1024 * 512 * 2;
constexpr size_t WS_WO = WS_WA + (size_t)1024 * 256 * 2;
constexpr size_t WS_WUP = WS_WO + (size_t)1024 * 1024 * 2;
constexpr size_t WS_WDN = WS_WUP + (size_t)4096 * 1024 * 2;
constexpr size_t WS_ROPE = WS_WDN + (size_t)4096 * 1024 * 2;
constexpr size_t WS_ZC = WS_ROPE + (size_t)4096 * 32 * 8;
constexpr size_t WS_QKV = WS_ZC + (size_t)M * 1536 * 2;
constexpr size_t WS_GATE = WS_QKV + (size_t)9 * M * 256 * 2;
constexpr size_t WS_OG = WS_GATE + (size_t)M * 2048 * 2;
constexpr size_t WS_LSE = WS_OG + (size_t)3 * M * 256 * 2;
constexpr size_t WS_YC = WS_LSE + (size_t)3 * M * 4 * 4;
constexpr size_t WS_YA = WS_YC + (size_t)M * 512 * 2;
constexpr size_t WS_MIX = WS_YA + (size_t)M * 256 * 2;
constexpr size_t WS_PRE = WS_MIX + (size_t)M * 1024 * 2;
constexpr size_t WS_X1F = WS_PRE + (size_t)M * 1024 * 4;
constexpr size_t WS_PART = WS_X1F;
constexpr size_t WS_X1B = WS_X1F + (size_t)M * 1024 * 4;
constexpr size_t WS_HID = WS_X1B + (size_t)M * 1024 * 2;
constexpr size_t WS_BAR = WS_HID + (size_t)M * 4096 * 2;
constexpr size_t WS_OGS = WS_BAR + 16384;
constexpr size_t WS_LSES = WS_OGS + (size_t)6 * MS * 256 * 2;
constexpr size_t WS_DUMP = WS_LSES + (size_t)6 * MS * 4 * 4;
constexpr size_t WS_END = WS_DUMP + (size_t)1024 * 8192;

constexpr size_t O_YP = 0;
constexpr size_t O_YS = O_YP + (size_t)MP * D;
constexpr size_t O_CP = O_YS + (size_t)MS * D;
constexpr size_t O_KVP0 = O_CP + 4 * 2 * 512;
constexpr size_t O_KVP1 = O_KVP0 + (size_t)4 * 128 * 512;
constexpr size_t O_KVP2 = O_KVP1 + (size_t)4 * 512 * 512;
constexpr size_t O_CS = O_KVP2 + (size_t)4 * 2048 * 512;
constexpr size_t O_KVS0 = O_CS + (size_t)128 * 2 * 512;
constexpr size_t O_KVS1 = O_KVS0 + (size_t)128 * 128 * 512;
constexpr size_t O_KVS2 = O_KVS1 + (size_t)128 * 512 * 512;
constexpr size_t O_END = O_KVS2 + (size_t)128 * 2048 * 512;

struct Params { const float* in[18]; float* out; unsigned char* ws; int ph_lo, ph_hi; };

__device__ __forceinline__ float bflo(unsigned w) { return __builtin_bit_cast(float, w << 16); }
__device__ __forceinline__ float bfhi(unsigned w) { return __builtin_bit_cast(float, w & 0xffff0000u); }
__device__ __forceinline__ float bf1(bf16_t h) { return __builtin_bit_cast(float, (unsigned)h << 16); }
__device__ __forceinline__ float wave_sum(float v) {
#pragma unroll
    for (int o = 1; o < 64; o <<= 1) v += __shfl_xor(v, o);
    return v;
}
__device__ __forceinline__ float wave_max(float v) {
#pragma unroll
    for (int o = 1; o < 64; o <<= 1) v = fmaxf(v, __shfl_xor(v, o));
    return v;
}

using pg8::Unit;
struct Epi1 {
    static constexpr int PERM = 2;
    bf16_t* zc; bf16_t* qkv; bf16_t* gates; const float* bgate; const float* rope; float* out;
    __device__ __forceinline__ void operator()(const f32x4 (&acc)[2][2][4][2], const Unit& u, int wr, int wc, int fr, int fq) const {
        const int row0 = u.pm * 256 + wr * 64 + fr;
        const int cw0 = 64 * (wc >> 1) + 16 * (wc & 1) + 4 * fq;
        if (u.pn < 6) {
#pragma unroll
            for (int ai = 0; ai < 2; ++ai)
#pragma unroll
                for (int m = 0; m < 4; ++m) { bf16_t* rp = zc + (size_t)(row0 + ai * 128 + m * 16) * 1536 + u.pn * 256 + cw0;
#pragma unroll
                    for (int bj = 0; bj < 2; ++bj)
#pragma unroll
                        for (int n = 0; n < 2; ++n) { const f32x4 v = acc[ai][bj][m][n]; u32x2 w; w.x = cvt_pk_bf16(v[0], v[1]); w.y = cvt_pk_bf16(v[2], v[3]); *(u32x2*)(rp + bj * 128 + n * 32) = w; } }
        } else if (u.pn < 15) {
            const int t = u.pn - 6, gi = t / 3, kind = t - 3 * gi;
            bf16_t* dst = qkv + (size_t)(gi * 3 + kind) * M * 256;
            const int Wk = 128 << (2 * gi);
            float* okp = out + (gi == 0 ? O_KVP0 : (gi == 1 ? O_KVP1 : O_KVP2));
            float* oks = out + (gi == 0 ? O_KVS0 : (gi == 1 ? O_KVS1 : O_KVS2));
            const int e0 = 16 * (wc & 1) + 4 * fq;
#pragma unroll
            for (int ai = 0; ai < 2; ++ai)
#pragma unroll
                for (int m = 0; m < 4; ++m) {
                    const int row = row0 + ai * 128 + m * 16;
                    int pos; float* kvb = nullptr;
                    if (row < MP) { const int nb = row >> 12, p = row & 4095; pos = p; const int pk = p - (SEQ - Wk); if (pk >= 0) kvb = okp + ((size_t)(nb * Wk + pk) * 2) * 256; }
                    else { const int rs = row - MP, nb = rs >> 3, tt = rs & 7; pos = 2048 + tt; kvb = oks + ((size_t)(nb * Wk + Wk - 8 + tt) * 2) * 256; }
                    f32x4 cs0 = {1.f, 0.f, 1.f, 0.f}, cs1 = {1.f, 0.f, 1.f, 0.f};
                    if (kind < 2) { const f32x4* rp = (const f32x4*)(rope + ((size_t)pos * 32 + e0) * 2); cs0 = rp[0]; cs1 = rp[1]; }
#pragma unroll
                    for (int bj = 0; bj < 2; ++bj) {
                        f32x4 x1 = acc[ai][bj][m][0], x2 = acc[ai][bj][m][1];
                        if (kind < 2) {
                            const f32x4 c = {cs0[0], cs0[2], cs1[0], cs1[2]}, s = {cs0[1], cs0[3], cs1[1], cs1[3]};
                            const f32x4 o1 = x1 * c - x2 * s, o2 = x2 * c + x1 * s; x1 = o1; x2 = o2;
                            if (kind == 0) { x1 = x1 * 0.125f; x2 = x2 * 0.125f; }
                        }
                        const int hc = (2 * bj + (wc >> 1)) * 64 + e0;
                        u32x2 w1, w2; w1.x = cvt_pk_bf16(x1[0], x1[1]); w1.y = cvt_pk_bf16(x1[2], x1[3]); w2.x = cvt_pk_bf16(x2[0], x2[1]); w2.y = cvt_pk_bf16(x2[2], x2[3]);
                        *(u32x2*)(dst + (size_t)row * 256 + hc) = w1; *(u32x2*)(dst + (size_t)row * 256 + hc + 32) = w2;
                        if (kind >= 1 && kvb) { float* kp = kvb + (kind - 1) * 256 + hc; *(f32x4*)kp = x1; *(f32x4*)(kp + 32) = x2; }
                    }
                    asm volatile("" ::: "memory");
                }
        } else {
            const int cg0 = (u.pn - 15) * 256 + cw0;
#pragma unroll
            for (int bj = 0; bj < 2; ++bj)
#pragma unroll
                for (int n = 0; n < 2; ++n) { const f32x4 bv = *(const f32x4*)(bgate + cg0 + bj * 128 + n * 32);
#pragma unroll
                    for (int ai = 0; ai < 2; ++ai)
#pragma unroll
                        for (int m = 0; m < 4; ++m) { const f32x4 v = acc[ai][bj][m][n] + bv; f32x4 s;
#pragma unroll
                            for (int j = 0; j < 4; ++j) s[j] = __builtin_amdgcn_rcpf(1.0f + __expf(-v[j]));
                            u32x2 w; w.x = cvt_pk_bf16(s[0], s[1]); w.y = cvt_pk_bf16(s[2], s[3]);
                            *(u32x2*)(gates + (size_t)(row0 + ai * 128 + m * 16) * 2048 + cg0 + bj * 128 + n * 32) = w; } }
        }
    }
};
struct Epi3 {
    static constexpr int PERM = 1;
    bf16_t* mix; const bf16_t* gates; int second;
    __device__ __forceinline__ void operator()(const f32x4 (&acc)[2][2][4][2], const Unit& u, int wr, int wc, int fr, int fq) const {
        const int row0 = u.pm * 256 + wr * 64 + fr, col0 = u.pn * 256 + wc * 32 + 8 * fq;
#pragma unroll
        for (int ai = 0; ai < 2; ++ai)
#pragma unroll
            for (int m = 0; m < 4; ++m) { const int row = row0 + ai * 128 + m * 16;
#pragma unroll
                for (int bj = 0; bj < 2; ++bj) { const int c = col0 + bj * 128;
                    const u32x4 g = *(const u32x4*)(gates + (size_t)row * 2048 + second * 1024 + c);
                    f32x4 v0 = acc[ai][bj][m][0], v1 = acc[ai][bj][m][1];
                    v0 = v0 * (f32x4){bflo(g.x), bfhi(g.x), bflo(g.y), bfhi(g.y)}; v1 = v1 * (f32x4){bflo(g.z), bfhi(g.z), bflo(g.w), bfhi(g.w)};
                    bf16_t* mp = mix + (size_t)row * 1024 + c;
                    if (second) { const u32x4 o = *(const u32x4*)mp; v0 = v0 + (f32x4){bflo(o.x), bfhi(o.x), bflo(o.y), bfhi(o.y)}; v1 = v1 + (f32x4){bflo(o.z), bfhi(o.z), bflo(o.w), bfhi(o.w)}; }
                    u32x4 w; w.x = cvt_pk_bf16(v0[0], v0[1]); w.y = cvt_pk_bf16(v0[2], v0[3]); w.z = cvt_pk_bf16(v1[0], v1[1]); w.w = cvt_pk_bf16(v1[2], v1[3]);
                    *(u32x4*)mp = w; }
                asm volatile("" ::: "memory"); }
    }
};
template <bool BF16RES>
struct EpiRes {
    static constexpr int PERM = 0;
    const void* res; float* pre; float* part;
    __device__ __forceinline__ void operator()(const f32x4 (&acc)[2][2][4][2], const Unit& u, int wr, int wc, int fr, int fq) const {
        const int row0 = u.pm * 256 + wr * 64 + fr, col0 = u.pn * 256 + wc * 32 + 4 * fq;
        if (u.pm >= 64) {
            float* pb = part + ((size_t)(u.kt0 / u.nt) * MS + (row0 - MP)) * 1024 + col0;
#pragma unroll
            for (int ai = 0; ai < 2; ++ai)
#pragma unroll
                for (int m = 0; m < 4; ++m)
#pragma unroll
                    for (int bj = 0; bj < 2; ++bj)
#pragma unroll
                        for (int n = 0; n < 2; ++n) *(f32x4*)(pb + (size_t)(ai * 128 + m * 16) * 1024 + bj * 128 + n * 16) = acc[ai][bj][m][n];
            return;
        }
#pragma unroll
        for (int ai = 0; ai < 2; ++ai)
#pragma unroll
            for (int m = 0; m < 4; ++m) { const size_t off = (size_t)(row0 + ai * 128 + m * 16) * 1024 + col0;
#pragma unroll
                for (int bj = 0; bj < 2; ++bj)
#pragma unroll
                    for (int n = 0; n < 2; ++n) { f32x4 r;
                        if (BF16RES) { const u32x2 rr = *(const u32x2*)((const bf16_t*)res + off + bj * 128 + n * 16); r = (f32x4){bflo(rr.x), bfhi(rr.x), bflo(rr.y), bfhi(rr.y)}; }
                        else r = *(const f32x4*)((const float*)res + off + bj * 128 + n * 16);
                        *(f32x4*)(pre + off + bj * 128 + n * 16) = r * ALPHA + acc[ai][bj][m][n]; }
                asm volatile("" ::: "memory"); }
    }
};
struct EpiHid {
    static constexpr int PERM = 1;
    bf16_t* hid;
    __device__ __forceinline__ void operator()(const f32x4 (&acc)[2][2][4][2], const Unit& u, int wr, int wc, int fr, int fq) const {
        const int row0 = u.pm * 256 + wr * 64 + fr, col0 = u.pn * 256 + wc * 32 + 8 * fq;
#pragma unroll
        for (int ai = 0; ai < 2; ++ai)
#pragma unroll
            for (int m = 0; m < 4; ++m) { bf16_t* rp = hid + (size_t)(row0 + ai * 128 + m * 16) * FF + col0;
#pragma unroll
                for (int bj = 0; bj < 2; ++bj) { f32x4 v0 = acc[ai][bj][m][0], v1 = acc[ai][bj][m][1];
#pragma unroll
                    for (int j = 0; j < 4; ++j) { const float a = fmaxf(v0[j], 0.f), b = fmaxf(v1[j], 0.f); v0[j] = a * a; v1[j] = b * b; }
                    u32x4 w; w.x = cvt_pk_bf16(v0[0], v0[1]); w.y = cvt_pk_bf16(v0[2], v0[3]); w.z = cvt_pk_bf16(v1[0], v1[1]); w.w = cvt_pk_bf16(v1[2], v1[3]);
                    *(u32x4*)(rp + bj * 128) = w; } }
    }
};


struct P1Order {
    int base, stride, limit, c;
    __device__ bool next(int i, pg8::Unit& u) const {
        u.kt0 = 0; u.nt = D / pg8::BK;
        if (c >= stride) return false;
        const int L = base + i * stride + c; if (L >= limit) return false;
        if (L < 92) { u.pm = 64 + L / 23; u.pn = L % 23; return true; }
        constexpr int nM = 64, nN = 23, nwg = nM * nN;
        int wgid = L - 92; { const int q = nwg / pg8::NXCD, r = nwg % pg8::NXCD, xcd = wgid % pg8::NXCD, off = wgid / pg8::NXCD; wgid = (xcd < r ? xcd * (q + 1) : r * (q + 1) + (xcd - r) * q) + off; }
        const int nig = pg8::WGM * nN, gid = wgid / nig, fm = gid * pg8::WGM, gsz = (nM - fm) < pg8::WGM ? (nM - fm) : pg8::WGM;
        u.pm = fm + ((wgid % nig) % gsz); u.pn = (wgid % nig) / gsz; return true;
    }
    __device__ __forceinline__ void a_ready(const pg8::Unit&) const {}
    __device__ __forceinline__ void done(const pg8::Unit&) const {}
};

struct SplitOrder {
    int NSL, ntk, G, c;
    __device__ __forceinline__ bool next(int i, pg8::Unit& u) const {
        const int nsub = 16 * NSL, L = i * G + c; const bool ok = (i <= 1) && (L < nsub + 256);
        const int idx = L / NSL, kz = L - idx * NSL, snt = ntk / NSL;
        constexpr int nM = 64, nN = 4, nwg = nM * nN;
        int wgid = L - nsub; wgid = wgid < 0 ? 0 : wgid;
        { const int q = nwg / pg8::NXCD, xcd = wgid % pg8::NXCD, off = wgid / pg8::NXCD; wgid = xcd * q + off; }
        const int nig = pg8::WGM * nN, gid = wgid / nig, fm = gid * pg8::WGM;
        const int ppm = fm + ((wgid % nig) % pg8::WGM), ppn = (wgid % nig) / pg8::WGM;
        const bool sub = L < nsub;
        pg8::Unit r; r.pm = sub ? 64 + (idx >> 2) : ppm; r.pn = sub ? (idx & 3) : ppn; r.kt0 = sub ? kz * snt : 0; r.nt = sub ? snt : ntk;
        u = r; return ok;
    }
    __device__ __forceinline__ void a_ready(const pg8::Unit&) const {}
    __device__ __forceinline__ void done(const pg8::Unit&) const {}
};
__device__ __forceinline__ void transpose_item(const float* W, int K, int N, bf16_t* WT, LAS float* scr, int item, int lane) {
    const int nblk = N / 32, kb = item / nblk, nb = item % nblk, k0 = 64 * kb, n0 = 32 * nb;
#pragma unroll 8
    for (int i = 0; i < 32; ++i) { const int kk = 2 * i + (lane >> 5); scr[kk * 33 + (lane & 31)] = W[(size_t)(k0 + kk) * N + n0 + (lane & 31)]; }
    asm volatile("s_waitcnt lgkmcnt(0)" ::: "memory");
    const int c = lane & 7;
#pragma unroll
    for (int j = 0; j < 4; ++j) { const int n = (lane >> 3) + 8 * j; const LAS float* s = scr + (8 * c) * 33 + n;
        u32x4 o; o.x = cvt_pk_bf16(s[0 * 33], s[1 * 33]); o.y = cvt_pk_bf16(s[2 * 33], s[3 * 33]); o.z = cvt_pk_bf16(s[4 * 33], s[5 * 33]); o.w = cvt_pk_bf16(s[6 * 33], s[7 * 33]);
        *(u32x4*)(WT + (size_t)(n0 + n) * K + k0 + 8 * c) = o; }
    asm volatile("s_waitcnt lgkmcnt(0)" ::: "memory");
}

__device__ __forceinline__ void phase_prep(const Params& p, LAS unsigned char* lds) {
    const int tid = fresh_tid(), lane = tid & 63, wave = tid >> 6;
    const size_t gt = (size_t)blockIdx.x * NT + tid, GT = (size_t)gridDim.x * NT;
    unsigned char* ws = p.ws;
    { bf16_t* xb = (bf16_t*)(ws + WS_XB); constexpr size_t NCH = (size_t)M * D / 8, NP = (size_t)MP * D / 8;
      for (size_t i0 = gt; i0 < NCH; i0 += 4 * GT) {
          f32x4 a[4], b[4];
#pragma unroll
          for (int k = 0; k < 4; ++k) { const size_t i = i0 + k * GT; if (i < NCH) { const float* src = (i < NP) ? p.in[0] + i * 8 : p.in[1] + (i - NP) * 8; a[k] = ((const f32x4*)src)[0]; b[k] = ((const f32x4*)src)[1]; } }
#pragma unroll
          for (int k = 0; k < 4; ++k) { const size_t i = i0 + k * GT; if (i < NCH) { u32x4 o; o.x = cvt_pk_bf16(a[k][0], a[k][1]); o.y = cvt_pk_bf16(a[k][2], a[k][3]); o.z = cvt_pk_bf16(b[k][0], b[k][1]); o.w = cvt_pk_bf16(b[k][2], b[k][3]);
              *(u32x4*)(xb + i * 8) = o; } } } }
    { float* rt = (float*)(ws + WS_ROPE);
      for (size_t i = gt; i < (size_t)4096 * 32; i += GT) { const int pos = (int)(i >> 5), f = (int)(i & 31);
          const float inv = 1.0f / exp2f((float)f * (13.287712379549449f / 32.0f));
          const float ang = (float)pos * inv;
          const double rev = (double)ang * 0.15915494309189535; const float fr = (float)(rev - floor(rev));
          rt[2 * i] = __builtin_amdgcn_cosf(fr); rt[2 * i + 1] = __builtin_amdgcn_sinf(fr); } }
    { LAS float* scr = (LAS float*)(lds + wave * 16384);
      const int gw = blockIdx.x * 8 + wave, NGW = gridDim.x * 8;
      constexpr int I_IN = (D / 64) * (NIN / 32), I_C = (DC / 64) * (D / 32), I_A = (256 / 64) * (D / 32), I_O = (D / 64) * (D / 32), I_UP = (D / 64) * (FF / 32), I_DN = (FF / 64) * (D / 32);
      constexpr int NITEMS = I_IN + I_C + I_A + I_O + I_UP + I_DN;
      for (int it = gw; it < NITEMS; it += NGW) { int r = it;
          if (r < I_IN) { transpose_item(p.in[6], D, NIN, (bf16_t*)(ws + WS_WIN), scr, r, lane); continue; } r -= I_IN;
          if (r < I_C) { transpose_item(p.in[9], DC, D, (bf16_t*)(ws + WS_WC), scr, r, lane); continue; } r -= I_C;
          if (r < I_A) { transpose_item(p.in[10], 256, D, (bf16_t*)(ws + WS_WA), scr, r, lane); continue; } r -= I_A;
          if (r < I_O) { transpose_item(p.in[11], D, D, (bf16_t*)(ws + WS_WO), scr, r, lane); continue; } r -= I_O;
          if (r < I_UP) { transpose_item(p.in[14], D, FF, (bf16_t*)(ws + WS_WUP), scr, r, lane); continue; } r -= I_UP;
          transpose_item(p.in[15], FF, D, (bf16_t*)(ws + WS_WDN), scr, r, lane); } }
}

constexpr int KS_STRIDE = 144;
constexpr int VT_STRIDE = 528;
constexpr int KS_OFF = 0, VT_OFF = 256 * KS_STRIDE;
__device__ __forceinline__ void attn_prompt_item(const Params& p, LAS unsigned char* lds, int item) {
    const int tid = fresh_tid(), lane = tid & 63, w = tid >> 6, fr = lane & 15, s = lane >> 4;
    const int g = item >> 9, rem = item & 511, nb = rem >> 7, rem2 = rem & 127, h = rem2 >> 5, rb = rem2 & 31;
    const int dsh = 2 * g, d = 1 << dsh, nbk = 32 >> dsh, r = rb / nbk, b = rb - r * nbk;
    const bf16_t* qb = (const bf16_t*)(p.ws + WS_QKV) + (size_t)(3 * g) * M * 256;
    const bf16_t* kb = qb + (size_t)M * 256; const bf16_t* vb = kb + (size_t)M * 256;
    const size_t rowbase = (size_t)nb * SEQ + r;
    const int i0 = 128 * (b - 1);
#pragma unroll
    for (int ii = 0; ii < 4; ++ii) { const int c = tid + NT * ii, kl = c >> 3, ch = c & 7; int ik = i0 + kl; ik = ik < 0 ? 0 : ik;
        const u32x4 v = *(const u32x4*)(kb + (rowbase + (size_t)ik * d) * 256 + h * 64 + ch * 8);
        *(LAS u32x4*)(lds + KS_OFF + kl * KS_STRIDE + ch * 16) = v; }
#pragma unroll
    for (int ii = 0; ii < 4; ++ii) { const int c = tid + NT * ii, kl = c & 255, ch = c >> 8; int ik = i0 + kl; ik = ik < 0 ? 0 : ik;
        const u32x4 v = *(const u32x4*)(vb + (rowbase + (size_t)ik * d) * 256 + h * 64 + ch * 8);
        LAS bf16_t* vt = (LAS bf16_t*)(lds + VT_OFF + (ch * 8) * VT_STRIDE) + kl;
        vt[0 * (VT_STRIDE / 2)] = (bf16_t)(v.x & 0xffff); vt[1 * (VT_STRIDE / 2)] = (bf16_t)(v.x >> 16);
        vt[2 * (VT_STRIDE / 2)] = (bf16_t)(v.y & 0xffff); vt[3 * (VT_STRIDE / 2)] = (bf16_t)(v.y >> 16);
        vt[4 * (VT_STRIDE / 2)] = (bf16_t)(v.z & 0xffff); vt[5 * (VT_STRIDE / 2)] = (bf16_t)(v.z >> 16);
        vt[6 * (VT_STRIDE / 2)] = (bf16_t)(v.w & 0xffff); vt[7 * (VT_STRIDE / 2)] = (bf16_t)(v.w >> 16); }
    const int iq = 128 * b + 16 * w + fr; const size_t qrow = rowbase + (size_t)iq * d;
    const bf16x8 q0 = *(const bf16x8*)(qb + qrow * 256 + h * 64 + 8 * s), q1 = *(const bf16x8*)(qb + qrow * 256 + h * 64 + 32 + 8 * s);
    __syncthreads();
    f32x4 sc[9];
#pragma unroll
    for (int j = 0; j < 9; ++j) {
        const LAS unsigned char* kp = lds + KS_OFF + (16 * (w + j) + fr) * KS_STRIDE + s * 16;
        const bf16x8 k0 = *(const LAS bf16x8*)kp, k1 = *(const LAS bf16x8*)(kp + 64);
        f32x4 a = {0.f, 0.f, 0.f, 0.f};
        a = __builtin_amdgcn_mfma_f32_16x16x32_bf16(k0, q0, a, 0, 0, 0);
        a = __builtin_amdgcn_mfma_f32_16x16x32_bf16(k1, q1, a, 0, 0, 0);
        sc[j] = a;
    }
    float mx = -INFINITY;
#pragma unroll
    for (int j = 0; j < 9; ++j)
#pragma unroll
        for (int i = 0; i < 4; ++i) { const int dist = 128 - 16 * j + fr - 4 * s - i; const int kl = 16 * (w + j) + 4 * s + i;
            const bool ok = (dist >= 0) && (dist <= 128) && (b > 0 || kl >= 128);
            sc[j][i] = ok ? sc[j][i] : -INFINITY; mx = fmaxf(mx, sc[j][i]); }
    mx = fmaxf(mx, __shfl_xor(mx, 16)); mx = fmaxf(mx, __shfl_xor(mx, 32));
    float sum = 0.f;
#pragma unroll
    for (int j = 0; j < 9; ++j)
#pragma unroll
        for (int i = 0; i < 4; ++i) { const float e = __expf(sc[j][i] - mx); sc[j][i] = e; sum += e; }
    sum += __shfl_xor(sum, 16); sum += __shfl_xor(sum, 32);
    f32x4 o[4];
#pragma unroll
    for (int dt = 0; dt < 4; ++dt) o[dt] = (f32x4){0.f, 0.f, 0.f, 0.f};
#pragma unroll
    for (int j = 0; j < 9; ++j) {
        u32x2 pw; pw.x = cvt_pk_bf16(sc[j][0], sc[j][1]); pw.y = cvt_pk_bf16(sc[j][2], sc[j][3]);
        const bf16x4 pf = __builtin_bit_cast(bf16x4, pw);
#pragma unroll
        for (int dt = 0; dt < 4; ++dt) {
            const bf16x4 vf = *(const LAS bf16x4*)(lds + VT_OFF + (16 * dt + fr) * VT_STRIDE + (16 * (w + j) + 4 * s) * 2);
            o[dt] = __builtin_amdgcn_mfma_f32_16x16x16bf16_1k(vf, pf, o[dt], 0, 0, 0);
        }
    }
    const float inv = 1.0f / sum;
    bf16_t* og = (bf16_t*)(p.ws + WS_OG) + (size_t)g * M * 256 + qrow * 256 + h * 64;
#pragma unroll
    for (int dt = 0; dt < 4; ++dt) { u32x2 ww; ww.x = cvt_pk_bf16(o[dt][0] * inv, o[dt][1] * inv); ww.y = cvt_pk_bf16(o[dt][2] * inv, o[dt][3] * inv); *(u32x2*)(og + 16 * dt + 4 * s) = ww; }
    if (s == 0) ((float*)(p.ws + WS_LSE))[((size_t)g * M + qrow) * 4 + h] = mx + __logf(sum);
    __syncthreads();
}

__device__ __forceinline__ void attn_sample_unit(const Params& p, LAS unsigned char* lds, int unit) {
    const int tid = fresh_tid(), lane = tid & 63, w = tid >> 6, ks = lane >> 4, dq = lane & 15;
    LAS float* ps = (LAS float*)(lds + w * 1024);
    const int it_ = unit >> 3, h = w & 3, t = 2 * (it_ & 3) + (w >> 2), g = (it_ >> 2) % 3, n = it_ / 12;
    const int dsh = 2 * g, d = 1 << dsh, W = 128 << dsh;
    const int nnew = (t >> dsh) + 1, ncache = 129 - nnew, idx0 = W + t - nnew * d;
    const size_t row = (size_t)MP + n * 8 + t;
    const bf16_t* qb = (const bf16_t*)(p.ws + WS_QKV) + (size_t)(3 * g) * M * 256 + h * 64 + 4 * dq;
    const bf16_t* kb = qb + (size_t)M * 256; const bf16_t* vb = kb + (size_t)M * 256;
    const float* cache = p.in[3 + g] + (size_t)n * W * 512 + h * 64 + 4 * dq;
    const u32x2 qq = *(const u32x2*)(qb + row * 256);
    const f32x4 qv = {bflo(qq.x), bfhi(qq.x), bflo(qq.y), bfhi(qq.y)};
    const size_t step = (size_t)4 * d * 512;
    { const float* kp = cache + (size_t)(idx0 - ks * d) * 512;
#pragma unroll 8
      for (int jj = 0; jj < 32; ++jj) {
          const f32x4 k = *(const f32x4*)kp; kp -= step;
          float a = (k[0] * qv[0] + k[1] * qv[1]) + (k[2] * qv[2] + k[3] * qv[3]);
          a += __shfl_xor(a, 1); a += __shfl_xor(a, 2); a += __shfl_xor(a, 4); a += __shfl_xor(a, 8);
          if (dq == 0) ps[4 * jj + ks] = (4 * jj + ks < ncache) ? a : -INFINITY;
      } }
#pragma unroll
    for (int i = 0; i < 2; ++i) { const int l = ks + 4 * i, lc = l < nnew ? l : 0;
        const u32x2 kk = *(const u32x2*)(kb + ((size_t)MP + n * 8 + (t - lc * d)) * 256);
        float a = (bflo(kk.x) * qv[0] + bfhi(kk.x) * qv[1]) + (bflo(kk.y) * qv[2] + bfhi(kk.y) * qv[3]);
        a += __shfl_xor(a, 1); a += __shfl_xor(a, 2); a += __shfl_xor(a, 4); a += __shfl_xor(a, 8);
        if (dq == 0) ps[128 + l] = (l < nnew) ? a : -INFINITY; }
    asm volatile("s_waitcnt lgkmcnt(0)" ::: "memory");
    const float s0 = ps[lane], s1 = ps[lane + 64], s2 = lane < 8 ? ps[128 + lane] : -INFINITY;
    const float mx = wave_max(fmaxf(fmaxf(s0, s1), s2));
    const float e0 = __expf(s0 - mx), e1 = __expf(s1 - mx), e2 = __expf(s2 - mx);
    asm volatile("s_waitcnt lgkmcnt(0)" ::: "memory");
    ps[lane] = e0; ps[lane + 64] = e1; if (lane < 8) ps[128 + lane] = e2;
    const float sum = wave_sum(e0 + e1 + e2);
    asm volatile("s_waitcnt lgkmcnt(0)" ::: "memory");
    f32x4 o = {0.f, 0.f, 0.f, 0.f};
    { const float* vp = cache + 256 + (size_t)(idx0 - ks * d) * 512;
#pragma unroll 8
      for (int jj = 0; jj < 32; ++jj) { const f32x4 v = *(const f32x4*)vp; vp -= step; o = o + v * ps[4 * jj + ks]; } }
#pragma unroll
    for (int i = 0; i < 2; ++i) { const int l = ks + 4 * i, lc = l < nnew ? l : 0;
        const u32x2 vv = *(const u32x2*)(vb + ((size_t)MP + n * 8 + (t - lc * d)) * 256);
        o = o + (f32x4){bflo(vv.x), bfhi(vv.x), bflo(vv.y), bfhi(vv.y)} * ps[128 + l]; }
#pragma unroll
    for (int i = 0; i < 4; ++i) { o[i] += __shfl_xor(o[i], 16); o[i] += __shfl_xor(o[i], 32); }
    const float inv = 1.0f / sum;
    if (ks == 0) { u32x2 ww; ww.x = cvt_pk_bf16(o[0] * inv, o[1] * inv); ww.y = cvt_pk_bf16(o[2] * inv, o[3] * inv);
        *(u32x2*)((bf16_t*)(p.ws + WS_OG) + (size_t)g * M * 256 + row * 256 + h * 64 + 4 * dq) = ww; }
    if (lane == 0) ((float*)(p.ws + WS_LSE))[((size_t)g * M + row) * 4 + h] = mx + __logf(sum);
    asm volatile("s_waitcnt lgkmcnt(0)" ::: "memory");
}

__device__ __forceinline__ float dpp_add16(float a) {
    a += __builtin_bit_cast(float, __builtin_amdgcn_update_dpp(0, __builtin_bit_cast(int, a), 0xB1, 0xF, 0xF, false));
    a += __builtin_bit_cast(float, __builtin_amdgcn_update_dpp(0, __builtin_bit_cast(int, a), 0x4E, 0xF, 0xF, false));
    a += __builtin_bit_cast(float, __builtin_amdgcn_update_dpp(0, __builtin_bit_cast(int, a), 0x141, 0xF, 0xF, false));
    a += __builtin_bit_cast(float, __builtin_amdgcn_update_dpp(0, __builtin_bit_cast(int, a), 0x140, 0xF, 0xF, false));
    return a;
}
struct SoftAcc { float m, l; f32x4 o; };
#ifndef SAC_COPY2
#define SAC_COPY2 0
#endif
#ifndef SAC_NS
#define SAC_NS 2
#endif
template <int R>
__device__ __forceinline__ void soft_update(SoftAcc& A, const float (&sc)[R], const f32x4 (&v)[R]) {
    float mn = A.m;
#pragma unroll
    for (int i = 0; i < R; ++i) mn = fmaxf(mn, sc[i]);
    const float mref = (mn == -INFINITY) ? 0.f : mn;
    const float corr = __expf(A.m - mref);
    float ps = 0.f; f32x4 po = {0.f, 0.f, 0.f, 0.f};
#pragma unroll
    for (int i = 0; i < R; ++i) { const float pi = __expf(sc[i] - mref); ps += pi; po = po + v[i] * pi; }
    A.l = A.l * corr + ps; A.o = A.o * corr + po; A.m = mn;
}
template <int GI>
__device__ __forceinline__ void sac_unit(const Params& p, int n, int kh) {
    constexpr int dsh = 2 * GI, d = 1 << dsh, W = 128 << dsh;
    const int tid = threadIdx.x, lane = tid & 63, w = tid >> 6, dq = lane & 15, h = lane >> 4;
    const int t = w, nnew = (t >> dsh) + 1, ncache = 129 - nnew, idx0 = W - d + (t & (d - 1));
    const size_t srow = (size_t)n * 8 + t, row = (size_t)MP + srow;
    const bf16_t* qb = (const bf16_t*)(p.ws + WS_QKV) + (size_t)(3 * GI) * M * 256 + lane * 4;
    const bf16_t* kb = qb + (size_t)M * 256; const bf16_t* vb = kb + (size_t)M * 256;
    const u32x2 qq = *(const u32x2*)(qb + row * 256);
    const f32x4 qv = {bflo(qq.x), bfhi(qq.x), bflo(qq.y), bfhi(qq.y)};
    const float* cbase = p.in[3 + GI] + (size_t)n * W * 512 + lane * 4;
    float* obase = p.out + (GI == 0 ? O_KVS0 : (GI == 1 ? O_KVS1 : O_KVS2)) + (size_t)n * W * 512 + lane * 4;
    SoftAcc A; A.m = -INFINITY; A.l = 0.f; A.o = (f32x4){0.f, 0.f, 0.f, 0.f};
    const int c0 = kh ? 0 : 64;
    constexpr int R = (GI == 2 && SAC_COPY2) ? 2 : 4;
    struct Rows { f32x4 k[R], v[R], k2[R], v2[R]; };
    auto load_rows = [&](Rows& X, int cc) {
#pragma unroll
        for (int i = 0; i < R; ++i) { const float* rp = cbase + (size_t)(idx0 - (c0 + cc + i) * d) * 512;
            if (GI == 2) { X.k[i] = __builtin_nontemporal_load((const f32x4*)rp); X.v[i] = __builtin_nontemporal_load((const f32x4*)(rp + 256));
                if (SAC_COPY2) { X.k2[i] = __builtin_nontemporal_load((const f32x4*)(rp + 8 * 512)); X.v2[i] = __builtin_nontemporal_load((const f32x4*)(rp + 8 * 512 + 256)); } }
            else { X.k[i] = *(const f32x4*)rp; X.v[i] = *(const f32x4*)(rp + 256); } }
    };
    auto process_rows = [&](Rows& X, int cc) {
        float sc[R];
#pragma unroll
        for (int i = 0; i < R; ++i) { const float a = dpp_add16((X.k[i][0] * qv[0] + X.k[i][1] * qv[1]) + (X.k[i][2] * qv[2] + X.k[i][3] * qv[3])); sc[i] = (c0 + cc + i < ncache) ? a : -INFINITY; }
        soft_update<R>(A, sc, X.v);
#pragma unroll
        for (int i = 0; i < R; ++i) { const int idx = idx0 - (c0 + cc + i) * d;
            const bool mine = (GI == 2) ? true : (GI == 1 ? (w < 4) : ((idx & 7) == w));
            if (mine && idx >= 8) { float* op = obase + (size_t)(idx - 8) * 512; __builtin_nontemporal_store(X.k[i], (f32x4*)op); __builtin_nontemporal_store(X.v[i], (f32x4*)(op + 256)); }
            if (GI == 2 && SAC_COPY2) { float* op = obase + (size_t)idx * 512; __builtin_nontemporal_store(X.k2[i], (f32x4*)op); __builtin_nontemporal_store(X.v2[i], (f32x4*)(op + 256)); } }
    };
    { constexpr int NS = SAC_NS; Rows X[NS];
#pragma unroll
      for (int st = 0; st < NS - 1; ++st) load_rows(X[st], st * R);
#pragma unroll 1
      for (int cc = 0; cc < 64; cc += NS * R) {
#pragma unroll
          for (int st = 0; st < NS; ++st) { const int nxt = cc + (st + NS - 1) * R; if (nxt < 64) load_rows(X[(st + NS - 1) % NS], nxt); process_rows(X[st], cc + st * R); }
      } }
    if (kh) {
#pragma unroll
        for (int gq = 0; gq < 2; ++gq) {
            float sc[4]; f32x4 v[4];
#pragma unroll
            for (int i = 0; i < 4; ++i) { const int l = 4 * gq + i, lc = l < nnew ? l : 0; const size_t kr = ((size_t)MP + n * 8 + (t - lc * d)) * 256;
                const u32x2 kk = *(const u32x2*)(kb + kr), vv = *(const u32x2*)(vb + kr);
                const float a = dpp_add16((bflo(kk.x) * qv[0] + bfhi(kk.x) * qv[1]) + (bflo(kk.y) * qv[2] + bfhi(kk.y) * qv[3]));
                sc[i] = (l < nnew) ? a : -INFINITY; v[i] = (f32x4){bflo(vv.x), bfhi(vv.x), bflo(vv.y), bfhi(vv.y)}; }
            soft_update<4>(A, sc, v);
        }
    }
    const float inv = 1.0f / A.l; const int pg = 2 * GI + kh;
    u32x2 ww; ww.x = cvt_pk_bf16(A.o[0] * inv, A.o[1] * inv); ww.y = cvt_pk_bf16(A.o[2] * inv, A.o[3] * inv);
    *(u32x2*)((bf16_t*)(p.ws + WS_OGS) + ((size_t)pg * MS + srow) * 256 + lane * 4) = ww;
    if (dq == 0) ((float*)(p.ws + WS_LSES))[((size_t)pg * MS + srow) * 4 + h] = A.m + __logf(A.l);
}
template <int GI>
__device__ __forceinline__ void sac_unit_lds(const Params& p, LAS unsigned char* lds, int n, int kh) {
    constexpr int dsh = 2 * GI, d = 1 << dsh, W = 128 << dsh, HR = W / 2, NCH = HR / 64, RPT = 64 / d;
    const int tid = threadIdx.x, lane = tid & 63, w = tid >> 6, dq = lane & 15, h = lane >> 4;
    const int t = w, r = t & (d - 1), nnew = (t >> dsh) + 1, ncache = 129 - nnew, idx0 = W - d + r;
    const size_t srow = (size_t)n * 8 + t, row = (size_t)MP + srow;
    const bf16_t* qb = (const bf16_t*)(p.ws + WS_QKV) + (size_t)(3 * GI) * M * 256 + lane * 4;
    const bf16_t* kb = qb + (size_t)M * 256; const bf16_t* vb = kb + (size_t)M * 256;
    const u32x2 qq = *(const u32x2*)(qb + row * 256);
    const f32x4 qv = {bflo(qq.x), bfhi(qq.x), bflo(qq.y), bfhi(qq.y)};
    const float* cbase = p.in[3 + GI] + (size_t)n * W * 512 + lane * 4;
    float* obase = p.out + (GI == 0 ? O_KVS0 : O_KVS1) + (size_t)n * W * 512 + lane * 4;
    SoftAcc A; A.m = -INFINITY; A.l = 0.f; A.o = (f32x4){0.f, 0.f, 0.f, 0.f};
#pragma unroll 1
    for (int ch = 0; ch < NCH; ++ch) {
        const int base = kh * HR + ch * 64;
#pragma unroll
        for (int b2 = 0; b2 < 2; ++b2) {
            f32x4 k[4], v[4];
#pragma unroll
            for (int i = 0; i < 4; ++i) { const float* rp = cbase + (size_t)(base + 8 * w + 4 * b2 + i) * 512; k[i] = __builtin_nontemporal_load((const f32x4*)rp); v[i] = __builtin_nontemporal_load((const f32x4*)(rp + 256)); }
#pragma unroll
            for (int i = 0; i < 4; ++i) { const int rl = 8 * w + 4 * b2 + i, idx = base + rl;
                *(LAS f32x4*)(lds + rl * 2048 + lane * 16) = k[i]; *(LAS f32x4*)(lds + rl * 2048 + 1024 + lane * 16) = v[i];
                if (idx >= 8) { float* op = obase + (size_t)(idx - 8) * 512; __builtin_nontemporal_store(k[i], (f32x4*)op); __builtin_nontemporal_store(v[i], (f32x4*)(op + 256)); } }
        }
        __syncthreads();
#pragma unroll 2
        for (int j0 = 0; j0 < RPT; j0 += 4) {
            float sc[4]; f32x4 v[4];
#pragma unroll
            for (int i = 0; i < 4; ++i) { const int rl = r + d * (j0 + i), c = (idx0 - (base + rl)) >> dsh;
                const f32x4 k = *(const LAS f32x4*)(lds + rl * 2048 + lane * 16); v[i] = *(const LAS f32x4*)(lds + rl * 2048 + 1024 + lane * 16);
                const float a = dpp_add16((k[0] * qv[0] + k[1] * qv[1]) + (k[2] * qv[2] + k[3] * qv[3])); sc[i] = (c < ncache) ? a : -INFINITY; }
            soft_update<4>(A, sc, v);
        }
        __syncthreads();
    }
    if (kh) {
#pragma unroll
        for (int gq = 0; gq < 2; ++gq) {
            float sc[4]; f32x4 v[4];
#pragma unroll
            for (int i = 0; i < 4; ++i) { const int l = 4 * gq + i, lc = l < nnew ? l : 0; const size_t kr = ((size_t)MP + n * 8 + (t - lc * d)) * 256;
                const u32x2 kk = *(const u32x2*)(kb + kr), vv = *(const u32x2*)(vb + kr);
                const float a = dpp_add16((bflo(kk.x) * qv[0] + bfhi(kk.x) * qv[1]) + (bflo(kk.y) * qv[2] + bfhi(kk.y) * qv[3]));
                sc[i] = (l < nnew) ? a : -INFINITY; v[i] = (f32x4){bflo(vv.x), bfhi(vv.x), bflo(vv.y), bfhi(vv.y)}; }
            soft_update<4>(A, sc, v);
        }
    }
    const float inv = 1.0f / A.l; const int pg = 2 * GI + kh;
    u32x2 ww; ww.x = cvt_pk_bf16(A.o[0] * inv, A.o[1] * inv); ww.y = cvt_pk_bf16(A.o[2] * inv, A.o[3] * inv);
    *(u32x2*)((bf16_t*)(p.ws + WS_OGS) + ((size_t)pg * MS + srow) * 256 + lane * 4) = ww;
    if (dq == 0) ((float*)(p.ws + WS_LSES))[((size_t)pg * MS + srow) * 4 + h] = A.m + __logf(A.l);
}
__device__ __forceinline__ void phase_sample_attn_copy(const Params& p) {
    for (int u = blockIdx.x; u < 256; u += gridDim.x) { const int n = u >> 1, kh = u & 1; sac_unit<2>(p, n, kh); sac_unit<1>(p, n, kh); sac_unit<0>(p, n, kh); }
}

__device__ __forceinline__ void load_u8(const bf16_t* zc, size_t row, int c, float (&u)[8]) {
    const u32x4 a = *(const u32x4*)(zc + row * 1536 + 512 + c), b = *(const u32x4*)(zc + row * 1536 + 1024 + c);
    u[0] = bflo(a.x) * bflo(b.x); u[1] = bfhi(a.x) * bfhi(b.x); u[2] = bflo(a.y) * bflo(b.y); u[3] = bfhi(a.y) * bfhi(b.y);
    u[4] = bflo(a.z) * bflo(b.z); u[5] = bfhi(a.z) * bfhi(b.z); u[6] = bflo(a.w) * bflo(b.w); u[7] = bfhi(a.w) * bfhi(b.w);
}
__device__ __forceinline__ void phase_conv(const Params& p) {
    const bf16_t* zc = (const bf16_t*)(p.ws + WS_ZC); bf16_t* yc = (bf16_t*)(p.ws + WS_YC);
    const float* cw = p.in[8]; const float* st = p.in[2];
    const size_t gt = (size_t)blockIdx.x * NT + fresh_tid(), GT = (size_t)gridDim.x * NT;
    for (size_t i = gt; i < (size_t)M * 64; i += GT) {
        const size_t row = i >> 6; const int c = (int)(i & 63) * 8;
        float u0[8], u1[8], u2[8];
        load_u8(zc, row, c, u2);
        int tpos; int nb = 0; const bool prm = row < MP;
        if (prm) tpos = (int)(row & 4095); else { const int rs = (int)(row - MP); nb = rs >> 3; tpos = rs & 7; }
        if (tpos >= 1) load_u8(zc, row - 1, c, u1);
        else if (prm) {
#pragma unroll
            for (int e = 0; e < 8; ++e) u1[e] = 0.f; }
        else { const f32x4 a = *(const f32x4*)(st + ((size_t)nb * 2 + 1) * 512 + c), b = *(const f32x4*)(st + ((size_t)nb * 2 + 1) * 512 + c + 4);
            u1[0] = a[0]; u1[1] = a[1]; u1[2] = a[2]; u1[3] = a[3]; u1[4] = b[0]; u1[5] = b[1]; u1[6] = b[2]; u1[7] = b[3]; }
        if (tpos >= 2) load_u8(zc, row - 2, c, u0);
        else if (prm) {
#pragma unroll
            for (int e = 0; e < 8; ++e) u0[e] = 0.f; }
        else { const int si = tpos;
            const f32x4 a = *(const f32x4*)(st + ((size_t)nb * 2 + si) * 512 + c), b = *(const f32x4*)(st + ((size_t)nb * 2 + si) * 512 + c + 4);
            u0[0] = a[0]; u0[1] = a[1]; u0[2] = a[2]; u0[3] = a[3]; u0[4] = b[0]; u0[5] = b[1]; u0[6] = b[2]; u0[7] = b[3]; }
        const u32x4 bb = *(const u32x4*)(zc + row * 1536 + c);
        const float Bv[8] = {bflo(bb.x), bfhi(bb.x), bflo(bb.y), bfhi(bb.y), bflo(bb.z), bfhi(bb.z), bflo(bb.w), bfhi(bb.w)};
        float y[8];
#pragma unroll
        for (int e = 0; e < 8; ++e) y[e] = Bv[e] * (cw[c + e] * u0[e] + cw[512 + c + e] * u1[e] + cw[1024 + c + e] * u2[e]);
        u32x4 o; o.x = cvt_pk_bf16(y[0], y[1]); o.y = cvt_pk_bf16(y[2], y[3]); o.z = cvt_pk_bf16(y[4], y[5]); o.w = cvt_pk_bf16(y[6], y[7]);
        *(u32x4*)(yc + row * 512 + c) = o;
        float* so = nullptr;
        if (prm) { if (tpos >= SEQ - 2) so = p.out + O_CP + ((size_t)(row >> 12) * 2 + (tpos - (SEQ - 2))) * 512 + c; }
        else if (tpos >= 6) so = p.out + O_CS + ((size_t)nb * 2 + (tpos - 6)) * 512 + c;
        if (so) { *(f32x4*)so = (f32x4){u2[0], u2[1], u2[2], u2[3]}; *(f32x4*)(so + 4) = (f32x4){u2[4], u2[5], u2[6], u2[7]}; }
    }
}

constexpr int CP_PIECE = 8192;
constexpr int CP_UNITS_N = 2 + 8 + 32;
constexpr int CP_UNITS = 128 * CP_UNITS_N;
__device__ __forceinline__ void copy_unit(const Params& p, int unit) {
    const int n = unit / CP_UNITS_N, q = unit - n * CP_UNITS_N;
    const int g = q < 2 ? 0 : (q < 10 ? 1 : 2), piece = q - (g == 0 ? 0 : (g == 1 ? 2 : 10));
    const int W = 128 << (2 * g);
    const size_t per = (size_t)(W - 8) * 128, full = (size_t)W * 128;
    const f32x4* src = (const f32x4*)p.in[3 + g] + n * full + 1024 + (size_t)piece * CP_PIECE;
    f32x4* dst = (f32x4*)(p.out + (g == 0 ? O_KVS0 : (g == 1 ? O_KVS1 : O_KVS2))) + n * full + (size_t)piece * CP_PIECE;
    const int cnt = (int)((per - (size_t)piece * CP_PIECE) < (size_t)CP_PIECE ? (per - (size_t)piece * CP_PIECE) : (size_t)CP_PIECE);
    const int tid = fresh_tid();
#pragma unroll
    for (int u = 0; u < 2; ++u) {
        f32x4 v[8];
#pragma unroll
        for (int k = 0; k < 8; ++k) { const int idx = tid + (u * 8 + k) * NT; if (idx < cnt) v[k] = __builtin_nontemporal_load(src + idx); }
#pragma unroll
        for (int k = 0; k < 8; ++k) { const int idx = tid + (u * 8 + k) * NT; if (idx < cnt) __builtin_nontemporal_store(v[k], dst + idx); }
    }
}
__device__ __forceinline__ void phase_copy(const Params& p) {
    for (int u = blockIdx.x; u < CP_UNITS; u += gridDim.x) copy_unit(p, u);
}

template <int NG>
__device__ __forceinline__ void merge_rows(const bf16_t* og, const float* lse, size_t gstride_rows, size_t row, int c, bf16_t* dst) {
    const int h = c >> 6; float l[NG], mx = -INFINITY;
#pragma unroll
    for (int g = 0; g < NG; ++g) { l[g] = lse[((size_t)g * gstride_rows + row) * 4 + h]; mx = fmaxf(mx, l[g]); }
    float ws = 0.f;
#pragma unroll
    for (int g = 0; g < NG; ++g) { l[g] = __expf(l[g] - mx); ws += l[g]; }
    const float inv = 1.0f / ws; float acc[8];
#pragma unroll
    for (int e = 0; e < 8; ++e) acc[e] = 0.f;
#pragma unroll
    for (int g = 0; g < NG; ++g) { const u32x4 a = *(const u32x4*)(og + ((size_t)g * gstride_rows + row) * 256 + c); const float wg = l[g] * inv;
        acc[0] += wg * bflo(a.x); acc[1] += wg * bfhi(a.x); acc[2] += wg * bflo(a.y); acc[3] += wg * bfhi(a.y); acc[4] += wg * bflo(a.z); acc[5] += wg * bfhi(a.z); acc[6] += wg * bflo(a.w); acc[7] += wg * bfhi(a.w); }
    u32x4 o; o.x = cvt_pk_bf16(acc[0], acc[1]); o.y = cvt_pk_bf16(acc[2], acc[3]); o.z = cvt_pk_bf16(acc[4], acc[5]); o.w = cvt_pk_bf16(acc[6], acc[7]);
    *(u32x4*)dst = o;
}
__device__ __forceinline__ void phase_merge(const Params& p) {
    bf16_t* ya = (bf16_t*)(p.ws + WS_YA);
    const size_t gt = (size_t)blockIdx.x * NT + threadIdx.x, GT = (size_t)gridDim.x * NT;
    for (size_t i = gt; i < (size_t)M * 32; i += GT) {
        const size_t row = i >> 5; const int c = (int)(i & 31) * 8;
        if (row < MP) merge_rows<3>((const bf16_t*)(p.ws + WS_OG), (const float*)(p.ws + WS_LSE), M, row, c, ya + row * 256 + c);
        else merge_rows<6>((const bf16_t*)(p.ws + WS_OGS), (const float*)(p.ws + WS_LSES), MS, row - MP, c, ya + row * 256 + c);
    }
}

template <bool FINAL>
__device__ __forceinline__ void phase_ln(const Params& p, const float* gam, const float* bet) {
    constexpr int NSL = FINAL ? 8 : 4;
    const int lane = threadIdx.x & 63, w = threadIdx.x >> 6;
    const float* pre = (const float*)(p.ws + WS_PRE); const float* part = (const float*)(p.ws + WS_PART);
    f32x4 gv[4], bv[4];
#pragma unroll
    for (int j = 0; j < 4; ++j) { gv[j] = ((const f32x4*)gam)[lane + 64 * j]; bv[j] = ((const f32x4*)bet)[lane + 64 * j]; }
    for (int row = blockIdx.x * 8 + w; row < M; row += gridDim.x * 8) {
        f32x4 v[4];
        if (row < MP) { const f32x4* xr = (const f32x4*)(pre + (size_t)row * 1024) + lane;
#pragma unroll
            for (int j = 0; j < 4; ++j) v[j] = xr[64 * j]; }
        else { const int rs = row - MP;
#pragma unroll
            for (int j = 0; j < 4; ++j) {
                if (FINAL) { const u32x2 rr = ((const u32x2*)(p.ws + WS_X1B + (size_t)row * 2048))[lane + 64 * j]; v[j] = (f32x4){bflo(rr.x), bfhi(rr.x), bflo(rr.y), bfhi(rr.y)} * ALPHA; }
                else v[j] = ((const f32x4*)(p.in[1] + (size_t)rs * 1024))[lane + 64 * j] * ALPHA; }
#pragma unroll 2
            for (int z = 0; z < NSL; ++z) { const f32x4* pr = (const f32x4*)(part + ((size_t)z * MS + rs) * 1024) + lane;
#pragma unroll
                for (int j = 0; j < 4; ++j) v[j] = v[j] + pr[64 * j]; } }
        float s = 0.f;
#pragma unroll
        for (int j = 0; j < 4; ++j) s += (v[j][0] + v[j][1]) + (v[j][2] + v[j][3]);
        const float mean = wave_sum(s) * (1.f / 1024.f); float s2 = 0.f;
#pragma unroll
        for (int j = 0; j < 4; ++j) { v[j] = v[j] - mean; s2 += (v[j][0] * v[j][0] + v[j][1] * v[j][1]) + (v[j][2] * v[j][2] + v[j][3] * v[j][3]); }
        const float rstd = 1.f / sqrtf(wave_sum(s2) * (1.f / 1024.f) + LN_EPS);
#pragma unroll
        for (int j = 0; j < 4; ++j) { const f32x4 y = v[j] * rstd * gv[j] + bv[j];
            if (FINAL) { ((f32x4*)(p.out + (size_t)row * 1024))[lane + 64 * j] = y; }
            else { u32x2 ww; ww.x = cvt_pk_bf16(y[0], y[1]); ww.y = cvt_pk_bf16(y[2], y[3]); ((u32x2*)(p.ws + WS_X1B + (size_t)row * 2048))[lane + 64 * j] = ww; } }
    }
}


struct CopyStream {
    static constexpr bool ON = true;
    static constexpr int NSTEPS = 128 * 256;
    f32x4 ra, rb; char* pa; char* pb;
    const char* src; char* dst; char* dump; unsigned lane_off; int cur, end;
    __device__ __forceinline__ void init(const Params& p) {
        const int spb = (NSTEPS + (int)gridDim.x - 1) / (int)gridDim.x;
        cur = (int)blockIdx.x * spb; end = cur + spb < NSTEPS ? cur + spb : NSTEPS; if (cur > end) cur = end;
        src = (const char*)p.in[5]; dst = (char*)(p.out + O_KVS2); dump = (char*)(p.ws + WS_DUMP) + (size_t)blockIdx.x * 8192; lane_off = threadIdx.x * 16u;
        pa = dump; pb = dump; ra = (f32x4){0.f, 0.f, 0.f, 0.f}; rb = ra;
    }
    __device__ __forceinline__ static size_t step_off(int s) { const int n = s >> 8, q = s & 255; return (((size_t)n << 20) + ((size_t)(q >> 1) << 13) + 4096 + ((size_t)(q & 1) << 11)) * 4; }
    __device__ __forceinline__ void load(f32x4& r, char*& d) {
        const bool live = cur < end; const size_t off = step_off(live ? cur : 0);
        const char* a = (live ? src + off : (const char*)dump) + lane_off; d = (live ? dst + off - 4096 * 4 : dump) + lane_off; cur += live ? 1 : 0;
        asm volatile("global_load_dwordx4 %0, %1, off nt" : "=&v"(r) : "v"(a) : "memory");
    }
    __device__ __forceinline__ void step(int k) {
        if (k == 0) { load(ra, pa); load(rb, pb); }
        else if (k == 3) { asm volatile("global_store_dwordx4 %0, %1, off nt" :: "v"(pa), "v"(ra) : "memory"); asm volatile("global_store_dwordx4 %0, %1, off nt" :: "v"(pb), "v"(rb) : "memory"); }
    }
    __device__ __forceinline__ void finish() {
        for (; cur < end; ++cur) { const size_t off = step_off(cur); const f32x4 v = __builtin_nontemporal_load((const f32x4*)(src + off + lane_off)); __builtin_nontemporal_store(v, (f32x4*)(dst + off - 4096 * 4 + lane_off)); }
    }
};

#define XB_TMO      128
#define XB_XCNT(j)  (256  + 64 * (j))
#define XB_XSUB(j)  (1280 + 64 * (j))
#define XB_XGEN(j)  (2304 + 64 * (j))
#define XB_TOP      3328
#define XB_TOPGEN   3392
#define XCD_BAR_WORDS 3456
#define XB_SPIN_CAP (1u << 18)
__device__ __forceinline__ unsigned xb_ld(unsigned* p)              { return __hip_atomic_load(p, __ATOMIC_RELAXED, __HIP_MEMORY_SCOPE_AGENT); }
__device__ __forceinline__ unsigned xb_add(unsigned* p, unsigned v) { return __hip_atomic_fetch_add(p, v, __ATOMIC_RELAXED, __HIP_MEMORY_SCOPE_AGENT); }
__device__ __forceinline__ unsigned xb_xcc_id() { return (unsigned)__builtin_amdgcn_s_getreg((3 << 11) | 20) & 0xFu; }
#define XB_SPIN(cond, bar) do { unsigned _sp = 0; while (cond) { __builtin_amdgcn_s_sleep(1); \
    if ((++_sp & 255u) == 0u) { if (xb_ld(&(bar)[XB_TMO])) break; if (_sp > XB_SPIN_CAP) { atomicAdd(&(bar)[XB_TMO], 1u); break; } } } } while (0)
struct XcdBarrier { unsigned* bar; unsigned x; volatile LAS unsigned* st; };
__device__ __forceinline__ XcdBarrier xcd_barrier_post(unsigned* bar, volatile LAS unsigned* st) {
    XcdBarrier b; b.bar = bar; b.x = xb_xcc_id(); b.st = st;
    if (threadIdx.x == 0) (void)xb_add(&bar[XB_XCNT(b.x)], 1u);
    return b;
}
__device__ __forceinline__ void xcd_barrier_complete(unsigned* bar, unsigned x, unsigned& nloc, unsigned& nx) {
    const unsigned G = gridDim.x * gridDim.y * gridDim.z;
    unsigned sum, cnt, mine, sp = 0u;
    for (;;) {
        sum = 0u; cnt = 0u; mine = 0u;
#pragma unroll
        for (unsigned j = 0; j < 16; ++j) { const unsigned c = xb_ld(&bar[XB_XCNT(j)]); sum += c; cnt += (c > 0u) ? 1u : 0u; mine = (j == x) ? c : mine; }
        if (sum == G) break;
        __builtin_amdgcn_s_sleep(1);
        if ((++sp & 255u) == 0u) { if (xb_ld(&bar[XB_TMO])) break; if (sp > XB_SPIN_CAP) { atomicAdd(&bar[XB_TMO], 1u); break; } }
    }
    nloc = mine > 0u ? mine : 1u; nx = cnt > 0u ? cnt : 1u;
}
__device__ __forceinline__ void xcd_barrier(const XcdBarrier& b) {
    asm volatile("s_waitcnt vmcnt(0)" ::: "memory");
    __syncthreads();
    if (threadIdx.x == 0) {
        unsigned* bar = b.bar;
        __builtin_amdgcn_s_waitcnt(0);
        unsigned nloc = b.st[0], nx = b.st[1];
        if (nloc == 0u) { xcd_barrier_complete(bar, b.x, nloc, nx); b.st[0] = nloc; b.st[1] = nx; }
        const unsigned old = xb_add(&bar[XB_XSUB(b.x)], 1u);
        const unsigned gen = old / nloc;
        if (old + 1u == (gen + 1u) * nloc) {
            __builtin_amdgcn_fence(__ATOMIC_RELEASE, "agent");
            asm volatile("s_waitcnt vmcnt(0)" ::: "memory");
            const unsigned og = xb_add(&bar[XB_TOP], 1u);
            const unsigned tg = og / nx;
            if (og + 1u == (tg + 1u) * nx) xb_add(&bar[XB_TOPGEN], 1u);
            else XB_SPIN(xb_ld(&bar[XB_TOPGEN]) == tg, bar);
            __builtin_amdgcn_fence(__ATOMIC_ACQUIRE, "agent");
            xb_add(&bar[XB_XGEN(b.x)], 1u);
            asm volatile("s_waitcnt vmcnt(0)" ::: "memory");
        } else {
            XB_SPIN(xb_ld(&bar[XB_XGEN(b.x)]) == gen, bar);
            __builtin_amdgcn_fence(__ATOMIC_ACQUIRE, "agent");
            asm volatile("s_waitcnt vmcnt(0)" ::: "memory");
        }
    }
    __syncthreads();
}

constexpr int N_PHASES = 10;
__global__ void __launch_bounds__(NT, 2) fwd_kernel(Params p) {
    extern __shared__ __attribute__((aligned(16))) unsigned char smem[];
    LAS unsigned char* lds = (LAS unsigned char*)smem;
    unsigned char* ws = p.ws;
    const int G = gridDim.x, bx = blockIdx.x;
#if MK_MULTI
#define SYNC() do {} while (0)
#else
    cg::grid_group grid = cg::this_grid();
    if (p.ph_lo < 0) grid.sync();
    volatile LAS unsigned* xst = (volatile LAS unsigned*)(lds + pg8::STAGE_BYTES);
    if (threadIdx.x < 4) xst[threadIdx.x] = 0u;
    __syncthreads();
    const XcdBarrier xbar = xcd_barrier_post((unsigned*)(ws + WS_BAR), xst);
#define SYNC1() xcd_barrier(xbar)
#define SYNC() do { SYNC1(); if (DUP == 30) SYNC1(); } while (0)
#endif
#ifndef DUP
#define DUP -1
#endif
#define IN(k) (p.ph_lo <= (k) && (k) < p.ph_hi)
#define REP(k) for (int rep_ = 0; rep_ < ((DUP) == (k) ? 2 : 1); ++rep_)
    if (IN(0)) { REP(0) { phase_prep(p, lds); __syncthreads(); } SYNC(); }
    if (IN(1)) {
        constexpr int GEMM_WGS = 192;
        pg8::Gemm g{(const bf16_t*)(ws + WS_XB), (const bf16_t*)(ws + WS_WIN), M, NIN, D};
        Epi1 E{(bf16_t*)(ws + WS_ZC), (bf16_t*)(ws + WS_QKV), (bf16_t*)(ws + WS_GATE), p.in[7], (const float*)(ws + WS_ROPE), p.out};
        { P1Order S{0, G, (G < 1564 ? G : 1564), bx}; pg8::gemm_phase<Epi1, P1Order, true, true>(lds, g, S, E); }
        SYNC();
        { const int gw = G > 64 ? (G * 3) / 4 : G;
          if (gw != GEMM_WGS && bx == 0 && threadIdx.x == 0) {   }
          P1Order S{G < 1564 ? G : 1564, gw, 1564, bx}; pg8::gemm_phase<Epi1, P1Order, true, true>(lds, g, S, E); }
        { unsigned* qctr = (unsigned*)(ws + WS_BAR) + 3520;
          for (;;) {
              __syncthreads();
              if (threadIdx.x == 0) xst[2] = __hip_atomic_fetch_add(qctr, 1u, __ATOMIC_RELAXED, __HIP_MEMORY_SCOPE_AGENT);
              __syncthreads();
              const int u = (int)xst[2]; if (u >= 256) break;
              const int n = u >> 1, kh = u & 1; sac_unit<2>(p, n, kh); sac_unit_lds<1>(p, lds, n, kh); sac_unit_lds<0>(p, lds, n, kh);
          } }
        SYNC();
    }
    if (IN(2)) {
        REP(21) for (int it = bx; it < 1536; it += G) attn_prompt_item(p, lds, it);
        REP(23) phase_conv(p);
        __syncthreads();
        SYNC();
    }
    if (IN(3)) { REP(3) phase_merge(p); SYNC(); }
    if (IN(4)) {
        REP(4) {
        { pg8::Gemm g{(const bf16_t*)(ws + WS_YC), (const bf16_t*)(ws + WS_WC), M, D, DC}; pg8::StaticOrder S; S.init(M, D, G, bx, DC);
          Epi3 E{(bf16_t*)(ws + WS_MIX), (const bf16_t*)(ws + WS_GATE), 0};
          pg8::gemm_phase<Epi3, pg8::StaticOrder, true, true>(lds, g, S, E); }
        { pg8::Gemm g{(const bf16_t*)(ws + WS_YA), (const bf16_t*)(ws + WS_WA), M, D, 256}; pg8::StaticOrder S; S.init(M, D, G, bx, 256);
          Epi3 E{(bf16_t*)(ws + WS_MIX), (const bf16_t*)(ws + WS_GATE), 1};
          pg8::gemm_phase<Epi3, pg8::StaticOrder, true, true>(lds, g, S, E); }
        }
        SYNC();
    }
    if (IN(5)) {
        REP(5) {
        pg8::Gemm g{(const bf16_t*)(ws + WS_MIX), (const bf16_t*)(ws + WS_WO), M, D, D}; SplitOrder S{4, D / 64, G, bx};
        EpiRes<false> E{p.in[0], (float*)(ws + WS_PRE), (float*)(ws + WS_PART)};
        pg8::gemm_phase<EpiRes<false>, SplitOrder, true, true>(lds, g, S, E);
        }
        SYNC();
    }
    if (IN(6)) { REP(6) phase_ln<false>(p, p.in[12], p.in[13]); SYNC(); }
#if !SAC_COPY2
    CopyStream cs; cs.init(p);
#endif
    if (IN(7)) {
        REP(7) {
        pg8::Gemm g{(const bf16_t*)(ws + WS_X1B), (const bf16_t*)(ws + WS_WUP), M, FF, D}; pg8::StaticOrder S; S.init(M, FF, G, bx, D);
        EpiHid E{(bf16_t*)(ws + WS_HID)};
#if SAC_COPY2
        pg8::gemm_phase<EpiHid, pg8::StaticOrder, true, true>(lds, g, S, E);
#else
        pg8::gemm_phase<EpiHid, pg8::StaticOrder, true, true, CopyStream>(lds, g, S, E, cs);
#endif
        }
        SYNC();
    }
    if (IN(8)) {
        REP(8) {
        pg8::Gemm g{(const bf16_t*)(ws + WS_HID), (const bf16_t*)(ws + WS_WDN), M, D, FF}; SplitOrder S{8, FF / 64, G, bx};
        EpiRes<true> E{(const void*)(ws + WS_X1B), (float*)(ws + WS_PRE), (float*)(ws + WS_PART)};
#if SAC_COPY2
        pg8::gemm_phase<EpiRes<true>, SplitOrder, true, true>(lds, g, S, E);
#else
        pg8::gemm_phase<EpiRes<true>, SplitOrder, true, true, CopyStream>(lds, g, S, E, cs);
        cs.finish();
#endif
        }
        SYNC();
    }
    if (IN(9)) { REP(9) phase_ln<true>(p, p.in[16], p.in[17]); }
#ifdef DUMP
    if (IN(20)) { const size_t gt = (size_t)blockIdx.x * NT + threadIdx.x, GT = (size_t)gridDim.x * NT;
        for (size_t i = gt; i < (size_t)M * 1024; i += GT) { const size_t row = i >> 10, c = i & 1023; float v;
            if (DUMP == 1) { v = bf1(((const bf16_t*)(ws + WS_GATE))[row * 2048 + c]) + bf1(((const bf16_t*)(ws + WS_GATE))[row * 2048 + 1024 + c]) + bf1(((const bf16_t*)(ws + WS_ZC))[row * 1536 + c]) + bf1(((const bf16_t*)(ws + WS_ZC))[row * 1536 + 512 + c]);
                for (int sl = 0; sl < 9; ++sl) v += (float)(sl + 1) * bf1(((const bf16_t*)(ws + WS_QKV))[((size_t)sl * M + row) * 256 + (c & 255)]); }
            else if (DUMP == 2) { v = bf1(((const bf16_t*)(ws + WS_YC))[row * 512 + (c & 511)]);
                for (int sl = 0; sl < 3; ++sl) v += (float)(sl + 1) * bf1(((const bf16_t*)(ws + WS_OG))[((size_t)sl * M + row) * 256 + (c & 255)]) + ((const float*)(ws + WS_LSE))[((size_t)sl * M + row) * 4 + (c & 3)]; }
            else if (DUMP == 3) v = bf1(((const bf16_t*)(ws + WS_YA))[row * 256 + (c & 255)]);
            else if (DUMP == 4) v = bf1(((const bf16_t*)(ws + WS_MIX))[i]);
            else if (DUMP == 5 || DUMP == 8) v = ((const float*)(ws + WS_PRE))[i];
            else if (DUMP == 6) v = ((const float*)(ws + WS_X1F))[i];
            else { const bf16_t* hp = (const bf16_t*)(ws + WS_HID) + row * 4096 + c; v = bf1(hp[0]) + bf1(hp[1024]) + bf1(hp[2048]) + bf1(hp[3072]); }
            p.out[i] = v; } }
#endif
#undef IN
#undef SYNC
}

extern "C" void kernel_launch(void* const* d_in, const int* in_sizes, int n_in, void* d_out, int out_size, void* d_ws, size_t ws_size, hipStream_t stream) {
    static int grid = 0;
    if (grid == 0) {
        if (n_in != 18 || (size_t)out_size != O_END || ws_size < WS_END) { fprintf(stderr, "kernel_launch: unexpected shapes (n_in %d out %d ws %zu need %zu)\n", n_in, out_size, ws_size, (size_t)WS_END); grid = -1; return; }
        int dev = 0, cus = 0, per_cu = 0;
        (void)hipGetDevice(&dev); (void)hipDeviceGetAttribute(&cus, hipDeviceAttributeMultiprocessorCount, dev);
        if (hipFuncSetAttribute((const void*)fwd_kernel, hipFuncAttributeMaxDynamicSharedMemorySize, LDS_BYTES) != hipSuccess) { fprintf(stderr, "kernel_launch: hipFuncSetAttribute failed\n"); grid = -1; return; }
        if (hipOccupancyMaxActiveBlocksPerMultiprocessor(&per_cu, (const void*)fwd_kernel, NT, LDS_BYTES) != hipSuccess || per_cu < 1) { fprintf(stderr, "kernel_launch: occupancy query says %d\n", per_cu); per_cu = 1; }
        (void)hipGetLastError();
        grid = cus * 1;
    }
    if (grid < 0) return;
    Params p{};
    for (int i = 0; i < 18; ++i) p.in[i] = (const float*)d_in[i];
    p.out = (float*)d_out; p.ws = (unsigned char*)d_ws;
#if MK_MULTI
#ifdef DUMP
    for (int k = 0; k <= DUMP; ++k) { p.ph_lo = k; p.ph_hi = k + 1; hipLaunchKernelGGL(fwd_kernel, dim3(grid), dim3(NT), LDS_BYTES, stream, p); }
    p.ph_lo = 20; p.ph_hi = 21; hipLaunchKernelGGL(fwd_kernel, dim3(grid), dim3(NT), LDS_BYTES, stream, p);
#else
    for (int k = 0; k < N_PHASES; ++k) { p.ph_lo = k; p.ph_hi = k + 1; hipLaunchKernelGGL(fwd_kernel, dim3(grid), dim3(NT), LDS_BYTES, stream, p); }
#endif
#else
    p.ph_lo = 0; p.ph_hi = N_PHASES;
    if (hipMemsetAsync((char*)d_ws + WS_BAR, 0, 16384, stream) != hipSuccess) { fprintf(stderr, "kernel_launch: memset of the barrier words failed\n"); return; }
    void* args[] = {&p};
    hipError_t e = hipLaunchCooperativeKernel((const void*)fwd_kernel, dim3(grid), dim3(NT), args, LDS_BYTES, stream);
    if (e != hipSuccess) fprintf(stderr, "cooperative launch failed: %s (grid %d)\n", hipGetErrorString(e), grid);
#endif
}
```
